# Optimizing an MI355X kernel written in HIP

```python
import math
import jax
import jax.numpy as jnp
from jax import lax
import numpy as np

D_MODEL = 1024
BATCH = 4
SEQ = 4096
DEPTH = 1

NORM_EPS = 1e-6
GMLP_WIDTH = 1024
GMLP_GROUPS = 8
GMLP_GROUP_DIM = GMLP_WIDTH // GMLP_GROUPS
GMLP_CHUNK = 128
ATT_HEADS = 8
HEAD_DIM = 128
ATT_WIDTH = ATT_HEADS * HEAD_DIM
MOBA_BLOCK = 256
MOBA_TOPK = 3
MOBA_QCHUNK = 32
REL_BUCKETS = 32
REL_MAX_DIST = 128
N_GROUPS = 4
EXPERTS_PER_GROUP = 8
N_EXPERTS = N_GROUPS * EXPERTS_PER_GROUP
TOPK_IN_GROUP = 2
D_EXPERT = 256
IN_SPLITS = (GMLP_WIDTH, GMLP_WIDTH, ATT_WIDTH, ATT_WIDTH, ATT_WIDTH, D_MODEL, D_MODEL)
IN_COLS = 2 * GMLP_WIDTH + 3 * ATT_WIDTH + 2 * D_MODEL

kernel_name = "hybrid_gmlp_moba_hmoe_block"


def rmsnorm(x, g):
    xf = x.astype(jnp.float32)
    y = xf * lax.rsqrt(jnp.mean(xf * xf, axis=-1, keepdims=True) + NORM_EPS)
    return (y * g.astype(jnp.float32)).astype(x.dtype)


def layernorm(x, g, b):
    xf = x.astype(jnp.float32)
    mu = jnp.mean(xf, axis=-1, keepdims=True)
    var = jnp.mean(jnp.square(xf - mu), axis=-1, keepdims=True)
    y = (xf - mu) * lax.rsqrt(var + NORM_EPS)
    return (y * g.astype(jnp.float32) + b.astype(jnp.float32)).astype(x.dtype)


def t5_bucket(n):
    n = jnp.maximum(n, 0)
    max_exact = REL_BUCKETS // 2
    nf = jnp.maximum(n, max_exact).astype(jnp.float32)
    large = max_exact + (jnp.log(nf / max_exact) / math.log(REL_MAX_DIST / max_exact)
                         * (REL_BUCKETS - max_exact)).astype(jnp.int32)
    large = jnp.minimum(large, REL_BUCKETS - 1)
    return jnp.where(n < max_exact, n, large)


def gmlp_spatial_gating(u, v, ln_g, ln_b, w_spatial, b_spatial):
    B, S, W = u.shape
    v = layernorm(v, ln_g, ln_b)
    n_chunks = S // GMLP_CHUNK
    vc = v.reshape(B, n_chunks, GMLP_CHUNK, GMLP_GROUPS, GMLP_GROUP_DIM)
    causal = jnp.tril(jnp.ones((GMLP_CHUNK, GMLP_CHUNK), dtype=bool))
    ws = jnp.where(causal[None], w_spatial, 0.0).astype(v.dtype)
    mixed = jnp.einsum('gts,bnsgc->bntgc', ws, vc)
    mixed = mixed + b_spatial.T.astype(v.dtype)[None, None, :, :, None]
    return u * mixed.reshape(B, S, W)


def moba_attention(q, k, v, rel_bias):
    B, H, S, Dh = q.shape
    nb = -(-S // MOBA_BLOCK)
    s_pad = nb * MOBA_BLOCK
    pad = ((0, 0), (0, 0), (0, s_pad - S), (0, 0))
    kb = jnp.pad(k, pad).reshape(B, H, nb, MOBA_BLOCK, Dh)
    vb = jnp.pad(v, pad).reshape(B, H, nb, MOBA_BLOCK, Dh)
    k_mean = jnp.mean(kb.astype(jnp.float32), axis=3)
    pos = jnp.arange(S, dtype=jnp.int32)
    q_blk = pos // MOBA_BLOCK
    gate = jnp.einsum('bhsd,bhnd->bhsn', q.astype(jnp.float32), k_mean)
    fully_past = jnp.arange(nb, dtype=jnp.int32)[None, :] < q_blk[:, None]
    gate = jnp.where(fully_past[None, None], gate, -jnp.inf)
    k_sel = min(MOBA_TOPK, nb)
    _, sel_idx = lax.top_k(gate, k_sel)
    sel_valid = jnp.arange(k_sel, dtype=jnp.int32)[None, :] < q_blk[:, None]
    sel_idx = jnp.where(sel_valid[None, None], sel_idx, 0)

    scale = HEAD_DIM ** -0.5
    offs = jnp.arange(MOBA_BLOCK, dtype=jnp.int32)
    b_ix = jnp.arange(B)[:, None, None, None]
    h_ix = jnp.arange(H)[None, :, None, None]
    h_ix5 = jnp.arange(H)[None, :, None, None, None]
    n_qc = S // MOBA_QCHUNK

    def one_chunk(c):
        q0 = c * MOBA_QCHUNK
        qc = lax.dynamic_slice_in_dim(q, q0, MOBA_QCHUNK, axis=2)
        idx = lax.dynamic_slice_in_dim(sel_idx, q0, MOBA_QCHUNK, axis=2)
        valid = lax.dynamic_slice_in_dim(sel_valid, q0, MOBA_QCHUNK, axis=0)
        qpos = q0 + jnp.arange(MOBA_QCHUNK, dtype=jnp.int32)
        k_past = kb[b_ix, h_ix, idx]
        v_past = vb[b_ix, h_ix, idx]
        s_past = jnp.einsum('bhqd,bhqkjd->bhqkj', qc, k_past).astype(jnp.float32) * scale
        kpos_past = idx[..., None] * MOBA_BLOCK + offs
        bucket_past = t5_bucket(qpos[None, None, :, None, None] - kpos_past)
        s_past = s_past + rel_bias[bucket_past, h_ix5].astype(jnp.float32)
        s_past = jnp.where(valid[None, None, :, :, None], s_past, -jnp.inf)
        blk = q0 // MOBA_BLOCK
        k_own = lax.dynamic_index_in_dim(kb, blk, axis=2, keepdims=False)
        v_own = lax.dynamic_index_in_dim(vb, blk, axis=2, keepdims=False)
        rel = qpos[:, None] - (blk * MOBA_BLOCK + offs)[None, :]
        bias_own = jnp.moveaxis(rel_bias[t5_bucket(rel)], -1, 0).astype(jnp.float32)
        s_own = jnp.einsum('bhqd,bhjd->bhqj', qc, k_own).astype(jnp.float32) * scale + bias_own[None]
        s_own = jnp.where((rel >= 0)[None, None], s_own, -jnp.inf)
        logits = jnp.concatenate([s_past.reshape(B, H, MOBA_QCHUNK, k_sel * MOBA_BLOCK), s_own], axis=-1)
        p = jax.nn.softmax(logits, axis=-1).astype(q.dtype)
        p_past = p[..., :k_sel * MOBA_BLOCK].reshape(B, H, MOBA_QCHUNK, k_sel, MOBA_BLOCK)
        p_own = p[..., k_sel * MOBA_BLOCK:]
        out = (jnp.einsum('bhqkj,bhqkjd->bhqd', p_past, v_past)
               + jnp.einsum('bhqj,bhjd->bhqd', p_own, v_own))
        return out.astype(q.dtype)

    outs = lax.map(one_chunk, jnp.arange(n_qc, dtype=jnp.int32))
    return jnp.transpose(outs, (1, 2, 0, 3, 4)).reshape(B, H, S, Dh)


def hierarchical_moe(xn, w_gr, b_gr, w_er, b_er, w1, w3, w2):
    B, S, D = xn.shape
    xt = xn.reshape(B * S, D)
    g_prob = jax.nn.softmax((xt @ w_gr + b_gr).astype(jnp.float32), axis=-1)
    g_w, g_idx = lax.top_k(g_prob, 1)
    e_logits = (jnp.einsum('td,gde->tge', xt, w_er) + b_er).astype(jnp.float32)
    e_logits = jnp.take_along_axis(e_logits, g_idx[:, :, None], axis=1)[:, 0]
    e_val, e_idx = lax.top_k(e_logits, TOPK_IN_GROUP)
    e_w = jax.nn.softmax(e_val, axis=-1) * g_w
    expert_id = g_idx * EXPERTS_PER_GROUP + e_idx
    combine = jnp.sum(jax.nn.one_hot(expert_id, N_EXPERTS, dtype=jnp.float32) * e_w[..., None],
                      axis=1).astype(xt.dtype)
    y = jnp.zeros_like(xt)
    for g in range(N_GROUPS):
        sl = slice(g * EXPERTS_PER_GROUP, (g + 1) * EXPERTS_PER_GROUP)
        a = jnp.einsum('td,edf->tef', xt, w1[sl])
        b = jnp.einsum('td,edf->tef', xt, w3[sl])
        hid = jax.nn.silu(a) * b * combine[:, sl, None]
        y = y + jnp.einsum('tef,efd->td', hid, w2[sl])
    return y.reshape(B, S, D)


def setup_inputs(seed: int = 0) -> dict:
    key = jax.random.key(seed)
    ks = jax.random.split(key, 20)
    L = DEPTH

    def nrm(k, shape, scale):
        return jax.random.normal(k, shape, jnp.float32) * scale

    return {
        "x": nrm(ks[0], (BATCH, SEQ, D_MODEL), 1.0),
        "norm_mix_g": 1.0 + nrm(ks[1], (L, D_MODEL), 0.02),
        "w_in": nrm(ks[2], (L, D_MODEL, IN_COLS), D_MODEL ** -0.5),
        "b_gates": nrm(ks[3], (L, 2 * D_MODEL), 0.1),
        "gmlp_ln_g": 1.0 + nrm(ks[4], (L, GMLP_WIDTH), 0.02),
        "gmlp_ln_b": nrm(ks[5], (L, GMLP_WIDTH), 0.02),
        "w_spatial": nrm(ks[6], (L, GMLP_GROUPS, GMLP_CHUNK, GMLP_CHUNK), GMLP_CHUNK ** -0.5),
        "b_spatial": 1.0 + nrm(ks[7], (L, GMLP_GROUPS, GMLP_CHUNK), 0.1),
        "rel_bias": nrm(ks[8], (REL_BUCKETS, ATT_HEADS), 0.5),
        "w_out": nrm(ks[9], (L, D_MODEL, D_MODEL), D_MODEL ** -0.5),
        "norm_ffn_g": 1.0 + nrm(ks[10], (L, D_MODEL), 0.02),
        "w_group_router": nrm(ks[11], (L, D_MODEL, N_GROUPS), D_MODEL ** -0.5),
        "b_group_router": nrm(ks[12], (L, N_GROUPS), 0.01),
        "w_expert_router": nrm(ks[13], (L, N_GROUPS, D_MODEL, EXPERTS_PER_GROUP), D_MODEL ** -0.5),
        "b_expert_router": nrm(ks[14], (L, N_GROUPS, EXPERTS_PER_GROUP), 0.01),
        "w1": nrm(ks[15], (L, N_EXPERTS, D_MODEL, D_EXPERT), D_MODEL ** -0.5),
        "w3": nrm(ks[16], (L, N_EXPERTS, D_MODEL, D_EXPERT), D_MODEL ** -0.5),
        "w2": nrm(ks[17], (L, N_EXPERTS, D_EXPERT, D_MODEL), D_EXPERT ** -0.5),
        "norm_final_g": 1.0 + nrm(ks[18], (D_MODEL,), 0.02),
    }


def reference(x, norm_mix_g, w_in, b_gates, gmlp_ln_g, gmlp_ln_b, w_spatial, b_spatial, rel_bias,
              w_out, norm_ffn_g, w_group_router, b_group_router, w_expert_router, b_expert_router,
              w1, w3, w2, norm_final_g):
    B, S, _ = x.shape
    split_at = [int(c) for c in np.cumsum(IN_SPLITS)[:-1]]
    h = x
    for l in range(DEPTH):
        xn = rmsnorm(h, norm_mix_g[l])
        proj = xn @ w_in[l]
        u, v_g, q, k, v_a, gate_a, gate_b = jnp.split(proj, split_at, axis=-1)
        y_a = gmlp_spatial_gating(jax.nn.gelu(u, approximate=False), jax.nn.gelu(v_g, approximate=False),
                                  gmlp_ln_g[l], gmlp_ln_b[l], w_spatial[l], b_spatial[l])
        heads = lambda t: jnp.transpose(t.reshape(B, S, ATT_HEADS, HEAD_DIM), (0, 2, 1, 3))
        y_b = moba_attention(heads(q), heads(k), heads(v_a), rel_bias)
        y_b = jnp.transpose(y_b, (0, 2, 1, 3)).reshape(B, S, ATT_WIDTH)
        gates = jax.nn.sigmoid(jnp.concatenate([gate_a, gate_b], axis=-1) + b_gates[l])
        g_a, g_b = gates[..., :D_MODEL], gates[..., D_MODEL:]
        h = h + (g_a * y_a + g_b * y_b) @ w_out[l]
        xn = rmsnorm(h, norm_ffn_g[l])
        h = h + hierarchical_moe(xn, w_group_router[l], b_group_router[l], w_expert_router[l],
                                 b_expert_router[l], w1[l], w3[l], w2[l])
    return rmsnorm(h, norm_final_g)
```

```cpp
#include <hip/hip_runtime.h>
#include <cstdio>
#include <cstdint>

#define LAS __attribute__((address_space(3)))
#define GAS __attribute__((address_space(1)))
typedef unsigned short bf16_t;
typedef short bf16x8 __attribute__((ext_vector_type(8)));
typedef short s16x4 __attribute__((ext_vector_type(4)));
typedef float f32x4 __attribute__((ext_vector_type(4)));
typedef float f32x2 __attribute__((ext_vector_type(2)));
typedef float f32x16 __attribute__((ext_vector_type(16)));
typedef unsigned u32x4 __attribute__((ext_vector_type(4)));
typedef unsigned u32x2 __attribute__((ext_vector_type(2)));

constexpr int T = 16384, D = 1024, NCOL = 7168, SEQ = 4096, NBATCH = 4, NH = 8, HD = 128;
constexpr int NEXP = 32, DEXP = 256, LCAP = 16384;
constexpr float NORM_EPS = 1e-6f;
constexpr float LOG2E = 1.4426950408889634f;
constexpr int NWAVES = 8, NTHREADS = 512;

constexpr size_t MiB = 1u << 20;
constexpr size_t WS_CTL = 0, CTL_ZERO_BYTES = 1 * MiB;
constexpr size_t WS_WIN = 1 * MiB;
constexpr size_t WS_WIN8 = 7 * MiB;
constexpr size_t WS_XN8 = 212 * MiB;
constexpr size_t WS_WOUT = 15 * MiB;
constexpr size_t WS_WSB = 17 * MiB;
constexpr size_t WS_KPART = 17 * MiB + 256 * 1024;
constexpr size_t WS_RW = 17 * MiB + 768 * 1024;
constexpr size_t WS_STAT = 18 * MiB;
constexpr size_t WS_U = 20 * MiB;
constexpr size_t SEG_BYTES = 32 * MiB;
constexpr size_t WS_VG = WS_U + SEG_BYTES, WS_Q = WS_U + 2 * SEG_BYTES, WS_K = WS_U + 3 * SEG_BYTES, WS_VA = WS_U + 4 * SEG_BYTES, WS_GB = WS_U + 5 * SEG_BYTES;
constexpr size_t WS_XN2 = 52 * MiB;
constexpr size_t WS_W13 = 84 * MiB;
constexpr size_t WS_W2 = 116 * MiB;
constexpr size_t WS_HID = 132 * MiB;
constexpr size_t WS_YP = 152 * MiB;
constexpr size_t WS_LIST = 232 * MiB;
constexpr size_t WS_INV = 234 * MiB;
constexpr size_t WS_WTOK = 235 * MiB;
constexpr size_t WS_RSP = 236 * MiB;
constexpr size_t WS_HB = 192 * MiB;
constexpr size_t WS_END = 238 * MiB;
constexpr int CW_BAR = 4096;
constexpr int CW_CNT = 8192;

constexpr int RING_BYTES = 131072;
constexpr int MISC_OFF = RING_BYTES;
constexpr int PREF_OFF = MISC_OFF + 64;
constexpr int LDS_BYTES = 147456;

typedef __bf16 bf16x2_t __attribute__((ext_vector_type(2)));
__device__ __forceinline__ unsigned cvt_pk_bf16(float lo, float hi) { const f32x2 v = {lo, hi}; const bf16x2_t b = __builtin_convertvector(v, bf16x2_t); return __builtin_bit_cast(unsigned, b); }
__device__ __forceinline__ unsigned cvt_pk4_fp8(float a, float b, float c, float d) { unsigned w = 0u; w = (unsigned)__builtin_amdgcn_cvt_pk_fp8_f32(a, b, (int)w, false); w = (unsigned)__builtin_amdgcn_cvt_pk_fp8_f32(c, d, (int)w, true); return w; }
__device__ __forceinline__ float bf_lo(unsigned w) { return __uint_as_float(w << 16); }
__device__ __forceinline__ float bf_hi(unsigned w) { return __uint_as_float(w & 0xffff0000u); }
__device__ __forceinline__ float wave_sum(float v) {
#pragma unroll
    for (int o = 1; o < 64; o <<= 1) v += __shfl_xor(v, o);
    return v;
}
#define LDS_WAIT() asm volatile("s_waitcnt lgkmcnt(0)" ::: "memory")
#define VM_WAIT() asm volatile("s_waitcnt vmcnt(0)" ::: "memory")

#define XB_TMO      128
#define XB_XCNT(j)  (256  + 64 * (j))
#define XB_XSUB(j)  (1280 + 64 * (j))
#define XB_XGEN(j)  (2304 + 64 * (j))
#define XB_TOP      3328
#define XB_TOPGEN   3392
#define XCD_BAR_WORDS 3456
#define XB_SPIN_CAP (1u << 18)
__device__ __forceinline__ unsigned xb_ld(unsigned* p)              { return __hip_atomic_load(p, __ATOMIC_RELAXED, __HIP_MEMORY_SCOPE_AGENT); }
__device__ __forceinline__ unsigned xb_add(unsigned* p, unsigned v) { return __hip_atomic_fetch_add(p, v, __ATOMIC_RELAXED, __HIP_MEMORY_SCOPE_AGENT); }
__device__ __forceinline__ unsigned xb_xcc_id() { return (unsigned)__builtin_amdgcn_s_getreg((3 << 11) | 20) & 0xFu; }
#define XB_SPIN(cond, bar) do { unsigned _sp = 0; while (cond) { __builtin_amdgcn_s_sleep(1); \
    if ((++_sp & 255u) == 0u) { if (xb_ld(&(bar)[XB_TMO])) break; if (_sp > XB_SPIN_CAP) { atomicAdd(&(bar)[XB_TMO], 1u); break; } } } } while (0)
struct XcdBarrier { unsigned* bar; unsigned x; volatile LAS unsigned* st; };
__device__ __forceinline__ XcdBarrier xcd_barrier_post(unsigned* bar, volatile LAS unsigned* st) {
    XcdBarrier b; b.bar = bar; b.x = xb_xcc_id(); b.st = st;
    if (threadIdx.x == 0) (void)xb_add(&bar[XB_XCNT(b.x)], 1u);
    return b;
}
__device__ __forceinline__ void xcd_barrier_complete(unsigned* bar, unsigned x, unsigned& nloc, unsigned& nx) {
    const unsigned G = gridDim.x * gridDim.y * gridDim.z;
    unsigned sum, cnt, mine, sp = 0u;
    for (;;) {
        sum = 0u; cnt = 0u; mine = 0u;
#pragma unroll
        for (unsigned j = 0; j < 16; ++j) { const unsigned c = xb_ld(&bar[XB_XCNT(j)]); sum += c; cnt += (c > 0u) ? 1u : 0u; mine = (j == x) ? c : mine; }
        if (sum == G) break;
        __builtin_amdgcn_s_sleep(1);
        if ((++sp & 255u) == 0u) { if (xb_ld(&bar[XB_TMO])) break; if (sp > XB_SPIN_CAP) { atomicAdd(&bar[XB_TMO], 1u); break; } }
    }
    nloc = mine > 0u ? mine : 1u; nx = cnt > 0u ? cnt : 1u;
}
__device__ __forceinline__ void xcd_barrier(const XcdBarrier& b) {
    asm volatile("s_waitcnt vmcnt(0)" ::: "memory");
    __syncthreads();
    if (threadIdx.x == 0) {
        unsigned* bar = b.bar;
        __builtin_amdgcn_s_waitcnt(0);
        unsigned nloc = b.st[0], nx = b.st[1];
        if (nloc == 0u) { xcd_barrier_complete(bar, b.x, nloc, nx); b.st[0] = nloc; b.st[1] = nx; }
        const unsigned old = xb_add(&bar[XB_XSUB(b.x)], 1u);
        const unsigned gen = old / nloc;
        if (old + 1u == (gen + 1u) * nloc) {
            __builtin_amdgcn_fence(__ATOMIC_RELEASE, "agent");
            asm volatile("s_waitcnt vmcnt(0)" ::: "memory");
            const unsigned og = xb_add(&bar[XB_TOP], 1u);
            const unsigned tg = og / nx;
            if (og + 1u == (tg + 1u) * nx) xb_add(&bar[XB_TOPGEN], 1u);
            else XB_SPIN(xb_ld(&bar[XB_TOPGEN]) == tg, bar);
            __builtin_amdgcn_fence(__ATOMIC_ACQUIRE, "agent");
            xb_add(&bar[XB_XGEN(b.x)], 1u);
            asm volatile("s_waitcnt vmcnt(0)" ::: "memory");
        } else {
            XB_SPIN(xb_ld(&bar[XB_XGEN(b.x)]) == gen, bar);
            __builtin_amdgcn_fence(__ATOMIC_ACQUIRE, "agent");
            asm volatile("s_waitcnt vmcnt(0)" ::: "memory");
        }
    }
    __syncthreads();
}

namespace pg8 {
constexpr int BM = 256, BK = 64, HALF = 128, HTB = HALF * BK * 2, STAGE_BYTES = 8 * HTB, NXCD = 8, WGM = 8;
__host__ __device__ __forceinline__ int lds_byte(int r, int c) { const int st = (r >> 4) * 2 + (c >> 5), rr = r & 15, cc = c & 31, ob = rr * 64 + cc * 2; return st * 1024 + (ob ^ (((ob >> 9) & 1) << 5)); }
__host__ __device__ __forceinline__ void stage_rc(int b, int& R, int& C) { const int st = b / 1024, sb = b % 1024, swz = sb ^ (((sb >> 9) & 1) << 5); R = (st >> 1) * 16 + swz / 64; C = (st & 1) * 32 + (swz % 64) / 2; }
__host__ __device__ __forceinline__ int perm32(int rho) { const int n = rho >> 4, i = rho & 15; return 8 * (i >> 2) + 4 * n + (i & 3); }

struct Unit { int pm, pn, ex, rt; };

struct StaticOrder {
    int nM, nN, nwg, G, c; const char* A; const char* Bt; size_t tstep;
    __device__ void init(const bf16_t* A_, const bf16_t* Bt_, int M, int N, int K, int G_, int c_) { nM = M / BM; nN = N / BM; nwg = nM * nN; G = G_; c = c_; A = (const char*)A_; Bt = (const char*)Bt_; tstep = (size_t)BM * K * 2; }
    __device__ bool next(int i, Unit& u) const {
        const long L = (long)i * G + c; if (L >= nwg) return false;
        int wgid = (int)L; { const int q = nwg / NXCD, r = nwg % NXCD, xcd = wgid % NXCD, off = wgid / NXCD; wgid = (xcd < r ? xcd * (q + 1) : r * (q + 1) + (xcd - r) * q) + off; }
        const int nig = WGM * nN, gid = wgid / nig, fm = gid * WGM, gsz = (nM - fm) < WGM ? (nM - fm) : WGM;
        u.pm = fm + ((wgid % nig) % gsz); u.pn = (wgid % nig) / gsz; u.ex = 0; u.rt = 0; return true;
    }
    __device__ __forceinline__ const char* abase(const Unit& u) const { return A + (size_t)u.pm * tstep; }
    __device__ __forceinline__ const char* bbase(const Unit& u) const { return Bt + (size_t)u.pn * tstep; }
    __device__ __forceinline__ unsigned arow_off(const Unit&, int) const { return 0u; }
};
template <int npn, size_t a_tstep, size_t b_estep, size_t b_tstep, unsigned rowbytes>
struct MoeOrder {
    const LAS int* pref; int c; const char* A; const char* Bt; const int* list;
    int first, limit, cbase, nwg;
    __device__ bool next(int i, Unit& u) const {
        if (c < cbase || c >= cbase + nwg) return false;
        const long L = (long)first + (long)i * nwg + (c - cbase);
        if (L >= (long)limit) return false;
        const int tl = (int)(L / npn); u.pn = (int)(L % npn); u.pm = tl;
        const int ln = (int)__builtin_amdgcn_mbcnt_hi(~0u, __builtin_amdgcn_mbcnt_lo(~0u, 0u));
        const int mine = pref[ln & 31];
        const unsigned long long m = __ballot(ln >= 1 && ln < NEXP && mine <= tl);
        const int e = __builtin_popcountll(m);
        u.ex = e; u.rt = tl - __builtin_amdgcn_readlane(mine, e); return true;
    }
    __device__ __forceinline__ const char* abase(const Unit& u) const { return A + (size_t)u.pm * a_tstep; }
    __device__ __forceinline__ const char* bbase(const Unit& u) const { return Bt + (size_t)u.ex * b_estep + (size_t)u.pn * b_tstep; }
    __device__ __forceinline__ unsigned arow_off(const Unit& u, int r, int cnt_e) const {
        int p = u.rt * 256 + r; p = p < cnt_e ? p : 0;
        const int ent = list[u.ex * LCAP + p];
        return (unsigned)(ent >> 1) * rowbytes;
    }
};

typedef float f32x2v __attribute__((ext_vector_type(2)));
typedef int i32x4_t __attribute__((ext_vector_type(4)));
typedef int i32x8_t __attribute__((ext_vector_type(8)));
__device__ __forceinline__ f32x2v gelu_pk(f32x2v v) {
    const f32x2v av = __builtin_elementwise_abs(v), d = av * 0.2316418882f + 1.0f;
    f32x2v t; t.x = __builtin_amdgcn_rcpf(d.x); t.y = __builtin_amdgcn_rcpf(d.y);
    f32x2v q = t * 0.5307027145f + (-0.7265760135f); q = q * t + 0.7107068705f; q = q * t + (-0.142248368f); q = q * t + 0.127414796f; q = q * t;
    const f32x2v s = (v * v) * (-0.72134752044f);
    f32x2v e; e.x = __builtin_amdgcn_exp2f(s.x); e.y = __builtin_amdgcn_exp2f(s.y);
    const f32x2v m = v * (q * e), r = v - m;
    f32x2v o; o.x = v.x < 0.f ? m.x : r.x; o.y = v.y < 0.f ? m.y : r.y; return o;
}

template <class Epi, class Sched, bool GATHER, int K, int WSCALE = 0>
__device__ __forceinline__ void gemm_phase(LAS unsigned char* lds, const int tid, const Sched& S, const Epi& E, const unsigned* cnts) {
    const int wid = __builtin_amdgcn_readfirstlane(tid >> 6), lane = tid & 63, wr = wid >> 2, wc = wid & 3, fr = lane & 15, fq = lane >> 4;
    const int nt = K / BK;
    unsigned voffA[2], voffB[2]; int stR[2];
#pragma unroll
    for (int i = 0; i < 2; ++i) { int R, C; stage_rc(tid * 16 + i * 8192, R, C); const int Rb = Epi::PERM ? ((R & ~31) + perm32(R & 31)) : R;
        voffA[i] = GATHER ? (unsigned)(C * 2) : (unsigned)(R * K + C) * 2u; voffB[i] = (unsigned)(Rb * K + C) * 2u; stR[i] = R; }
    const size_t kstep = (size_t)(BK * 2);
    const size_t hstep = (size_t)HALF * K * 2;
    const unsigned ldsw = (unsigned)wid * 1024u;
    const int aoff = lds_byte(wr * 64 + fr, fq * 8), boff = lds_byte(wc * 32 + fr, fq * 8);
#define PG8_SA(b, h) (((b) * 2 + (h)) * HTB)
#define PG8_SB(b, h) ((4 + (b) * 2 + (h)) * HTB)
#define PG8_GLDS(gp, bufoff, i) __builtin_amdgcn_global_load_lds((const unsigned*)(gp), (LAS unsigned*)(lds + (bufoff) + ldsw + (i) * 8192), 16, 0, 0)
#define PG8_STAGE(bufoff, gbase, voff) do { _Pragma("unroll") for (int _i = 0; _i < 2; ++_i) PG8_GLDS((const char*)(gbase) + (voff)[_i], bufoff, _i); } while (0)
#define PG8_STAGE_A(bufoff, H, NX, KO) do { _Pragma("unroll") for (int _i = 0; _i < 2; ++_i) { \
        if constexpr (GATHER) { const unsigned _o = (NX) ? offN[H][_i] : offC[H][_i]; PG8_GLDS(gA + _o + voffA[_i] + (KO), bufoff, _i); } \
        else { PG8_GLDS(((NX) ? nA : cA) + (H) * hstep + voffA[_i] + (KO), bufoff, _i); } } } while (0)
#define PG8_LDA(dst, b, h) do { _Pragma("unroll") for (int m = 0; m < 4; ++m) { dst[m].lo = *(const LAS i32x4_t*)(lds + PG8_SA(b, h) + aoff + m * 2048); dst[m].hi = *(const LAS i32x4_t*)(lds + PG8_SA(b, h) + aoff + m * 2048 + 1024); } } while (0)
#define PG8_LDB(dst, b, h) do { _Pragma("unroll") for (int n = 0; n < 2; ++n) { dst[n].lo = *(const LAS i32x4_t*)(lds + PG8_SB(b, h) + boff + n * 2048); dst[n].hi = *(const LAS i32x4_t*)(lds + PG8_SB(b, h) + boff + n * 2048 + 1024); } } while (0)
#define PG8_MMA(ai, bj, At, Bt) do { __builtin_amdgcn_s_setprio(1); if constexpr (WSCALE != 0) asm volatile("s_nop 3" ::: "memory");     \
        _Pragma("unroll") for (int m = 0; m < 4; ++m) _Pragma("unroll") for (int n = 0; n < 2; ++n) { \
        if constexpr (WSCALE != 0) { asm volatile("v_mfma_scale_f32_16x16x128_f8f6f4 %0, %1, %2, %0, %3, %4 op_sel_hi:[0,0,0]" : "+v"(acc[ai][bj][m][n]) : "v"(Bt[n]), "v"(At[m]), "v"(wscale_v), "v"(ascale_v)); } \
        else { const i32x4_t bl_ = Bt[n].lo, bh_ = Bt[n].hi, al_ = At[m].lo, ah_ = At[m].hi;     \
               acc[ai][bj][m][n] = __builtin_amdgcn_mfma_f32_16x16x32_bf16(__builtin_bit_cast(bf16x8, bl_), __builtin_bit_cast(bf16x8, al_), acc[ai][bj][m][n], 0, 0, 0); \
               acc[ai][bj][m][n] = __builtin_amdgcn_mfma_f32_16x16x32_bf16(__builtin_bit_cast(bf16x8, bh_), __builtin_bit_cast(bf16x8, ah_), acc[ai][bj][m][n], 0, 0, 0); } } \
        __builtin_amdgcn_s_setprio(0); } while (0)
#define PG8_WAIT_V(n) asm volatile("s_waitcnt vmcnt(" #n ")" ::: "memory")
#define PG8_WAIT_L(n) asm volatile("s_waitcnt lgkmcnt(" #n ")" ::: "memory")
#define PG8_BAR __builtin_amdgcn_s_barrier()
#define PG8_SCHED __builtin_amdgcn_sched_barrier(0)
    Unit cur, nxt; int ui = 0;
    if (!S.next(0, cur)) return;
    f32x4 acc[2][2][4][2];
#pragma unroll
    for (int a = 0; a < 2; ++a)
#pragma unroll
        for (int b = 0; b < 2; ++b)
#pragma unroll
            for (int m = 0; m < 4; ++m)
#pragma unroll
                for (int n = 0; n < 2; ++n) acc[a][b][m][n] = (f32x4){0.f, 0.f, 0.f, 0.f};
    i32x8_t At[4], B0[2], B1[2];
    const int wscale_v = WSCALE * 0x01010101, ascale_v = 0x7f7f7f7f;
    const char* gA = S.A;
    const char* cA = S.abase(cur); const char* cB = S.bbase(cur);
    const char* nA = cA;
    unsigned offC[2][2], offN[2][2];
    if constexpr (GATHER) {
        const int ce = __builtin_amdgcn_readfirstlane((int)cnts[64 * cur.ex]);
#pragma unroll
        for (int h = 0; h < 2; ++h)
#pragma unroll
            for (int i = 0; i < 2; ++i) { offC[h][i] = S.arow_off(cur, stR[i] + h * HALF, ce); offN[h][i] = offC[h][i]; }
    } else {
#pragma unroll
        for (int h = 0; h < 2; ++h)
#pragma unroll
            for (int i = 0; i < 2; ++i) { offC[h][i] = 0u; offN[h][i] = 0u; }
    }
    PG8_STAGE(PG8_SB(0, 0), cB, voffB); PG8_STAGE(PG8_SB(0, 1), cB + hstep, voffB); PG8_STAGE_A(PG8_SA(0, 0), 0, false, 0); PG8_STAGE_A(PG8_SA(0, 1), 1, false, 0);
    if (wr == 1) PG8_BAR;
    PG8_WAIT_V(2); PG8_BAR;
    PG8_STAGE(PG8_SB(1, 0), cB + kstep, voffB); PG8_STAGE_A(PG8_SA(1, 0), 0, false, kstep); PG8_STAGE(PG8_SB(1, 1), cB + hstep + kstep, voffB);
    PG8_WAIT_V(6); PG8_BAR;
    for (;;) {
        const bool has_next = S.next(ui + 1, nxt);
        nA = has_next ? S.abase(nxt) : cA; const char* nB = has_next ? S.bbase(nxt) : cB;
        if constexpr (GATHER) {
            if (has_next) { const int ce = __builtin_amdgcn_readfirstlane((int)cnts[64 * nxt.ex]);
#pragma unroll
                for (int h = 0; h < 2; ++h)
#pragma unroll
                    for (int i = 0; i < 2; ++i) offN[h][i] = S.arow_off(nxt, stR[i] + h * HALF, ce);
            } else {
#pragma unroll
                for (int h = 0; h < 2; ++h)
#pragma unroll
                    for (int i = 0; i < 2; ++i) offN[h][i] = offC[h][i];
            }
        }
#pragma unroll 1
        for (int t = 0; t < nt; t += 2) {
            const bool last = (t == nt - 2);
            const size_t k1 = (size_t)(t + 1) * kstep;
            const size_t k2 = last ? 0 : (size_t)(t + 2) * kstep, k3 = k2 + kstep;
            const char* b2 = last ? nB : cB + (size_t)(t + 2) * kstep; const char* b3 = b2 + kstep;
            PG8_LDB(B0, 0, 0); PG8_LDB(B1, 0, 1); PG8_SCHED; PG8_LDA(At, 0, 0); PG8_STAGE_A(PG8_SA(1, 1), 1, false, k1);
            PG8_WAIT_V(8); PG8_WAIT_L(0); PG8_BAR; PG8_MMA(0, 0, At, B0); PG8_MMA(0, 1, At, B1); PG8_BAR; PG8_SCHED;
            PG8_LDA(At, 0, 1); PG8_STAGE(PG8_SB(0, 0), b2, voffB); PG8_STAGE(PG8_SB(0, 1), b2 + hstep, voffB); PG8_STAGE_A(PG8_SA(0, 0), 0, last, k2);
            PG8_WAIT_V(8); PG8_WAIT_L(0); PG8_BAR; PG8_MMA(1, 0, At, B0); PG8_MMA(1, 1, At, B1); PG8_BAR; PG8_SCHED;
            PG8_LDB(B0, 1, 0); PG8_LDB(B1, 1, 1); PG8_SCHED; PG8_LDA(At, 1, 0); PG8_STAGE_A(PG8_SA(0, 1), 1, last, k2);
            PG8_WAIT_V(8); PG8_WAIT_L(0); PG8_BAR; PG8_MMA(0, 0, At, B0); PG8_MMA(0, 1, At, B1); PG8_BAR; PG8_SCHED;
            PG8_LDA(At, 1, 1); PG8_STAGE(PG8_SB(1, 0), b3, voffB); PG8_STAGE(PG8_SB(1, 1), b3 + hstep, voffB); PG8_STAGE_A(PG8_SA(1, 0), 0, last, k3);
            PG8_WAIT_V(8); PG8_WAIT_L(0); PG8_BAR; PG8_MMA(1, 0, At, B0); PG8_MMA(1, 1, At, B1); PG8_BAR; PG8_SCHED;
        }
        if (wr == 0) PG8_BAR;
        if constexpr (WSCALE != 0) asm volatile("s_nop 15\n\ts_nop 7" ::: "memory");
        E(acc, cur, wr, wc, fr, fq);
        if (!has_next) break;
#pragma unroll
        for (int a = 0; a < 2; ++a)
#pragma unroll
            for (int b = 0; b < 2; ++b)
#pragma unroll
                for (int m = 0; m < 4; ++m)
#pragma unroll
                    for (int n = 0; n < 2; ++n) acc[a][b][m][n] = (f32x4){0.f, 0.f, 0.f, 0.f};
        cur = nxt; cA = nA; cB = nB; ++ui;
#pragma unroll
        for (int h = 0; h < 2; ++h)
#pragma unroll
            for (int i = 0; i < 2; ++i) offC[h][i] = offN[h][i];
        if (wr == 1) PG8_BAR;
    }
    PG8_WAIT_V(0);
    PG8_BAR;
#undef PG8_SA
#undef PG8_SB
#undef PG8_GLDS
#undef PG8_STAGE
#undef PG8_STAGE_A
#undef PG8_LDA
#undef PG8_LDB
#undef PG8_MMA
#undef PG8_WAIT_V
#undef PG8_WAIT_L
#undef PG8_BAR
#undef PG8_SCHED
}
}

struct EpiInProj {
    static constexpr bool PERM = true;
    bf16_t* seg0; const float* b_gates; float* kpart; f32x2* stats; int pn_off;
    __device__ __forceinline__ void operator()(const f32x4 (&acc)[2][2][4][2], const pg8::Unit& u_, int wr, int wc, int fr, int fq) const {
        pg8::Unit u = u_; u.pn += pn_off;
        const int row0 = u.pm * 256 + wr * 64 + fr;
        if (u.pn < 8) {
            const int ch0 = 128 * u.pn + 16 * wc + 4 * fq;
            f32x4 bv[2];
#pragma unroll
            for (int bj = 0; bj < 2; ++bj) bv[bj] = *(const f32x4*)(b_gates + ch0 + 64 * bj);
#pragma unroll
            for (int ai = 0; ai < 2; ++ai)
#pragma unroll
                for (int m = 0; m < 4; ++m) { bf16_t* rowp = seg0 + (size_t)(row0 + ai * 128 + m * 16) * D + ch0;
#pragma unroll
                    for (int bj = 0; bj < 2; ++bj) { const f32x4 uu = acc[ai][bj][m][0], gg = acc[ai][bj][m][1] + bv[bj];
                        const pg8::f32x2v a = pg8::gelu_pk((pg8::f32x2v){uu[0], uu[1]}), b = pg8::gelu_pk((pg8::f32x2v){uu[2], uu[3]});
                        float sg[4];
#pragma unroll
                        for (int j = 0; j < 4; ++j) sg[j] = __builtin_amdgcn_rcpf(1.0f + __builtin_amdgcn_exp2f(-LOG2E * gg[j]));
                        u32x2 w; w.x = cvt_pk_bf16(a.x * sg[0], a.y * sg[1]); w.y = cvt_pk_bf16(b.x * sg[2], b.y * sg[3]);
                        *(u32x2*)(rowp + 64 * bj) = w; } }
            return;
        }
        const int seg = (u.pn >> 2) - 1;
        const int colt = (u.pn & 3) * 256, col0 = colt + wc * 32 + 8 * fq;
        bf16_t* base = seg0 + (size_t)seg * (SEG_BYTES / 2);
        if (seg == 1) {
#pragma unroll
            for (int ai = 0; ai < 2; ++ai)
#pragma unroll
                for (int m = 0; m < 4; ++m) { bf16_t* rowp = base + (size_t)(row0 + ai * 128 + m * 16) * D + col0; float s1 = 0.f, s2 = 0.f;
#pragma unroll
                    for (int bj = 0; bj < 2; ++bj) { const f32x4 v0 = acc[ai][bj][m][0], v1 = acc[ai][bj][m][1];
                        const pg8::f32x2v a = pg8::gelu_pk((pg8::f32x2v){v0[0], v0[1]}), b = pg8::gelu_pk((pg8::f32x2v){v0[2], v0[3]}), c = pg8::gelu_pk((pg8::f32x2v){v1[0], v1[1]}), d = pg8::gelu_pk((pg8::f32x2v){v1[2], v1[3]});
                        s1 += ((a.x + a.y) + (b.x + b.y)) + ((c.x + c.y) + (d.x + d.y));
                        s2 += ((a.x * a.x + a.y * a.y) + (b.x * b.x + b.y * b.y)) + ((c.x * c.x + c.y * c.y) + (d.x * d.x + d.y * d.y));
                        u32x4 w; w.x = cvt_pk_bf16(a.x, a.y); w.y = cvt_pk_bf16(b.x, b.y); w.z = cvt_pk_bf16(c.x, c.y); w.w = cvt_pk_bf16(d.x, d.y);
                        *(u32x4*)(rowp + bj * 128) = w; }
                    s1 += __shfl_xor(s1, 16); s1 += __shfl_xor(s1, 32); s2 += __shfl_xor(s2, 16); s2 += __shfl_xor(s2, 32);
                    if (fq == 0) stats[(size_t)(row0 + ai * 128 + m * 16) * 16 + (u.pn & 3) * 4 + wc] = (f32x2){s1, s2}; }
        } else if (seg == 5) {
            const float* bp = b_gates + D + col0;
            f32x4 bv[2][2];
#pragma unroll
            for (int bj = 0; bj < 2; ++bj)
#pragma unroll
                for (int n = 0; n < 2; ++n) bv[bj][n] = *(const f32x4*)(bp + bj * 128 + 4 * n);
#pragma unroll
            for (int ai = 0; ai < 2; ++ai)
#pragma unroll
                for (int m = 0; m < 4; ++m) { bf16_t* rowp = base + (size_t)(row0 + ai * 128 + m * 16) * D + col0;
#pragma unroll
                    for (int bj = 0; bj < 2; ++bj) { f32x4 v0 = acc[ai][bj][m][0] + bv[bj][0], v1 = acc[ai][bj][m][1] + bv[bj][1];
#pragma unroll
                        for (int j = 0; j < 4; ++j) { v0[j] = __builtin_amdgcn_rcpf(1.0f + __builtin_amdgcn_exp2f(-LOG2E * v0[j])); v1[j] = __builtin_amdgcn_rcpf(1.0f + __builtin_amdgcn_exp2f(-LOG2E * v1[j])); }
                        u32x2 w; w.x = cvt_pk4_fp8(v0[0], v0[1], v0[2], v0[3]); w.y = cvt_pk4_fp8(v1[0], v1[1], v1[2], v1[3]);
                        *(u32x2*)((unsigned char*)base + (size_t)(row0 + ai * 128 + m * 16) * D + col0 + bj * 128) = w; } }
        } else if (seg == 4) {
            unsigned char* vt = (unsigned char*)base;
            const int pw = 4 * (8 * ((fr >> 2) & 1) + 4 * (fr >> 3) + (fr & 3));
#pragma unroll
            for (int ai = 0; ai < 2; ++ai)
#pragma unroll
                for (int bj = 0; bj < 2; ++bj) {
                    unsigned char* tb = vt + ((size_t)(((u.pm >> 4) * 8 + 2 * (u.pn & 3) + bj) * 64 + 4 * (u.pm & 15) + 2 * ai + wr) * 128 + 32 * wc + 8 * fq) * 64 + pw;
#pragma unroll
                    for (int n = 0; n < 2; ++n)
#pragma unroll
                        for (int i = 0; i < 4; ++i) *(unsigned*)(tb + (4 * n + i) * 64) = cvt_pk4_fp8(acc[ai][bj][0][n][i], acc[ai][bj][1][n][i], acc[ai][bj][2][n][i], acc[ai][bj][3][n][i]); }
        } else {
            if (seg == 3) {
#pragma unroll
                for (int ai = 0; ai < 2; ++ai)
#pragma unroll
                    for (int m = 0; m < 4; ++m)
#pragma unroll
                        for (int bj = 0; bj < 2; ++bj) { const f32x4 v0 = acc[ai][bj][m][0], v1 = acc[ai][bj][m][1];
                            u32x2 w; w.x = cvt_pk4_fp8(v0[0], v0[1], v0[2], v0[3]); w.y = cvt_pk4_fp8(v1[0], v1[1], v1[2], v1[3]);
                            *(u32x2*)((unsigned char*)base + (size_t)(row0 + ai * 128 + m * 16) * D + col0 + bj * 128) = w; }
            } else {
#pragma unroll
            for (int ai = 0; ai < 2; ++ai)
#pragma unroll
                for (int m = 0; m < 4; ++m) { bf16_t* rowp = base + (size_t)(row0 + ai * 128 + m * 16) * D + col0;
#pragma unroll
                    for (int bj = 0; bj < 2; ++bj) { const f32x4 v0 = acc[ai][bj][m][0], v1 = acc[ai][bj][m][1];
                        u32x4 w; w.x = cvt_pk_bf16(v0[0], v0[1]); w.y = cvt_pk_bf16(v0[2], v0[3]); w.z = cvt_pk_bf16(v1[0], v1[1]); w.w = cvt_pk_bf16(v1[2], v1[3]);
                        *(u32x4*)(rowp + bj * 128) = w; } }
            }
            if (seg == 3) {
#pragma unroll
                for (int bj = 0; bj < 2; ++bj)
#pragma unroll
                    for (int n = 0; n < 2; ++n) { f32x4 s = (f32x4){0.f, 0.f, 0.f, 0.f};
#pragma unroll
                        for (int ai = 0; ai < 2; ++ai)
#pragma unroll
                            for (int m = 0; m < 4; ++m) s += acc[ai][bj][m][n];
#pragma unroll
                        for (int o = 1; o < 16; o <<= 1) { s[0] += __shfl_xor(s[0], o); s[1] += __shfl_xor(s[1], o); s[2] += __shfl_xor(s[2], o); s[3] += __shfl_xor(s[3], o); }
                        if (fr == 0) *(f32x4*)(kpart + ((size_t)u.pm * 2 + wr) * D + col0 + bj * 128 + 4 * n) = s; }
            }
        }
    }
};
struct EpiOutProj {
    static constexpr bool PERM = true;
    const float* x; bf16_t* hb;
    __device__ __forceinline__ void operator()(const f32x4 (&acc)[2][2][4][2], const pg8::Unit& u, int wr, int wc, int fr, int fq) const {
        const int row0 = u.pm * 256 + wr * 64 + fr, col0 = u.pn * 256 + wc * 32 + 8 * fq;
#pragma unroll
        for (int ai = 0; ai < 2; ++ai)
#pragma unroll
            for (int m = 0; m < 4; ++m) { const size_t off = (size_t)(row0 + ai * 128 + m * 16) * D + col0;
#pragma unroll
                for (int bj = 0; bj < 2; ++bj) { const f32x4 h0 = *(const f32x4*)(x + off + bj * 128) + acc[ai][bj][m][0], h1 = *(const f32x4*)(x + off + bj * 128 + 4) + acc[ai][bj][m][1];
                    u32x4 w; w.x = cvt_pk_bf16(h0[0], h0[1]); w.y = cvt_pk_bf16(h0[2], h0[3]); w.z = cvt_pk_bf16(h1[0], h1[1]); w.w = cvt_pk_bf16(h1[2], h1[3]);
                    *(u32x4*)(hb + off + bj * 128) = w; } }
    }
};
struct EpiMoe1 {
    static constexpr bool PERM = true;
    unsigned char* hid;
    const float* rsp; const unsigned* cnt;
    __device__ __forceinline__ void operator()(const f32x4 (&acc)[2][2][4][2], const pg8::Unit& u, int wr, int wc, int fr, int fq) const {
        const int hc0 = 128 * u.pn + 16 * wc + 4 * fq;
        const int ce = __builtin_amdgcn_readfirstlane((int)cnt[64 * u.ex]);
        float rsv[2][4];
#pragma unroll
        for (int ai = 0; ai < 2; ++ai)
#pragma unroll
            for (int m = 0; m < 4; ++m) { const int p = u.rt * 256 + ai * 128 + wr * 64 + m * 16 + fr; rsv[ai][m] = p < ce ? rsp[u.ex * LCAP + p] : 0.f; }
#pragma unroll
        for (int ai = 0; ai < 2; ++ai)
#pragma unroll
            for (int m = 0; m < 4; ++m) { const int r = ai * 128 + wr * 64 + m * 16 + fr; const float rs = rsv[ai][m];
                unsigned char* rowp = hid + (size_t)(u.pm * 256 + r) * DEXP + hc0;
#pragma unroll
                for (int bj = 0; bj < 2; ++bj) { const f32x4 a = acc[ai][bj][m][0] * rs, b = acc[ai][bj][m][1] * rs; f32x4 o;
#pragma unroll
                    for (int j = 0; j < 4; ++j) { const float sg = __builtin_amdgcn_rcpf(1.0f + __builtin_amdgcn_exp2f(-LOG2E * a[j])); o[j] = a[j] * sg * b[j]; }
                    *(unsigned*)(rowp + bj * 64) = cvt_pk4_fp8(o[0], o[1], o[2], o[3]); } }
    }
};
struct EpiMoe2 {
    static constexpr bool PERM = true;
    unsigned char* yp;
    __device__ __forceinline__ void operator()(const f32x4 (&acc)[2][2][4][2], const pg8::Unit& u, int wr, int wc, int fr, int fq) const {
        const int row0 = u.pm * 256 + wr * 64 + fr, col0 = u.pn * 256 + wc * 32 + 8 * fq;
#pragma unroll
        for (int ai = 0; ai < 2; ++ai)
#pragma unroll
            for (int m = 0; m < 4; ++m) { unsigned char* rowp = yp + (size_t)(row0 + ai * 128 + m * 16) * D + col0;
#pragma unroll
                for (int bj = 0; bj < 2; ++bj) { const f32x4 v0 = acc[ai][bj][m][0] * 16.0f, v1 = acc[ai][bj][m][1] * 16.0f;
                    u32x2 w; w.x = cvt_pk4_fp8(v0[0], v0[1], v0[2], v0[3]); w.y = cvt_pk4_fp8(v1[0], v1[1], v1[2], v1[3]);
                    *(u32x2*)(rowp + bj * 128) = w; } }
    }
};

struct Args {
    const float* x; const float* norm_mix_g; const float* w_in; const float* b_gates; const float* ln_g; const float* ln_b; const float* w_spatial; const float* b_spatial;
    const float* rel_bias; const float* w_out; const float* norm_ffn_g; const float* w_gr; const float* b_gr; const float* w_er; const float* b_er;
    const float* w1; const float* w3; const float* w2; const float* norm_final_g;
    float* out; unsigned char* ws; int ph_lo, ph_hi; int rep_mask, pad;
};
struct Frame { LAS unsigned char* lds; int tid, lane, wave, vcu, G; };
__device__ __forceinline__ Args load_args() {
#if defined(__HIP_DEVICE_COMPILE__)
    const __attribute__((address_space(4))) Args* p = (const __attribute__((address_space(4))) Args*)__builtin_amdgcn_kernarg_segment_ptr(); asm volatile("" : "+s"(p));
    Args r; __builtin_memcpy(&r, (const Args*)p, sizeof(Args)); return r;
#else
    return Args{};
#endif
}

__device__ __forceinline__ unsigned off_b(unsigned row, unsigned ch) { return 256u * row + 16u * (ch ^ (((row & 3) << 2) | ((row >> 2) & 3))); }
__device__ __forceinline__ int crow(int r, int hi) { return (r & 3) + 8 * (r >> 2) + 4 * hi; }
__device__ __forceinline__ s16x4 lds_tr(LAS const unsigned char* p) { typedef short v4i16_t __attribute__((ext_vector_type(4))); return __builtin_bit_cast(s16x4, __builtin_amdgcn_ds_read_tr16_b64_v4i16((LAS v4i16_t*)p)); }

struct TDesc { const float* src; int N, k0, n0; unsigned char* dst; int ldd  ; int rmk  , which; float scale  ; };
__device__ __forceinline__ int tdesc_row(const TDesc& d, int n) {
    if (d.rmk == 0) return n;
    if (d.rmk == 3) return 8 * (n >> 2) + 4 * d.which + (n & 3);
    const int sg = n >> 10, j = n & 1023; const int r = sg == 0 ? 8 * (j >> 2) + (j & 3) : sg == 5 ? 8 * (j >> 2) + 4 + (j & 3) : sg == 6 ? 6144 + j : 1024 + n;
    return d.rmk == 1 ? r : r - 3072;
}
__device__ __forceinline__ void titem_load(const TDesc& d, f32x4 (&v)[8], int lane) {
    const float* p = d.src + (size_t)(d.k0 + (lane >> 4)) * d.N + d.n0 + 4 * (lane & 15);
#pragma unroll
    for (int i = 0; i < 8; ++i) v[i] = __builtin_nontemporal_load((const f32x4*)(p + (size_t)(4 * i) * d.N));
}
__device__ __forceinline__ void titem_store(const TDesc& d, const f32x4 (&v)[8], LAS float* scr  , int lane) {
#pragma unroll
    for (int i = 0; i < 8; ++i) *(LAS f32x4*)(scr + (4 * i + (lane >> 4)) * 68 + 4 * (lane & 15)) = v[i];
    LDS_WAIT(); asm volatile("" ::: "memory");
    if (d.scale != 0.f) {
#pragma unroll
        for (int q = 0; q < 2; ++q) { const int n = (lane >> 1) + 32 * q, kh = lane & 1; const LAS float* sp = scr + (16 * kh) * 68 + n; float f[16];
#pragma unroll
            for (int j = 0; j < 16; ++j) f[j] = sp[j * 68] * d.scale;
            u32x4 o; o.x = cvt_pk4_fp8(f[0], f[1], f[2], f[3]); o.y = cvt_pk4_fp8(f[4], f[5], f[6], f[7]); o.z = cvt_pk4_fp8(f[8], f[9], f[10], f[11]); o.w = cvt_pk4_fp8(f[12], f[13], f[14], f[15]);
            *(u32x4*)(d.dst + (size_t)tdesc_row(d, d.n0 + n) * d.ldd + d.k0 + 16 * kh) = o; }
    } else {
#pragma unroll
        for (int q = 0; q < 4; ++q) { const int n = (lane >> 2) + 16 * q, kq = lane & 3; const LAS float* sp = scr + (8 * kq) * 68 + n; float f[8];
#pragma unroll
            for (int j = 0; j < 8; ++j) f[j] = sp[j * 68];
            u32x4 o; o.x = cvt_pk_bf16(f[0], f[1]); o.y = cvt_pk_bf16(f[2], f[3]); o.z = cvt_pk_bf16(f[4], f[5]); o.w = cvt_pk_bf16(f[6], f[7]);
            *(u32x4*)(d.dst + (size_t)tdesc_row(d, d.n0 + n) * d.ldd + (size_t)(d.k0 + 8 * kq) * 2) = o; }
    }
    LDS_WAIT(); asm volatile("" ::: "memory");
}
template <class Gen>
__device__ __forceinline__ void titems_run(const Gen& gen, int first, int stride, int end, LAS float* scr, int lane) {
    for (int it = first; it < end; it += 4 * stride) {
        const bool h1 = it + stride < end, h2 = it + 2 * stride < end, h3 = it + 3 * stride < end;
        const TDesc d0 = gen(it), d1 = gen(h1 ? it + stride : it), d2 = gen(h2 ? it + 2 * stride : it), d3 = gen(h3 ? it + 3 * stride : it);
        f32x4 v0[8], v1[8], v2[8], v3[8];
        titem_load(d0, v0, lane); if (h1) titem_load(d1, v1, lane); if (h2) titem_load(d2, v2, lane); if (h3) titem_load(d3, v3, lane);
        titem_store(d0, v0, scr, lane); if (h1) titem_store(d1, v1, scr, lane); if (h2) titem_store(d2, v2, scr, lane); if (h3) titem_store(d3, v3, scr, lane);
    }
}
template <class RowMap>
__device__ __forceinline__ void transpose_item_fp8(const float* W, int N, int k0, int n0, unsigned char* dst, int ldd, LAS float* scr, int lane, RowMap rm, float scale) {
#pragma unroll 8
    for (int i = 0; i < 32; ++i) { const int kk = 2 * i + (lane >> 5); scr[kk * 33 + (lane & 31)] = W[(size_t)(k0 + kk) * N + n0 + (lane & 31)]; }
    LDS_WAIT(); asm volatile("" ::: "memory");
    const int c = lane & 7;
#pragma unroll
    for (int j = 0; j < 4; ++j) { const int n = (lane >> 3) + 8 * j; const LAS float* s = scr + (8 * c) * 33 + n;
        u32x2 o; o.x = cvt_pk4_fp8(s[0 * 33] * scale, s[1 * 33] * scale, s[2 * 33] * scale, s[3 * 33] * scale); o.y = cvt_pk4_fp8(s[4 * 33] * scale, s[5 * 33] * scale, s[6 * 33] * scale, s[7 * 33] * scale);
        *(u32x2*)(dst + (size_t)rm(n0 + n) * ldd + k0 + 8 * c) = o; }
    LDS_WAIT(); asm volatile("" ::: "memory");
}
template <class RowMap>
__device__ __forceinline__ void transpose_item(const float* W, int N, int k0, int n0, bf16_t* dst, int ldd, LAS float* scr, int lane, RowMap rm) {
#pragma unroll 8
    for (int i = 0; i < 32; ++i) { const int kk = 2 * i + (lane >> 5); scr[kk * 33 + (lane & 31)] = W[(size_t)(k0 + kk) * N + n0 + (lane & 31)]; }
    LDS_WAIT(); asm volatile("" ::: "memory");
    const int c = lane & 7;
#pragma unroll
    for (int j = 0; j < 4; ++j) { const int n = (lane >> 3) + 8 * j; const LAS float* s = scr + (8 * c) * 33 + n;
        u32x4 o; o.x = cvt_pk_bf16(s[0 * 33], s[1 * 33]); o.y = cvt_pk_bf16(s[2 * 33], s[3 * 33]); o.z = cvt_pk_bf16(s[4 * 33], s[5 * 33]); o.w = cvt_pk_bf16(s[6 * 33], s[7 * 33]);
        *(u32x4*)(dst + (size_t)rm(n0 + n) * ldd + k0 + 8 * c) = o; }
    LDS_WAIT(); asm volatile("" ::: "memory");
}
struct RmId { __device__ __forceinline__ int operator()(int n) const { return n; } };
struct RmWin { __device__ __forceinline__ int operator()(int n) const { const int sg = n >> 10, j = n & 1023;
    return sg == 0 ? 8 * (j >> 2) + (j & 3) : sg == 5 ? 8 * (j >> 2) + 4 + (j & 3) : sg == 6 ? 6144 + j : 1024 + n; } };
struct RmWin8 { __device__ __forceinline__ int operator()(int n) const { return RmWin{}(n) - 3072; } };
struct RmW13 { int which; __device__ __forceinline__ int operator()(int j) const { return 8 * (j >> 2) + 4 * which + (j & 3); } };

__device__ __forceinline__ void p0_prologue(const Frame& F, const Args& a) {
    unsigned char* ws = a.ws;
    LAS float* scr = (LAS float*)(F.lds + F.wave * 16384);
    const int gw = F.vcu * NWAVES + F.wave, NGW = F.G * NWAVES;
    bf16_t* win_t = (bf16_t*)(ws + WS_WIN); bf16_t* wout_t = (bf16_t*)(ws + WS_WOUT);
    constexpr int I_IN = (D / 32) * (NCOL / 64), I_OUT = (D / 32) * (D / 64);
    { const float* w_in = a.w_in; unsigned char* wsb_ = ws;
      auto gen = [=](int it) -> TDesc {
          TDesc d; const int nblk = NCOL / 64, kb = it / nblk, nb = it % nblk; const int sg = (64 * nb) >> 10; const bool bf = (sg == 0 || sg == 1 || sg == 5);
          d.src = w_in; d.N = NCOL; d.k0 = 32 * kb; d.n0 = 64 * nb; d.dst = wsb_ + (bf ? WS_WIN : WS_WIN8); d.ldd = bf ? D * 2 : D; d.rmk = bf ? 1 : 2; d.which = 0; d.scale = bf ? 0.f : 32.0f;
          return d; };
      titems_run(gen, gw, NGW, I_IN, scr, F.lane); }
    { const float* w_out = a.w_out; unsigned char* wsb_ = ws;
      auto gen = [=](int it) -> TDesc {
          TDesc d; const int nblk = D / 64, kb = it / nblk, nb = it % nblk;
          d.src = w_out; d.N = D; d.k0 = 32 * kb; d.n0 = 64 * nb; d.dst = wsb_ + WS_WOUT; d.ldd = D * 2; d.rmk = 0; d.which = 0; d.scale = 0.f;
          return d; };
      titems_run(gen, gw, NGW, I_OUT, scr, F.lane); }
    bf16_t* xn = (bf16_t*)a.out;
    f32x4 gv[4];
#pragma unroll
    for (int j = 0; j < 4; ++j) gv[j] = *((const f32x4*)a.norm_mix_g + F.lane + 64 * j);
    for (int m = gw; m < T; m += NGW) {
        const f32x4* xr = (const f32x4*)(a.x + (size_t)m * D) + F.lane;
        f32x4 v[4]; float s = 0.f;
#pragma unroll
        for (int j = 0; j < 4; ++j) { v[j] = __builtin_nontemporal_load(xr + 64 * j); s += (v[j].x * v[j].x + v[j].y * v[j].y) + (v[j].z * v[j].z + v[j].w * v[j].w); }
        const float rs = 1.0f / sqrtf(wave_sum(s) * (1.f / D) + NORM_EPS);
        u32x2* o8 = (u32x2*)(xn + (size_t)m * D) + F.lane;
#pragma unroll
        for (int j = 0; j < 4; ++j) { const f32x4 y = v[j] * rs * gv[j]; u32x2 w; w.x = cvt_pk_bf16(y.x, y.y); w.y = cvt_pk_bf16(y.z, y.w); o8[64 * j] = w;
            ((unsigned*)(ws + WS_XN8 + (size_t)m * D))[F.lane + 64 * j] = cvt_pk4_fp8(y.x, y.y, y.z, y.w); }
    }
    { bf16_t* rwh = (bf16_t*)(ws + WS_RW); bf16_t* rwl = rwh + 48 * D;
      for (int i = (blockIdx.x * NTHREADS + F.tid) * 2; i < 48 * D; i += F.G * NTHREADS * 2) {
          const int c = i >> 10, k = i & 1023; float v0 = 0.f, v1 = 0.f;
          if (c < 32) { v0 = a.norm_ffn_g[k] * a.w_er[((size_t)(c >> 3) * D + k) * 8 + (c & 7)]; v1 = a.norm_ffn_g[k + 1] * a.w_er[((size_t)(c >> 3) * D + k + 1) * 8 + (c & 7)]; }
          else if (c < 36) { v0 = a.norm_ffn_g[k] * a.w_gr[k * 4 + (c - 32)]; v1 = a.norm_ffn_g[k + 1] * a.w_gr[(k + 1) * 4 + (c - 32)]; }
          const unsigned hi = cvt_pk_bf16(v0, v1);
          *(unsigned*)(rwh + i) = hi; *(unsigned*)(rwl + i) = cvt_pk_bf16(v0 - bf_lo(hi), v1 - bf_hi(hi)); } }
    bf16_t* wsb = (bf16_t*)(ws + WS_WSB);
    for (int i = (blockIdx.x * NTHREADS + F.tid) * 2; i < 8 * 128 * 128; i += F.G * NTHREADS * 2) {
        const int s = i & 127, t = (i >> 7) & 127;
        const float v0 = (s <= t) ? a.w_spatial[i] : 0.f, v1 = (s + 1 <= t) ? a.w_spatial[i + 1] : 0.f;
        *(unsigned*)(wsb + i) = cvt_pk_bf16(v0, v1);
    }
}

constexpr int GM_WSL = 98304, GM_STAT = 90112;
__device__ __forceinline__ void gmlp_load_ws(const Frame& F, const Args& a, int g) {
    const bf16_t* wsb = (const bf16_t*)(a.ws + WS_WSB);
    for (int i = F.tid; i < 128 * 16; i += NTHREADS) { const int row = i >> 4, ch = i & 15; *(LAS u32x4*)(F.lds + GM_WSL + off_b(row, ch)) = *(const u32x4*)(wsb + ((size_t)g * 128 + row) * 128 + ch * 8); }
}
__device__ __forceinline__ void gmlp_chunk(const Frame& F, const Args& a, int row0, int g, const bool live) {
    asm volatile("" : "+s"(row0), "+s"(g));
    int tid_ = F.tid; asm volatile("" : "+v"(tid_));
    unsigned char* ws = a.ws;
    bf16_t* Ub = (bf16_t*)(ws + WS_U); const bf16_t* VG = (const bf16_t*)(ws + WS_VG);
    const f32x2* stats = (const f32x2*)(ws + WS_STAT);
    LAS unsigned char* VN = F.lds;
    LAS unsigned char* WSL = F.lds + GM_WSL;
    LAS float* MEAN = (LAS float*)(F.lds + GM_STAT); LAS float* RSTD = MEAN + 128;
    const int lane = tid_ & 63, wid = __builtin_amdgcn_readfirstlane(tid_ >> 6), r32 = lane & 31, hh = lane >> 5;
    const int mych = tid_ & 15;
    const f32x4 lg0 = *(const f32x4*)(a.ln_g + g * 128 + mych * 8), lg1 = *(const f32x4*)(a.ln_g + g * 128 + mych * 8 + 4);
    const f32x4 lb0 = *(const f32x4*)(a.ln_b + g * 128 + mych * 8), lb1 = *(const f32x4*)(a.ln_b + g * 128 + mych * 8 + 4);
    const int tt = wid >> 1, cp = wid & 1;
    const float bsp = a.b_spatial[g * 128 + tt * 32 + r32];
    __syncthreads();
    if (tid_ < 128) { const f32x2* sp = stats + (size_t)(row0 + tid_) * 16; float s1 = 0.f, s2 = 0.f;
#pragma unroll
        for (int j = 0; j < 16; ++j) { const f32x2 v = sp[j]; s1 += v.x; s2 += v.y; }
        const float mean = s1 * (1.f / 1024.f), var = s2 * (1.f / 1024.f) - mean * mean;
        MEAN[tid_] = mean; RSTD[tid_] = 1.0f / sqrtf(fmaxf(var, 0.f) + NORM_EPS); }
    __syncthreads();
#pragma unroll
    for (int it = 0; it < 4; ++it) { const int s = (tid_ >> 4) + 32 * it;
        const u32x4 raw = *(const u32x4*)(VG + (size_t)(row0 + s) * D + g * 128 + mych * 8);
        const float mu = MEAN[s], rs = RSTD[s];
        f32x4 x0 = (f32x4){bf_lo(raw.x), bf_hi(raw.x), bf_lo(raw.y), bf_hi(raw.y)}, x1 = (f32x4){bf_lo(raw.z), bf_hi(raw.z), bf_lo(raw.w), bf_hi(raw.w)};
        x0 = (x0 - mu) * rs * lg0 + lb0; x1 = (x1 - mu) * rs * lg1 + lb1;
        u32x4 w; w.x = cvt_pk_bf16(x0[0], x0[1]); w.y = cvt_pk_bf16(x0[2], x0[3]); w.z = cvt_pk_bf16(x1[0], x1[1]); w.w = cvt_pk_bf16(x1[2], x1[3]);
        *(LAS u32x4*)(VN + off_b(s, mych)) = w; }
    __syncthreads();
    f32x16 c0 = {}, c1 = {};
    const unsigned blk = (lane >> 4) & 1, q = (lane & 15) >> 2, p = lane & 3;
    for (int ks = 0; ks < 2 * (tt + 1); ++ks) {
        const bf16x8 bfrag = *(const LAS bf16x8*)(WSL + off_b(tt * 32 + r32, 2 * ks + hh));
        bf16x8 af[2];
#pragma unroll
        for (int ct = 0; ct < 2; ++ct) { const int cc = 2 * cp + ct;
            const s16x4 lo = lds_tr(VN + off_b(16 * ks + 8 * hh + q, 4 * cc + 2 * blk + (p >> 1)) + 8 * (p & 1));
            const s16x4 hi = lds_tr(VN + off_b(16 * ks + 8 * hh + 4 + q, 4 * cc + 2 * blk + (p >> 1)) + 8 * (p & 1));
            af[ct] = (bf16x8){lo[0], lo[1], lo[2], lo[3], hi[0], hi[1], hi[2], hi[3]}; }
        c0 = __builtin_amdgcn_mfma_f32_32x32x16_bf16(af[0], bfrag, c0, 0, 0, 0);
        c1 = __builtin_amdgcn_mfma_f32_32x32x16_bf16(af[1], bfrag, c1, 0, 0, 0);
    }
    const size_t rowoff = (size_t)(row0 + tt * 32 + r32) * D + g * 128;
#pragma unroll
    for (int ct = 0; ct < 2; ++ct)
#pragma unroll
        for (int gq = 0; gq < 4; ++gq) { const int c = 32 * (2 * cp + ct) + 8 * gq + 4 * hh;
            const u32x2 uu = *(const u32x2*)(Ub + rowoff + c);
            const f32x16& cc_ = ct ? c1 : c0;
            const float m0 = cc_[4 * gq + 0] + bsp, m1 = cc_[4 * gq + 1] + bsp, m2 = cc_[4 * gq + 2] + bsp, m3 = cc_[4 * gq + 3] + bsp;
            u32x2 o; o.x = cvt_pk_bf16(bf_lo(uu.x) * m0, bf_hi(uu.x) * m1); o.y = cvt_pk_bf16(bf_lo(uu.y) * m2, bf_hi(uu.y) * m3);
            if (live) *(u32x2*)(Ub + rowoff + c) = o; }
}

__constant__ unsigned char T5_BUCKET[128] = {0, 1, 2, 3, 4, 5, 6, 7, 8, 9, 10, 11, 12, 13, 14, 15, 16, 16, 16, 17, 17, 18, 18, 18, 19, 19, 19, 20, 20, 20, 20, 21, 21, 21, 21, 22, 22, 22, 22, 22, 23, 23, 23, 23, 23, 23, 24, 24, 24, 24, 24, 24, 25, 25, 25, 25, 25, 25, 25, 26, 26, 26, 26, 26, 26, 26, 26, 27, 27, 27, 27, 27, 27, 27, 27, 27, 27, 28, 28, 28, 28, 28, 28, 28, 28, 28, 28, 29, 29, 29, 29, 29, 29, 29, 29, 29, 29, 29, 29, 30, 30, 30, 30, 30, 30, 30, 30, 30, 30, 30, 30, 30, 30, 31, 31, 31, 31, 31, 31, 31, 31, 31, 31, 31, 31, 31, 31, 31};
constexpr int AT_KV = 0;
constexpr int AT_KMH = 65536, AT_KML = 73728, AT_TB = 81920;
__device__ __forceinline__ void attn_bh_tables(const Frame& F, const Args& a, int b, int h) {
    LAS unsigned char* lds = F.lds; const int tid = F.tid;
    const float* kpart = (const float*)(a.ws + WS_KPART);
    { const int n = tid >> 5, c4 = (tid & 31) * 4;
      const float* kp = kpart + ((size_t)(b * 16 + n) * 2) * D + h * HD + c4;
      const f32x4 s = (*(const f32x4*)kp + *(const f32x4*)(kp + D)) * (1.0f / 256.0f);
      u32x2 hi; hi.x = cvt_pk_bf16(s[0], s[1]); hi.y = cvt_pk_bf16(s[2], s[3]);
      const f32x4 rsd = (f32x4){s[0] - bf_lo(hi.x), s[1] - bf_hi(hi.x), s[2] - bf_lo(hi.y), s[3] - bf_hi(hi.y)};
      u32x2 lo; lo.x = cvt_pk_bf16(rsd[0], rsd[1]); lo.y = cvt_pk_bf16(rsd[2], rsd[3]);
      const unsigned o = off_b(n, c4 >> 3) + (c4 & 7) * 2, oz = off_b(n + 16, c4 >> 3) + (c4 & 7) * 2;
      *(LAS u32x2*)(lds + AT_KMH + o) = hi; *(LAS u32x2*)(lds + AT_KML + o) = lo;
      *(LAS u32x2*)(lds + AT_KMH + oz) = (u32x2){0u, 0u}; *(LAS u32x2*)(lds + AT_KML + oz) = (u32x2){0u, 0u};
#pragma unroll
      for (int i = 0; i < 3; ++i) { const int j = tid + 512 * i; const int d = 512 - j;
          if (j < 768) ((LAS float*)(lds + AT_TB))[j] = d < 0 ? -INFINITY : a.rel_bias[T5_BUCKET[d > 127 ? 127 : d] * NH + h] * LOG2E - 4.0f; else ((LAS float*)(lds + AT_TB))[j] = -INFINITY; } }
}
__device__ __forceinline__ void attn_unit(const Frame& F, const Args& a, int b, int h, int qb, const bool live) {
    unsigned char* ws = a.ws;
    const bf16_t* Qg = (const bf16_t*)(ws + WS_Q); const unsigned char* K8g = ws + WS_K; const unsigned char* VTg = ws + WS_VA;
    bf16_t* Zg = (bf16_t*)(ws + WS_U); const bf16_t* GBg = (const bf16_t*)(ws + WS_GB);
    const float* kpart = (const float*)(ws + WS_KPART);
    LAS unsigned char* lds = F.lds;
    int lane_ = F.lane, wid_ = F.wave; asm volatile("" : "+v"(lane_), "+s"(wid_));
    const int lane = lane_, wid = wid_, tid = wid * 64 + lane, r32 = lane & 31, hh = lane >> 5;
    const size_t tok_b = (size_t)b * SEQ;
    const int NT = 4 * (qb + 1);
#pragma unroll 1
    for (int cch = ((a.rep_mask >> 10) & 1) ? -2 : 0; cch < 2; ++cch) gmlp_chunk(F, a, (int)tok_b + qb * 256 + 128 * (cch & 1), h, live && cch >= 0);
    asm volatile("s_waitcnt vmcnt(0)" ::: "memory"); __builtin_amdgcn_fence(__ATOMIC_ACQ_REL, "workgroup");
    __syncthreads();
    const unsigned char* ksrc = K8g + (tok_b + 8 * wid + (lane >> 3)) * D + h * HD + 16 * ((lane & 7) ^ ((4 * wid + (lane >> 4)) & 7));
    const unsigned char* vsrc = VTg + (size_t)(b * 8 + h) * (64 * 8192) + (16 * wid + (lane >> 2)) * 64 + 16 * ((lane & 3) ^ ((lane >> 4) & 3));
#define AT_ISSUE(t) do { const int _bo = ((t) & 1) * 32768; \
        __builtin_amdgcn_global_load_lds((const unsigned*)(ksrc + (size_t)(t) * 64 * D), (LAS unsigned*)(lds + AT_KV + _bo + wid * 1024), 16, 0, 0); \
        __builtin_amdgcn_global_load_lds((const unsigned*)(vsrc + (size_t)(t) * 8192), (LAS unsigned*)(lds + AT_KV + _bo + 16384 + wid * 1024), 16, 0, 0); } while (0)
    AT_ISSUE(0);
    const int qi = wid * 32 + r32;
    const size_t qtok = tok_b + (size_t)qb * 256 + qi;
    pg8::i32x8_t q8[2];
    const float QS = 8.0f * 0.08838834764831845f * LOG2E;
    unsigned sel = 0u;
    { f32x16 gacc = {};
#pragma unroll
      for (int ks2 = 0; ks2 < 2; ++ks2) { bf16x8 qraw[4];
#pragma unroll
          for (int e = 0; e < 4; ++e) qraw[e] = *(const bf16x8*)(Qg + qtok * D + h * HD + 64 * ks2 + 32 * hh + 8 * e);
#pragma unroll
          for (int e = 0; e < 4; ++e) { const bf16x8 kh = *(const LAS bf16x8*)(lds + AT_KMH + off_b(r32, 8 * ks2 + 4 * hh + e)), kl = *(const LAS bf16x8*)(lds + AT_KML + off_b(r32, 8 * ks2 + 4 * hh + e));
              gacc = __builtin_amdgcn_mfma_f32_32x32x16_bf16(kh, qraw[e], gacc, 0, 0, 0); gacc = __builtin_amdgcn_mfma_f32_32x32x16_bf16(kl, qraw[e], gacc, 0, 0, 0); }
#pragma unroll
          for (int e = 0; e < 4; ++e) { const bf16x8 qq = qraw[e]; const u32x4 qw = __builtin_bit_cast(u32x4, qq);
              q8[ks2][2 * e] = (int)cvt_pk4_fp8(QS * bf_lo(qw.x), QS * bf_hi(qw.x), QS * bf_lo(qw.y), QS * bf_hi(qw.y)); q8[ks2][2 * e + 1] = (int)cvt_pk4_fp8(QS * bf_lo(qw.z), QS * bf_hi(qw.z), QS * bf_lo(qw.w), QS * bf_hi(qw.w)); } }
      float gv[16];
#pragma unroll
      for (int aa = 0; aa < 2; ++aa)
#pragma unroll
          for (int i = 0; i < 4; ++i) { const float own = gacc[4 * aa + i], oth = __shfl_xor(own, 32);
              gv[8 * aa + i] = hh ? oth : own; gv[8 * aa + 4 + i] = hh ? own : oth; }
#pragma unroll
      for (int n = 0; n < 16; ++n) if (n >= qb) gv[n] = -INFINITY;
#pragma unroll
      for (int k = 0; k < 3; ++k) { float best = -INFINITY; int bi = -1;
#pragma unroll
          for (int n = 0; n < 16; ++n) { const bool c = !((sel >> n) & 1u) && gv[n] > best; best = c ? gv[n] : best; bi = c ? n : bi; }
          if (bi >= 0) sel |= 1u << bi; } }
    const LAS float* TB = (const LAS float*)(lds + AT_TB);
    const float b31 = TB[512 - 127];
    const LAS float* tbl = TB + (512 - r32 + 4 * hh);
    f32x16 o[4]; o[0] = f32x16{}; o[1] = f32x16{}; o[2] = f32x16{}; o[3] = f32x16{};
    f32x16 o5 = f32x16{};
    const pg8::i32x8_t ones8 = {0x38383838, 0x38383838, 0x38383838, 0x38383838, 0x38383838, 0x38383838, 0x38383838, 0x38383838};
    pg8::i32x8_t p8 = {0, 0, 0, 0, 0, 0, 0, 0};
    f32x16 cbf = {};
    const unsigned kb0 = 128u * r32 + 16u * ((2u * hh) ^ ((r32 >> 1) & 7u));
    const unsigned vb0 = 64u * r32 + 16u * ((2u * hh) ^ ((r32 >> 2) & 3u));
    const int sc1 = 0x7f7f7f7f, scq = 0x7c7c7c7c;
#define AT_MMA_SEED(S, KF, QF) asm volatile("v_mfma_scale_f32_32x32x64_f8f6f4 %0, %1, %2, %5, %3, %4 op_sel_hi:[0,0,0]" : "=&v"(S) : "v"(KF), "v"(QF), "v"(sc1), "v"(scq), "v"(cbf))
#define AT_MMA_ACC(S, KF, QF) asm volatile("v_mfma_scale_f32_32x32x64_f8f6f4 %0, %1, %2, %0, %3, %4 op_sel_hi:[0,0,0]" : "+v"(S) : "v"(KF), "v"(QF), "v"(sc1), "v"(scq))
#define AT_SOFTMAX(S, HI) { float pr[16]; \
            _Pragma("unroll") for (int r = 0; r < 16; ++r) pr[r] = __builtin_amdgcn_exp2f(S[r]); \
            _Pragma("unroll") for (int w = 0; w < 8; ++w) p8[w] = HI ? __builtin_amdgcn_cvt_pk_fp8_f32(pr[w], pr[8 + w], p8[w], true) : __builtin_amdgcn_cvt_pk_fp8_f32(pr[w], pr[8 + w], p8[w], false); }
#define AT_TILE(FAST) { pg8::i32x8_t kf[4]; \
            _Pragma("unroll") for (int i = 0; i < 4; ++i) { const pg8::i32x4_t lo = *(const LAS pg8::i32x4_t*)(lds + (kb ^ (64u * (i & 1))) + (i >> 1) * 4096), hi = *(const LAS pg8::i32x4_t*)(lds + (kb ^ (64u * (i & 1)) ^ 16u) + (i >> 1) * 4096); \
                kf[i] = (pg8::i32x8_t){lo[0], lo[1], lo[2], lo[3], hi[0], hi[1], hi[2], hi[3]}; } \
            f32x16 s0, s1; \
            if (!(FAST)) { const LAS float* tp = tbl + (bfar == -INFINITY ? 768 : 0) + (kj0 - rel - wid * 32); \
                _Pragma("unroll") for (int r = 0; r < 16; ++r) s0[r] = tp[(r & 3) + 8 * (r >> 2)]; \
                _Pragma("unroll") for (int r = 0; r < 16; ++r) s1[r] = tp[32 + (r & 3) + 8 * (r >> 2)]; } \
            asm volatile("s_waitcnt lgkmcnt(0)\n\ts_nop 1" ::: "memory"); \
            if (FAST) { AT_MMA_SEED(s0, kf[0], q8[0]); } else { AT_MMA_ACC(s0, kf[0], q8[0]); } \
            AT_MMA_ACC(s0, kf[1], q8[1]); \
            if (FAST) { AT_MMA_SEED(s1, kf[2], q8[0]); } else { AT_MMA_ACC(s1, kf[2], q8[0]); } \
              \
            asm volatile("v_mfma_scale_f32_32x32x64_f8f6f4 %0, %2, %3, %0, %4, %5 op_sel_hi:[0,0,0]\n\ts_nop 7" : "+v"(s1), "+v"(s0) : "v"(kf[3]), "v"(q8[1]), "v"(sc1), "v"(scq)); \
              \
            pg8::i32x8_t vf[4]; \
            _Pragma("unroll") for (int dt = 0; dt < 4; ++dt) { const pg8::i32x4_t lo = *(const LAS pg8::i32x4_t*)(lds + vb + 2048 * dt), hi = *(const LAS pg8::i32x4_t*)(lds + (vb ^ 16u) + 2048 * dt); \
                vf[dt] = (pg8::i32x8_t){lo[0], lo[1], lo[2], lo[3], hi[0], hi[1], hi[2], hi[3]}; } \
            __builtin_amdgcn_sched_barrier(0); \
            AT_SOFTMAX(s0, false) \
            __builtin_amdgcn_sched_barrier(0); \
            AT_SOFTMAX(s1, true) \
            __builtin_amdgcn_sched_barrier(0); \
              \
            asm volatile("s_waitcnt lgkmcnt(0)\n\ts_nop 3" ::: "memory"); \
            _Pragma("unroll") for (int dt = 0; dt < 4; ++dt) \
                asm volatile("v_mfma_scale_f32_32x32x64_f8f6f4 %0, %1, %2, %0, %3, %4 op_sel_hi:[0,0,0]" : "+v"(o[dt]) : "v"(p8), "v"(vf[dt]), "v"(sc1), "v"(sc1)); \
            asm volatile("v_mfma_scale_f32_32x32x64_f8f6f4 %0, %1, %2, %0, %3, %4 op_sel_hi:[0,0,0]" : "+v"(o5) : "v"(p8), "v"(ones8), "v"(sc1), "v"(sc1)); \
            __builtin_amdgcn_sched_barrier(0); }
#define AT_STEP(FAST) { \
        if (t + 1 < NT) { AT_ISSUE(t + 1); asm volatile("s_waitcnt vmcnt(2)" ::: "memory"); } else { asm volatile("s_waitcnt vmcnt(0)" ::: "memory"); } \
        __builtin_amdgcn_s_barrier(); asm volatile("" ::: "memory"); \
        const int n = t >> 2, kj0 = (t & 3) * 64; \
        unsigned kb = kb0 + AT_KV + (t & 1) * 32768, vb = vb0 + AT_KV + (t & 1) * 32768 + 16384; \
        asm volatile("" : "+v"(kb), "+v"(vb));                                    \
        const int rel = (n == qb) ? 0 : 256;                                      \
        const float bfar = (n == qb || ((sel >> n) & 1u)) ? b31 : -INFINITY;      \
        AT_TILE(FAST) \
        asm volatile("s_waitcnt lgkmcnt(0)" ::: "memory"); __builtin_amdgcn_s_barrier(); asm volatile("" ::: "memory"); }
    const int T1 = qb > 0 ? 4 * (qb - 1) : 0;
#pragma unroll 1
    for (int pass = (a.rep_mask >> 11) & 1; pass >= 0; --pass) {
    int t = 0;
#pragma unroll 1
    while (t < T1) {
        { const float bf = ((sel >> (t >> 2)) & 1u) ? b31 : -INFINITY;
#pragma unroll
          for (int r = 0; r < 16; ++r) cbf[r] = bf; }
#pragma unroll 1
        for (int j = 0; j < 4; ++j, ++t) AT_STEP(1)
    }
    asm volatile("s_nop 15\n\ts_nop 7" : "+v"(o[0]), "+v"(o[1]), "+v"(o[2]), "+v"(o[3]), "+v"(o5));
#pragma unroll 1
    for (; t < NT; ++t) AT_STEP(0)
    asm volatile("s_nop 15\n\ts_nop 7" : "+v"(o[0]), "+v"(o[1]), "+v"(o[2]), "+v"(o[3]), "+v"(o5));
    if (pass) { AT_ISSUE(0); }
    }
#undef AT_STEP
#undef AT_TILE
#undef AT_SOFTMAX
#undef AT_MMA_ACC
#undef AT_MMA_SEED
    asm volatile("s_nop 15\n\ts_nop 15" ::: "memory");
    { LAS unsigned char* stg = lds + AT_KV + wid * 8192;
#pragma unroll
      for (int r = 0; r < 16; ++r) { const int qrow = crow(r, hh); const float li = __builtin_amdgcn_rcpf(o5[r]);
#pragma unroll
          for (int dt = 0; dt < 4; ++dt) *(LAS bf16_t*)(stg + qrow * 256 + (32 * dt + r32) * 2) = (bf16_t)(cvt_pk_bf16(o[dt][r] * li, 0.f) & 0xffffu); }
      asm volatile("s_waitcnt lgkmcnt(0)" ::: "memory");
      const size_t rowbase = (tok_b + (size_t)qb * 256 + wid * 32) * D + h * HD;
#pragma unroll
      for (int i = 0; i < 8; ++i) { const int row = 4 * i + (lane >> 4), ch = lane & 15;
          const u32x4 yv = *(const LAS u32x4*)(stg + row * 256 + ch * 16);
          const size_t off = rowbase + (size_t)row * D + ch * 8;
          const u32x4 zv = *(const u32x4*)(Zg + off); const u32x2 g8 = *(const u32x2*)((const unsigned char*)GBg + off);
          u32x4 ov;
          { const f32x2 g0 = __builtin_amdgcn_cvt_pk_f32_fp8((int)g8.x, false), g1 = __builtin_amdgcn_cvt_pk_f32_fp8((int)g8.x, true), g2 = __builtin_amdgcn_cvt_pk_f32_fp8((int)g8.y, false), g3 = __builtin_amdgcn_cvt_pk_f32_fp8((int)g8.y, true);
            ov.x = cvt_pk_bf16(bf_lo(zv.x) + g0[0] * bf_lo(yv.x), bf_hi(zv.x) + g0[1] * bf_hi(yv.x)); ov.y = cvt_pk_bf16(bf_lo(zv.y) + g1[0] * bf_lo(yv.y), bf_hi(zv.y) + g1[1] * bf_hi(yv.y));
            ov.z = cvt_pk_bf16(bf_lo(zv.z) + g2[0] * bf_lo(yv.z), bf_hi(zv.z) + g2[1] * bf_hi(yv.z)); ov.w = cvt_pk_bf16(bf_lo(zv.w) + g3[0] * bf_lo(yv.w), bf_hi(zv.w) + g3[1] * bf_hi(yv.w)); }
          if (live) *(u32x4*)(Zg + off) = ov; }
      asm volatile("s_waitcnt lgkmcnt(0)" ::: "memory"); }
#undef AT_ISSUE
}
__device__ __forceinline__ void p3_attention(const Frame& F, const Args& a, const bool live) {
    for (int v = F.vcu; v < 256; v += F.G) {
        const int bh = v >> 3, s = v & 7;
        __syncthreads(); gmlp_load_ws(F, a, bh & 7); attn_bh_tables(F, a, bh >> 3, bh & 7);
#pragma unroll 1
        for (int uu = 0; uu < 2; ++uu) attn_unit(F, a, bh >> 3, bh & 7, uu ? s : 15 - s, live);
    }
}

constexpr int P5_CTR_OFF = MISC_OFF + 256;
__device__ __forceinline__ void p5_router(const Frame& F, const Args& a, const bool live) {
    unsigned char* ws = a.ws;
    const int lane = F.lane, wid = F.wave;
    const bf16_t* H = (const bf16_t*)(ws + WS_HB); unsigned char* xn2 = ws + WS_XN2;
    unsigned* cnt = (unsigned*)(ws + WS_CTL) + CW_CNT; int* list = (int*)(ws + WS_LIST); int* inv = (int*)(ws + WS_INV); float* wtok = (float*)(ws + WS_WTOK); float* rsp = (float*)(ws + WS_RSP);
    LAS unsigned* ctr = (LAS unsigned*)(F.lds + P5_CTR_OFF);
    if (F.tid == 0) *ctr = 0u;
    __syncthreads();
    if (wid < 4) {
        const bf16_t* rwh = (const bf16_t*)(ws + WS_RW); const bf16_t* rwl = rwh + 48 * D;
        LAS float* scr = (LAS float*)(F.lds + wid * 16384 + 8704);
        for (int tile = F.vcu * 4 + wid; tile < T / 16; tile += F.G * 4) {
        const int row0 = tile * 16, r = lane & 15, kq = lane >> 4;
        const bf16_t* hrow = H + (size_t)(row0 + r) * D + 8 * kq;
        const bf16_t* bh = rwh + (size_t)r * D + 8 * kq; const bf16_t* bl = rwl + (size_t)r * D + 8 * kq;
        f32x4 acc[3]; acc[0] = (f32x4){0.f, 0.f, 0.f, 0.f}; acc[1] = acc[0]; acc[2] = acc[0];
        float ssq = 0.f;
        const float* gp = a.norm_ffn_g + 8 * kq;
        unsigned char* orow = xn2 + (size_t)(row0 + r) * D + 8 * kq;
#pragma unroll 4
        for (int ks = 0; ks < 32; ++ks) {
            const u32x4 hi = *(const u32x4*)(hrow + 32 * ks);
            const f32x4 x0 = (f32x4){bf_lo(hi.x), bf_hi(hi.x), bf_lo(hi.y), bf_hi(hi.y)}, x1 = (f32x4){bf_lo(hi.z), bf_hi(hi.z), bf_lo(hi.w), bf_hi(hi.w)};
            ssq += ((x0[0] * x0[0] + x0[1] * x0[1]) + (x0[2] * x0[2] + x0[3] * x0[3])) + ((x1[0] * x1[0] + x1[1] * x1[1]) + (x1[2] * x1[2] + x1[3] * x1[3]));
            const bf16x8 ah = __builtin_bit_cast(bf16x8, hi);
            { const f32x4 y0 = x0 * *(const f32x4*)(gp + 32 * ks), y1 = x1 * *(const f32x4*)(gp + 32 * ks + 4);
              u32x2 w; w.x = cvt_pk4_fp8(y0[0], y0[1], y0[2], y0[3]); w.y = cvt_pk4_fp8(y1[0], y1[1], y1[2], y1[3]);
              *(u32x2*)(orow + 32 * ks) = w; }
#pragma unroll
            for (int nt = 0; nt < 3; ++nt) { const bf16x8 wh = *(const bf16x8*)(bh + (size_t)nt * 16 * D + 32 * ks), wlo = *(const bf16x8*)(bl + (size_t)nt * 16 * D + 32 * ks);
                acc[nt] = __builtin_amdgcn_mfma_f32_16x16x32_bf16(ah, wh, acc[nt], 0, 0, 0);
                acc[nt] = __builtin_amdgcn_mfma_f32_16x16x32_bf16(ah, wlo, acc[nt], 0, 0, 0); }
        }
        ssq += __shfl_xor(ssq, 16); ssq += __shfl_xor(ssq, 32);
        const float rs = 1.0f / sqrtf(ssq * (1.f / D) + NORM_EPS);
#pragma unroll
        for (int nt = 0; nt < 3; ++nt)
#pragma unroll
            for (int j = 0; j < 4; ++j) scr[(4 * kq + j) * 49 + 16 * nt + r] = acc[nt][j];
        LDS_WAIT(); asm volatile("" ::: "memory");
        if (lane < 16) {
            const LAS float* lr = scr + lane * 49;
            float gl[4];
#pragma unroll
            for (int g = 0; g < 4; ++g) gl[g] = lr[32 + g] * rs + a.b_gr[g];
            int gi = 0; float gm = gl[0];
#pragma unroll
            for (int g = 1; g < 4; ++g) if (gl[g] > gm) { gm = gl[g]; gi = g; }
            float den = 0.f;
#pragma unroll
            for (int g = 0; g < 4; ++g) den += __expf(gl[g] - gm);
            const float g_w = 1.0f / den;
            float el[8];
#pragma unroll
            for (int e = 0; e < 8; ++e) el[e] = lr[gi * 8 + e] * rs + a.b_er[gi * 8 + e];
            int e0 = 0; float v0 = el[0];
#pragma unroll
            for (int e = 1; e < 8; ++e) if (el[e] > v0) { v0 = el[e]; e0 = e; }
            int e1 = -1; float v1 = -INFINITY;
#pragma unroll
            for (int e = 0; e < 8; ++e) if (e != e0 && el[e] > v1) { v1 = el[e]; e1 = e; }
            const float x1 = __expf(v1 - v0), w0f = g_w / (1.0f + x1), w1f = g_w * x1 / (1.0f + x1);
            if (live) { const int m = row0 + lane;
                const int ex0 = gi * 8 + e0, ex1 = gi * 8 + e1;
                const unsigned p0 = __hip_atomic_fetch_add(cnt + 64 * ex0, 1u, __ATOMIC_RELAXED, __HIP_MEMORY_SCOPE_AGENT);
                const unsigned p1 = __hip_atomic_fetch_add(cnt + 64 * ex1, 1u, __ATOMIC_RELAXED, __HIP_MEMORY_SCOPE_AGENT);
                list[ex0 * LCAP + p0] = m * 2; list[ex1 * LCAP + p1] = m * 2 + 1;
                rsp[ex0 * LCAP + p0] = rs; rsp[ex1 * LCAP + p1] = rs;
                *(int2*)(inv + m * 2) = make_int2(ex0 * LCAP + (int)p0, ex1 * LCAP + (int)p1); *(float2*)(wtok + m * 2) = make_float2(w0f, w1f); }
        }
        LDS_WAIT(); asm volatile("" ::: "memory");
        }
    }
    { LAS float* tscr = (LAS float*)(F.lds + wid * 16384);
      const float* w1 = a.w1; const float* w3 = a.w3; const float* w2 = a.w2; unsigned char* w13 = ws + WS_W13; unsigned char* w2t = ws + WS_W2;
      constexpr int I13 = (D / 32) * (DEXP / 64), I2 = (DEXP / 32) * (D / 64), IPE = 2 * I13 + I2;
      auto gen = [=](int it) -> TDesc {
          TDesc d; const int e = it / IPE; int r = it % IPE;
          if (r < 2 * I13) { const int which = r / I13; r %= I13; const int kb = r / (DEXP / 64), nb = r % (DEXP / 64);
              d.src = (which ? w3 : w1) + (size_t)e * D * DEXP; d.N = DEXP; d.k0 = 32 * kb; d.n0 = 64 * nb; d.dst = w13 + (size_t)e * 512 * D; d.ldd = D; d.rmk = 3; d.which = which; d.scale = 32.0f; }
          else { r -= 2 * I13; const int kb = r / (D / 64), nb = r % (D / 64);
              d.src = w2 + (size_t)e * DEXP * D; d.N = D; d.k0 = 32 * kb; d.n0 = 64 * nb; d.dst = w2t + (size_t)e * D * DEXP; d.ldd = DEXP; d.rmk = 0; d.which = 0; d.scale = 16.0f; }
          return d; };
      const int per_wg = (NEXP * IPE + F.G - 1) / F.G;
      const int base = F.vcu * per_wg;
      const int q4 = per_wg / 24;
      const int restw = (per_wg - 4 * q4 + 3) / 4;
      const int lo_ = wid < 4 ? wid * q4 : 4 * q4 + (wid - 4) * restw;
      int hi_ = wid < 4 ? lo_ + q4 : lo_ + restw; if (hi_ > per_wg) hi_ = per_wg;
      int endi = base + hi_; if (endi > NEXP * IPE) endi = NEXP * IPE;
      titems_run(gen, base + lo_, 1, endi, tscr, lane); }
    __syncthreads();
}

__device__ __forceinline__ void p8_final(const Frame& F, const Args& a, const bool live) {
    const int gw = F.vcu * NWAVES + F.wave, NGW = F.G * NWAVES, lane = F.lane;
    const unsigned char* yp = a.ws + WS_YP;
    const LAS int* pref = (const LAS int*)(F.lds + PREF_OFF);
    f32x4 gv[4];
#pragma unroll
    for (int j = 0; j < 4; ++j) gv[j] = *((const f32x4*)a.norm_final_g + lane + 64 * j);
    for (int m = gw; m < T; m += NGW) {
        f32x4* xr = (f32x4*)(a.out + (size_t)m * D) + lane;
        const u32x2* hr = (const u32x2*)((const bf16_t*)(a.ws + WS_HB) + (size_t)m * D) + lane;
        const int2 iv = *(const int2*)((const int*)(a.ws + WS_INV) + m * 2); const float2 wv = *(const float2*)((const float*)(a.ws + WS_WTOK) + m * 2);
        const int pr0 = 256 * pref[iv.x >> 14] + (iv.x & (LCAP - 1)), pr1 = 256 * pref[iv.y >> 14] + (iv.y & (LCAP - 1));
        const unsigned* y0 = (const unsigned*)(yp + (size_t)pr0 * D) + lane; const unsigned* y1 = (const unsigned*)(yp + (size_t)pr1 * D) + lane;
        const float w0 = wv.x * (1.0f / 16.0f), w1 = wv.y * (1.0f / 16.0f);
        f32x4 v[4]; float s = 0.f;
#pragma unroll
        for (int j = 0; j < 4; ++j) { const unsigned p0 = y0[64 * j], p1 = y1[64 * j];
            const f32x2 a0 = __builtin_amdgcn_cvt_pk_f32_fp8((int)p0, false), a1 = __builtin_amdgcn_cvt_pk_f32_fp8((int)p0, true), b0 = __builtin_amdgcn_cvt_pk_f32_fp8((int)p1, false), b1 = __builtin_amdgcn_cvt_pk_f32_fp8((int)p1, true);
            const u32x2 hb = hr[64 * j];
            v[j] = (f32x4){bf_lo(hb.x), bf_hi(hb.x), bf_lo(hb.y), bf_hi(hb.y)} + (f32x4){w0 * a0[0] + w1 * b0[0], w0 * a0[1] + w1 * b0[1], w0 * a1[0] + w1 * b1[0], w0 * a1[1] + w1 * b1[1]};
            s += (v[j].x * v[j].x + v[j].y * v[j].y) + (v[j].z * v[j].z + v[j].w * v[j].w); }
        const float rs = 1.0f / sqrtf(wave_sum(s) * (1.f / D) + NORM_EPS);
#pragma unroll
        for (int j = 0; j < 4; ++j) if (live) xr[64 * j] = v[j] * rs * gv[j];
    }
}

constexpr int N_PHASES = 9;
__global__ void __launch_bounds__(NTHREADS, 2) mk_fwd(Args args) {
    extern __shared__ __attribute__((aligned(16))) unsigned char lds_raw[];
#define MKFRAME() Frame F; { unsigned l_ = __builtin_amdgcn_mbcnt_hi(~0u, __builtin_amdgcn_mbcnt_lo(~0u, 0u)); asm volatile("" : "+v"(l_)); F.lds = (LAS unsigned char*)lds_raw; F.lane = (int)l_; F.wave = wave0; F.tid = wave0 * 64 + F.lane; \
        F.G = gridDim.x; const int bx_ = blockIdx.x; F.vcu = (F.G % 8 == 0) ? (bx_ % 8) * (F.G / 8) + bx_ / 8 : bx_; }
    LAS unsigned char* const lds0 = (LAS unsigned char*)lds_raw;
    const int wave0 = __builtin_amdgcn_readfirstlane((int)(threadIdx.x >> 6));
    unsigned char* ws = args.ws;
    unsigned* ctl = (unsigned*)(ws + WS_CTL);
    if (threadIdx.x < 64) ((LAS unsigned*)(lds0 + MISC_OFF))[threadIdx.x] = 0u;
    __syncthreads();
    const int lo = args.ph_lo, hi = args.ph_hi, repm = args.rep_mask;
    XcdBarrier bar; bar.bar = ctl + CW_BAR; bar.x = 0; bar.st = nullptr;
    bar = xcd_barrier_post(ctl + CW_BAR, (volatile LAS unsigned*)(lds0 + MISC_OFF));
#ifndef PHASE_MASK
#define PHASE_MASK 0x1ff
#endif
#define IN(k) (((PHASE_MASK >> (k)) & 1) && lo <= (k) && (k) < hi)
#define SEAM(k) do { if (IN(k) && IN((k) + 1)) xcd_barrier(bar); } while (0)
#define REP(k) _Pragma("unroll 1") for (int rep_ = ((repm >> (k)) & 1); rep_ >= 0; --rep_)
#define LIVE (rep_ == 0)

    if (IN(0)) { REP(0) { MKFRAME(); const Args a = load_args(); p0_prologue(F, a); } SEAM(0); }
    if (IN(1)) { REP(1) {
        { MKFRAME(); const Args args = load_args();
          pg8::StaticOrder S; S.init((const bf16_t*)args.out, (const bf16_t*)(ws + WS_WIN), T, 3072, D, F.G, (int)blockIdx.x);
          EpiInProj E{(bf16_t*)(ws + WS_U), args.b_gates, (float*)(ws + WS_KPART), (f32x2*)(ws + WS_STAT), 0};
          pg8::gemm_phase<EpiInProj, pg8::StaticOrder, false, D>(F.lds, F.tid, S, E, nullptr); }
        { MKFRAME(); const Args args = load_args();
          pg8::StaticOrder S; S.init((const bf16_t*)(ws + WS_XN8), (const bf16_t*)(ws + WS_WIN8), T, 4096, D / 2, F.G, (int)blockIdx.x);
          EpiInProj E{(bf16_t*)(ws + WS_U), args.b_gates, (float*)(ws + WS_KPART), (f32x2*)(ws + WS_STAT), 12};
          pg8::gemm_phase<EpiInProj, pg8::StaticOrder, false, D / 2, 0x7a>(F.lds, F.tid, S, E, nullptr); } }
        SEAM(1);
    }
    if (IN(3)) { REP(3) { MKFRAME(); const Args a = load_args(); p3_attention(F, a, LIVE); } SEAM(3); }
    if (IN(4)) { REP(4) {
        MKFRAME(); const Args args = load_args();
        pg8::StaticOrder S; S.init((const bf16_t*)(ws + WS_U), (const bf16_t*)(ws + WS_WOUT), T, D, D, F.G, (int)blockIdx.x);
        EpiOutProj E{args.x, (bf16_t*)(ws + WS_HB)};
        pg8::gemm_phase<EpiOutProj, pg8::StaticOrder, false, D>(F.lds, F.tid, S, E, nullptr); }
        SEAM(4);
    }
    if (IN(5)) { REP(5) { MKFRAME(); const Args a = load_args(); p5_router(F, a, LIVE); } SEAM(5); }
    if (IN(6) || IN(7) || IN(8)) {
        if (threadIdx.x == 0) { LAS int* pref = (LAS int*)(lds0 + PREF_OFF); int acc = 0;
            for (int e = 0; e < NEXP; ++e) { pref[e] = acc; const int c = (int)__hip_atomic_load(ctl + CW_CNT + 64 * e, __ATOMIC_RELAXED, __HIP_MEMORY_SCOPE_AGENT); acc += (c + 255) >> 8; }
            pref[NEXP] = acc; }
        __syncthreads();
    }
    if (IN(6)) { REP(6) {
        typedef pg8::MoeOrder<2, 0, (size_t)512 * D, (size_t)256 * D, D> Ord1;
        typedef pg8::MoeOrder<4, (size_t)256 * DEXP, (size_t)D * DEXP, (size_t)256 * DEXP, 0> Ord2;
        const int G = gridDim.x, total = __builtin_amdgcn_readfirstlane(((const LAS int*)(lds0 + PREF_OFF))[NEXP]);
        const int n1 = 2 * total, r = n1 > G ? n1 - G : 0, early = (n1 > G ? G : n1) / 2;
#pragma unroll 1
        for (int stage = 0; stage < 2; ++stage) {
            MKFRAME();
            Ord1 S; S.pref = (const LAS int*)(F.lds + PREF_OFF); S.c = (int)blockIdx.x; S.A = (const char*)(ws + WS_XN2); S.Bt = (const char*)(ws + WS_W13); S.list = (const int*)(ws + WS_LIST);
            S.first = stage == 0 ? 0 : 2 * early; S.limit = stage == 0 ? 2 * early : n1; S.cbase = 0; S.nwg = stage == 0 ? G : (r > 0 ? r : 1);
            EpiMoe1 E{ws + WS_HID, (const float*)(ws + WS_RSP), ctl + CW_CNT};
            pg8::gemm_phase<EpiMoe1, Ord1, true, D / 2, 0x7a>(F.lds, F.tid, S, E, ctl + CW_CNT);
            if (stage == 0) xcd_barrier(bar);
        }
#pragma unroll 1
        for (int stage = 1; stage < 3; ++stage) {
            MKFRAME();
            Ord2 S; S.pref = (const LAS int*)(F.lds + PREF_OFF); S.c = (int)blockIdx.x; S.A = (const char*)(ws + WS_HID); S.Bt = (const char*)(ws + WS_W2); S.list = (const int*)(ws + WS_LIST);
            S.first = stage == 2 ? 4 * early : 0; S.limit = stage == 1 ? 4 * early : 4 * total; S.cbase = stage == 1 ? r : 0; S.nwg = stage == 1 ? G - r : G;
            EpiMoe2 E{ws + WS_YP};
            pg8::gemm_phase<EpiMoe2, Ord2, false, DEXP / 2, 0x7b>(F.lds, F.tid, S, E, nullptr);
            if (stage == 1) xcd_barrier(bar);
        } }
        SEAM(6);
    }
    if (IN(8)) { REP(8) { MKFRAME(); const Args a = load_args(); p8_final(F, a, LIVE); } }
#undef IN
#undef SEAM
#undef REP
#undef LIVE
}

#ifndef MK_REP_MASK
#define MK_REP_MASK 0x000
#endif
#ifndef MK_SPLIT
#define MK_SPLIT 0
#endif
extern "C" void kernel_launch(void* const* d_in, const int* in_sizes, int n_in, void* d_out, int out_size, void* d_ws, size_t ws_size, hipStream_t stream) {
    static int grid = 0;
    if (grid == 0) {
        if (n_in != 19 || out_size != T * D || ws_size < WS_END) { fprintf(stderr, "kernel_launch: unexpected problem (n_in %d, out %d, ws %zu)\n", n_in, out_size, ws_size); grid = -1; return; }
        int dev = 0, cus = 0, per_cu = 0;
        if (hipGetDevice(&dev) != hipSuccess || hipDeviceGetAttribute(&cus, hipDeviceAttributeMultiprocessorCount, dev) != hipSuccess) { grid = -1; return; }
        if (hipFuncSetAttribute((const void*)mk_fwd, hipFuncAttributeMaxDynamicSharedMemorySize, LDS_BYTES) != hipSuccess) { fprintf(stderr, "kernel_launch: hipFuncSetAttribute failed\n"); grid = -1; return; }
        if (hipOccupancyMaxActiveBlocksPerMultiprocessor(&per_cu, (const void*)mk_fwd, NTHREADS, LDS_BYTES) != hipSuccess || per_cu < 1) fprintf(stderr, "kernel_launch: occupancy query reports %d\n", per_cu);
        (void)hipGetLastError();
        grid = cus;
    }
    if (grid < 0) return;
    if (hipMemsetAsync((char*)d_ws + WS_CTL, 0, CTL_ZERO_BYTES, stream) != hipSuccess) return;
    Args a{};
    a.x = (const float*)d_in[0]; a.norm_mix_g = (const float*)d_in[1]; a.w_in = (const float*)d_in[2]; a.b_gates = (const float*)d_in[3]; a.ln_g = (const float*)d_in[4]; a.ln_b = (const float*)d_in[5];
    a.w_spatial = (const float*)d_in[6]; a.b_spatial = (const float*)d_in[7]; a.rel_bias = (const float*)d_in[8]; a.w_out = (const float*)d_in[9]; a.norm_ffn_g = (const float*)d_in[10];
    a.w_gr = (const float*)d_in[11]; a.b_gr = (const float*)d_in[12]; a.w_er = (const float*)d_in[13]; a.b_er = (const float*)d_in[14]; a.w1 = (const float*)d_in[15]; a.w3 = (const float*)d_in[16]; a.w2 = (const float*)d_in[17];
    a.norm_final_g = (const float*)d_in[18]; a.out = (float*)d_out; a.ws = (unsigned char*)d_ws; a.rep_mask = MK_REP_MASK; a.pad = 0;
#if MK_SPLIT
    for (int p = 0; p < N_PHASES; ++p) { a.ph_lo = p; a.ph_hi = p + 1; hipLaunchKernelGGL(mk_fwd, dim3(grid), dim3(NTHREADS), LDS_BYTES, stream, a); }
#else
    a.ph_lo = 0; a.ph_hi = N_PHASES; hipLaunchKernelGGL(mk_fwd, dim3(grid), dim3(NTHREADS), LDS_BYTES, stream, a);
#endif
}
```

```cpp
#include <hip/hip_runtime.h>
#include <cstdio>
#include <cstdint>

#define LAS __attribute__((address_space(3)))
#define GAS __attribute__((address_space(1)))
typedef unsigned short bf16_t;
typedef short bf16x8 __attribute__((ext_vector_type(8)));
typedef short s16x4 __attribute__((ext_vector_type(4)));
typedef float f32x4 __attribute__((ext_vector_type(4)));
typedef float f32x2 __attribute__((ext_vector_type(2)));
typedef float f32x16 __attribute__((ext_vector_type(16)));
typedef unsigned u32x4 __attribute__((ext_vector_type(4)));
typedef unsigned u32x2 __attribute__((ext_vector_type(2)));

constexpr int T = 16384, D = 1024, NCOL = 7168, SEQ = 4096, NBATCH = 4, NH = 8, HD = 128;
constexpr int NEXP = 32, DEXP = 256, LCAP = 16384;
constexpr float NORM_EPS = 1e-6f;
constexpr float LOG2E = 1.4426950408889634f;
constexpr int NWAVES = 8, NTHREADS = 512;

constexpr size_t MiB = 1u << 20;
constexpr size_t WS_CTL = 0, CTL_ZERO_BYTES = 1 * MiB;
constexpr size_t WS_WIN = 1 * MiB;
constexpr size_t WS_WIN8 = 7 * MiB;
constexpr size_t WS_XN8 = 212 * MiB;
constexpr size_t WS_WOUT = 15 * MiB;
constexpr size_t WS_WSB = 17 * MiB;
constexpr size_t WS_KPART = 17 * MiB + 256 * 1024;
constexpr size_t WS_RW = 17 * MiB + 768 * 1024;
constexpr size_t WS_STAT = 18 * MiB;
constexpr size_t WS_U = 20 * MiB;
constexpr size_t SEG_BYTES = 32 * MiB;
constexpr size_t WS_VG = WS_U + SEG_BYTES, WS_Q = WS_U + 2 * SEG_BYTES, WS_K = WS_U + 3 * SEG_BYTES, WS_VA = WS_U + 4 * SEG_BYTES, WS_GB = WS_U + 5 * SEG_BYTES;
constexpr size_t WS_XN2 = 52 * MiB;
constexpr size_t WS_W13 = 84 * MiB;
constexpr size_t WS_W2 = 116 * MiB;
constexpr size_t WS_HID = 132 * MiB;
constexpr size_t WS_YP = 152 * MiB;
constexpr size_t WS_LIST = 232 * MiB;
constexpr size_t WS_INV = 234 * MiB;
constexpr size_t WS_WTOK = 235 * MiB;
constexpr size_t WS_RSP = 236 * MiB;
constexpr size_t WS_HB = 192 * MiB;
constexpr size_t WS_END = 238 * MiB;
constexpr int CW_BAR = 4096;
constexpr int CW_CNT = 8192;

constexpr int RING_BYTES = 131072;
constexpr int MISC_OFF = RING_BYTES;
constexpr int PREF_OFF = MISC_OFF + 64;
constexpr int LDS_BYTES = 147456;

typedef __bf16 bf16x2_t __attribute__((ext_vector_type(2)));
__device__ __forceinline__ unsigned cvt_pk_bf16(float lo, float hi) { const f32x2 v = {lo, hi}; const bf16x2_t b = __builtin_convertvector(v, bf16x2_t); return __builtin_bit_cast(unsigned, b); }
__device__ __forceinline__ unsigned cvt_pk4_fp8(float a, float b, float c, float d) { unsigned w = 0u; w = (unsigned)__builtin_amdgcn_cvt_pk_fp8_f32(a, b, (int)w, false); w = (unsigned)__builtin_amdgcn_cvt_pk_fp8_f32(c, d, (int)w, true); return w; }
__device__ __forceinline__ float bf_lo(unsigned w) { return __uint_as_float(w << 16); }
__device__ __forceinline__ float bf_hi(unsigned w) { return __uint_as_float(w & 0xffff0000u); }
__device__ __forceinline__ float wave_sum(float v) {
#pragma unroll
    for (int o = 1; o < 64; o <<= 1) v += __shfl_xor(v, o);
    return v;
}
#define LDS_WAIT() asm volatile("s_waitcnt lgkmcnt(0)" ::: "memory")
#define VM_WAIT() asm volatile("s_waitcnt vmcnt(0)" ::: "memory")

#define XB_TMO      128
#define XB_XCNT(j)  (256  + 64 * (j))
#define XB_XSUB(j)  (1280 + 64 * (j))
#define XB_XGEN(j)  (2304 + 64 * (j))
#define XB_TOP      3328
#define XB_TOPGEN   3392
#define XCD_BAR_WORDS 3456
#define XB_SPIN_CAP (1u << 18)
__device__ __forceinline__ unsigned xb_ld(unsigned* p)              { return __hip_atomic_load(p, __ATOMIC_RELAXED, __HIP_MEMORY_SCOPE_AGENT); }
__device__ __forceinline__ unsigned xb_add(unsigned* p, unsigned v) { return __hip_atomic_fetch_add(p, v, __ATOMIC_RELAXED, __HIP_MEMORY_SCOPE_AGENT); }
__device__ __forceinline__ unsigned xb_xcc_id() { return (unsigned)__builtin_amdgcn_s_getreg((3 << 11) | 20) & 0xFu; }
#define XB_SPIN(cond, bar) do { unsigned _sp = 0; while (cond) { __builtin_amdgcn_s_sleep(1); \
    if ((++_sp & 255u) == 0u) { if (xb_ld(&(bar)[XB_TMO])) break; if (_sp > XB_SPIN_CAP) { atomicAdd(&(bar)[XB_TMO], 1u); break; } } } } while (0)
struct XcdBarrier { unsigned* bar; unsigned x; volatile LAS unsigned* st; };
__device__ __forceinline__ XcdBarrier xcd_barrier_post(unsigned* bar, volatile LAS unsigned* st) {
    XcdBarrier b; b.bar = bar; b.x = xb_xcc_id(); b.st = st;
    if (threadIdx.x == 0) (void)xb_add(&bar[XB_XCNT(b.x)], 1u);
    return b;
}
__device__ __forceinline__ void xcd_barrier_complete(unsigned* bar, unsigned x, unsigned& nloc, unsigned& nx) {
    const unsigned G = gridDim.x * gridDim.y * gridDim.z;
    unsigned sum, cnt, mine, sp = 0u;
    for (;;) {
        sum = 0u; cnt = 0u; mine = 0u;
#pragma unroll
        for (unsigned j = 0; j < 16; ++j) { const unsigned c = xb_ld(&bar[XB_XCNT(j)]); sum += c; cnt += (c > 0u) ? 1u : 0u; mine = (j == x) ? c : mine; }
        if (sum == G) break;
        __builtin_amdgcn_s_sleep(1);
        if ((++sp & 255u) == 0u) { if (xb_ld(&bar[XB_TMO])) break; if (sp > XB_SPIN_CAP) { atomicAdd(&bar[XB_TMO], 1u); break; } }
    }
    nloc = mine > 0u ? mine : 1u; nx = cnt > 0u ? cnt : 1u;
}
__device__ __forceinline__ void xcd_barrier(const XcdBarrier& b) {
    asm volatile("s_waitcnt vmcnt(0)" ::: "memory");
    __syncthreads();
    if (threadIdx.x == 0) {
        unsigned* bar = b.bar;
        __builtin_amdgcn_s_waitcnt(0);
        unsigned nloc = b.st[0], nx = b.st[1];
        if (nloc == 0u) { xcd_barrier_complete(bar, b.x, nloc, nx); b.st[0] = nloc; b.st[1] = nx; }
        const unsigned old = xb_add(&bar[XB_XSUB(b.x)], 1u);
        const unsigned gen = old / nloc;
        if (old + 1u == (gen + 1u) * nloc) {
            __builtin_amdgcn_fence(__ATOMIC_RELEASE, "agent");
            asm volatile("s_waitcnt vmcnt(0)" ::: "memory");
            const unsigned og = xb_add(&bar[XB_TOP], 1u);
            const unsigned tg = og / nx;
            if (og + 1u == (tg + 1u) * nx) xb_add(&bar[XB_TOPGEN], 1u);
            else XB_SPIN(xb_ld(&bar[XB_TOPGEN]) == tg, bar);
            __builtin_amdgcn_fence(__ATOMIC_ACQUIRE, "agent");
            xb_add(&bar[XB_XGEN(b.x)], 1u);
            asm volatile("s_waitcnt vmcnt(0)" ::: "memory");
        } else {
            XB_SPIN(xb_ld(&bar[XB_XGEN(b.x)]) == gen, bar);
            __builtin_amdgcn_fence(__ATOMIC_ACQUIRE, "agent");
            asm volatile("s_waitcnt vmcnt(0)" ::: "memory");
        }
    }
    __syncthreads();
}

namespace pg8 {
constexpr int BM = 256, BK = 64, HALF = 128, HTB = HALF * BK * 2, STAGE_BYTES = 8 * HTB, NXCD = 8, WGM = 8;
__host__ __device__ __forceinline__ int lds_byte(int r, int c) { const int st = (r >> 4) * 2 + (c >> 5), rr = r & 15, cc = c & 31, ob = rr * 64 + cc * 2; return st * 1024 + (ob ^ (((ob >> 9) & 1) << 5)); }
__host__ __device__ __forceinline__ void stage_rc(int b, int& R, int& C) { const int st = b / 1024, sb = b % 1024, swz = sb ^ (((sb >> 9) & 1) << 5); R = (st >> 1) * 16 + swz / 64; C = (st & 1) * 32 + (swz % 64) / 2; }
__host__ __device__ __forceinline__ int perm32(int rho) { const int n = rho >> 4, i = rho & 15; return 8 * (i >> 2) + 4 * n + (i & 3); }

struct Unit { int pm, pn, ex, rt; };

struct StaticOrder {
    int nM, nN, nwg, G, c; const char* A; const char* Bt; size_t tstep;
    __device__ void init(const bf16_t* A_, const bf16_t* Bt_, int M, int N, int K, int G_, int c_) { nM = M / BM; nN = N / BM; nwg = nM * nN; G = G_; c = c_; A = (const char*)A_; Bt = (const char*)Bt_; tstep = (size_t)BM * K * 2; }
    __device__ bool next(int i, Unit& u) const {
        const long L = (long)i * G + c; if (L >= nwg) return false;
        int wgid = (int)L; { const int q = nwg / NXCD, r = nwg % NXCD, xcd = wgid % NXCD, off = wgid / NXCD; wgid = (xcd < r ? xcd * (q + 1) : r * (q + 1) + (xcd - r) * q) + off; }
        const int nig = WGM * nN, gid = wgid / nig, fm = gid * WGM, gsz = (nM - fm) < WGM ? (nM - fm) : WGM;
        u.pm = fm + ((wgid % nig) % gsz); u.pn = (wgid % nig) / gsz; u.ex = 0; u.rt = 0; return true;
    }
    __device__ __forceinline__ const char* abase(const Unit& u) const { return A + (size_t)u.pm * tstep; }
    __device__ __forceinline__ const char* bbase(const Unit& u) const { return Bt + (size_t)u.pn * tstep; }
    __device__ __forceinline__ unsigned arow_off(const Unit&, int) const { return 0u; }
};
template <int npn, size_t a_tstep, size_t b_estep, size_t b_tstep, unsigned rowbytes>
struct MoeOrder {
    const LAS int* pref; int c; const char* A; const char* Bt; const int* list;
    int first, limit, cbase, nwg;
    __device__ bool next(int i, Unit& u) const {
        if (c < cbase || c >= cbase + nwg) return false;
        const long L = (long)first + (long)i * nwg + (c - cbase);
        if (L >= (long)limit) return false;
        const int tl = (int)(L / npn); u.pn = (int)(L % npn); u.pm = tl;
        const int ln = (int)__builtin_amdgcn_mbcnt_hi(~0u, __builtin_amdgcn_mbcnt_lo(~0u, 0u));
        const int mine = pref[ln & 31];
        const unsigned long long m = __ballot(ln >= 1 && ln < NEXP && mine <= tl);
        const int e = __builtin_popcountll(m);
        u.ex = e; u.rt = tl - __builtin_amdgcn_readlane(mine, e); return true;
    }
    __device__ __forceinline__ const char* abase(const Unit& u) const { return A + (size_t)u.pm * a_tstep; }
    __device__ __forceinline__ const char* bbase(const Unit& u) const { return Bt + (size_t)u.ex * b_estep + (size_t)u.pn * b_tstep; }
    __device__ __forceinline__ unsigned arow_off(const Unit& u, int r, int cnt_e) const {
        int p = u.rt * 256 + r; p = p < cnt_e ? p : 0;
        const int ent = list[u.ex * LCAP + p];
        return (unsigned)(ent >> 1) * rowbytes;
    }
};

typedef float f32x2v __attribute__((ext_vector_type(2)));
typedef int i32x4_t __attribute__((ext_vector_type(4)));
typedef int i32x8_t __attribute__((ext_vector_type(8)));
__device__ __forceinline__ f32x2v gelu_pk(f32x2v v) {
    const f32x2v av = __builtin_elementwise_abs(v), d = av * 0.2316418882f + 1.0f;
    f32x2v t; t.x = __builtin_amdgcn_rcpf(d.x); t.y = __builtin_amdgcn_rcpf(d.y);
    f32x2v q = t * 0.5307027145f + (-0.7265760135f); q = q * t + 0.7107068705f; q = q * t + (-0.142248368f); q = q * t + 0.127414796f; q = q * t;
    const f32x2v s = (v * v) * (-0.72134752044f);
    f32x2v e; e.x = __builtin_amdgcn_exp2f(s.x); e.y = __builtin_amdgcn_exp2f(s.y);
    const f32x2v m = v * (q * e), r = v - m;
    f32x2v o; o.x = v.x < 0.f ? m.x : r.x; o.y = v.y < 0.f ? m.y : r.y; return o;
}

template <class Epi, class Sched, bool GATHER, int K, int WSCALE = 0>
__device__ __forceinline__ void gemm_phase(LAS unsigned char* lds, const int tid, const Sched& S, const Epi& E, const unsigned* cnts) {
    const int wid = __builtin_amdgcn_readfirstlane(tid >> 6), lane = tid & 63, wr = wid >> 2, wc = wid & 3, fr = lane & 15, fq = lane >> 4;
    const int nt = K / BK;
    unsigned voffA[2], voffB[2]; int stR[2];
#pragma unroll
    for (int i = 0; i < 2; ++i) { int R, C; stage_rc(tid * 16 + i * 8192, R, C); const int Rb = Epi::PERM ? ((R & ~31) + perm32(R & 31)) : R;
        voffA[i] = GATHER ? (unsigned)(C * 2) : (unsigned)(R * K + C) * 2u; voffB[i] = (unsigned)(Rb * K + C) * 2u; stR[i] = R; }
    const size_t kstep = (size_t)(BK * 2);
    const size_t hstep = (size_t)HALF * K * 2;
    const unsigned ldsw = (unsigned)wid * 1024u;
    const int aoff = lds_byte(wr * 64 + fr, fq * 8), boff = lds_byte(wc * 32 + fr, fq * 8);
#define PG8_SA(b, h) (((b) * 2 + (h)) * HTB)
#define PG8_SB(b, h) ((4 + (b) * 2 + (h)) * HTB)
#define PG8_GLDS(gp, bufoff, i) __builtin_amdgcn_global_load_lds((const unsigned*)(gp), (LAS unsigned*)(lds + (bufoff) + ldsw + (i) * 8192), 16, 0, 0)
#define PG8_STAGE(bufoff, gbase, voff) do { _Pragma("unroll") for (int _i = 0; _i < 2; ++_i) PG8_GLDS((const char*)(gbase) + (voff)[_i], bufoff, _i); } while (0)
#define PG8_STAGE_A(bufoff, H, NX, KO) do { _Pragma("unroll") for (int _i = 0; _i < 2; ++_i) { \
        if constexpr (GATHER) { const unsigned _o = (NX) ? offN[H][_i] : offC[H][_i]; PG8_GLDS(gA + _o + voffA[_i] + (KO), bufoff, _i); } \
        else { PG8_GLDS(((NX) ? nA : cA) + (H) * hstep + voffA[_i] + (KO), bufoff, _i); } } } while (0)
#define PG8_LDA(dst, b, h) do { _Pragma("unroll") for (int m = 0; m < 4; ++m) { dst[m].lo = *(const LAS i32x4_t*)(lds + PG8_SA(b, h) + aoff + m * 2048); dst[m].hi = *(const LAS i32x4_t*)(lds + PG8_SA(b, h) + aoff + m * 2048 + 1024); } } while (0)
#define PG8_LDB(dst, b, h) do { _Pragma("unroll") for (int n = 0; n < 2; ++n) { dst[n].lo = *(const LAS i32x4_t*)(lds + PG8_SB(b, h) + boff + n * 2048); dst[n].hi = *(const LAS i32x4_t*)(lds + PG8_SB(b, h) + boff + n * 2048 + 1024); } } while (0)
#define PG8_MMA(ai, bj, At, Bt) do { __builtin_amdgcn_s_setprio(1); if constexpr (WSCALE != 0) asm volatile("s_nop 3" ::: "memory");     \
        _Pragma("unroll") for (int m = 0; m < 4; ++m) _Pragma("unroll") for (int n = 0; n < 2; ++n) { \
        if constexpr (WSCALE != 0) { asm volatile("v_mfma_scale_f32_16x16x128_f8f6f4 %0, %1, %2, %0, %3, %4 op_sel_hi:[0,0,0]" : "+v"(acc[ai][bj][m][n]) : "v"(Bt[n]), "v"(At[m]), "v"(wscale_v), "v"(ascale_v)); } \
        else { const i32x4_t bl_ = Bt[n].lo, bh_ = Bt[n].hi, al_ = At[m].lo, ah_ = At[m].hi;     \
               acc[ai][bj][m][n] = __builtin_amdgcn_mfma_f32_16x16x32_bf16(__builtin_bit_cast(bf16x8, bl_), __builtin_bit_cast(bf16x8, al_), acc[ai][bj][m][n], 0, 0, 0); \
               acc[ai][bj][m][n] = __builtin_amdgcn_mfma_f32_16x16x32_bf16(__builtin_bit_cast(bf16x8, bh_), __builtin_bit_cast(bf16x8, ah_), acc[ai][bj][m][n], 0, 0, 0); } } \
        __builtin_amdgcn_s_setprio(0); } while (0)
#define PG8_WAIT_V(n) asm volatile("s_waitcnt vmcnt(" #n ")" ::: "memory")
#define PG8_WAIT_L(n) asm volatile("s_waitcnt lgkmcnt(" #n ")" ::: "memory")
#define PG8_BAR __builtin_amdgcn_s_barrier()
#define PG8_SCHED __builtin_amdgcn_sched_barrier(0)
    Unit cur, nxt; int ui = 0;
    if (!S.next(0, cur)) return;
    f32x4 acc[2][2][4][2];
#pragma unroll
    for (int a = 0; a < 2; ++a)
#pragma unroll
        for (int b = 0; b < 2; ++b)
#pragma unroll
            for (int m = 0; m < 4; ++m)
#pragma unroll
                for (int n = 0; n < 2; ++n) acc[a][b][m][n] = (f32x4){0.f, 0.f, 0.f, 0.f};
    i32x8_t At[4], B0[2], B1[2];
    const int wscale_v = WSCALE * 0x01010101, ascale_v = 0x7f7f7f7f;
    const char* gA = S.A;
    const char* cA = S.abase(cur); const char* cB = S.bbase(cur);
    const char* nA = cA;
    unsigned offC[2][2], offN[2][2];
    if constexpr (GATHER) {
        const int ce = __builtin_amdgcn_readfirstlane((int)cnts[64 * cur.ex]);
#pragma unroll
        for (int h = 0; h < 2; ++h)
#pragma unroll
            for (int i = 0; i < 2; ++i) { offC[h][i] = S.arow_off(cur, stR[i] + h * HALF, ce); offN[h][i] = offC[h][i]; }
    } else {
#pragma unroll
        for (int h = 0; h < 2; ++h)
#pragma unroll
            for (int i = 0; i < 2; ++i) { offC[h][i] = 0u; offN[h][i] = 0u; }
    }
    PG8_STAGE(PG8_SB(0, 0), cB, voffB); PG8_STAGE(PG8_SB(0, 1), cB + hstep, voffB); PG8_STAGE_A(PG8_SA(0, 0), 0, false, 0); PG8_STAGE_A(PG8_SA(0, 1), 1, false, 0);
    if (wr == 1) PG8_BAR;
    PG8_WAIT_V(2); PG8_BAR;
    PG8_STAGE(PG8_SB(1, 0), cB + kstep, voffB); PG8_STAGE_A(PG8_SA(1, 0), 0, false, kstep); PG8_STAGE(PG8_SB(1, 1), cB + hstep + kstep, voffB);
    PG8_WAIT_V(6); PG8_BAR;
    for (;;) {
        const bool has_next = S.next(ui + 1, nxt);
        nA = has_next ? S.abase(nxt) : cA; const char* nB = has_next ? S.bbase(nxt) : cB;
        if constexpr (GATHER) {
            if (has_next) { const int ce = __builtin_amdgcn_readfirstlane((int)cnts[64 * nxt.ex]);
#pragma unroll
                for (int h = 0; h < 2; ++h)
#pragma unroll
                    for (int i = 0; i < 2; ++i) offN[h][i] = S.arow_off(nxt, stR[i] + h * HALF, ce);
            } else {
#pragma unroll
                for (int h = 0; h < 2; ++h)
#pragma unroll
                    for (int i = 0; i < 2; ++i) offN[h][i] = offC[h][i];
            }
        }
#pragma unroll 1
        for (int t = 0; t < nt; t += 2) {
            const bool last = (t == nt - 2);
            const size_t k1 = (size_t)(t + 1) * kstep;
            const size_t k2 = last ? 0 : (size_t)(t + 2) * kstep, k3 = k2 + kstep;
            const char* b2 = last ? nB : cB + (size_t)(t + 2) * kstep; const char* b3 = b2 + kstep;
            PG8_LDB(B0, 0, 0); PG8_LDB(B1, 0, 1); PG8_SCHED; PG8_LDA(At, 0, 0); PG8_STAGE_A(PG8_SA(1, 1), 1, false, k1);
            PG8_WAIT_V(8); PG8_WAIT_L(0); PG8_BAR; PG8_MMA(0, 0, At, B0); PG8_MMA(0, 1, At, B1); PG8_BAR; PG8_SCHED;
            PG8_LDA(At, 0, 1); PG8_STAGE(PG8_SB(0, 0), b2, voffB); PG8_STAGE(PG8_SB(0, 1), b2 + hstep, voffB); PG8_STAGE_A(PG8_SA(0, 0), 0, last, k2);
            PG8_WAIT_V(8); PG8_WAIT_L(0); PG8_BAR; PG8_MMA(1, 0, At, B0); PG8_MMA(1, 1, At, B1); PG8_BAR; PG8_SCHED;
            PG8_LDB(B0, 1, 0); PG8_LDB(B1, 1, 1); PG8_SCHED; PG8_LDA(At, 1, 0); PG8_STAGE_A(PG8_SA(0, 1), 1, last, k2);
            PG8_WAIT_V(8); PG8_WAIT_L(0); PG8_BAR; PG8_MMA(0, 0, At, B0); PG8_MMA(0, 1, At, B1); PG8_BAR; PG8_SCHED;
            PG8_LDA(At, 1, 1); PG8_STAGE(PG8_SB(1, 0), b3, voffB); PG8_STAGE(PG8_SB(1, 1), b3 + hstep, voffB); PG8_STAGE_A(PG8_SA(1, 0), 0, last, k3);
            PG8_WAIT_V(8); PG8_WAIT_L(0); PG8_BAR; PG8_MMA(1, 0, At, B0); PG8_MMA(1, 1, At, B1); PG8_BAR; PG8_SCHED;
        }
        if (wr == 0) PG8_BAR;
        if constexpr (WSCALE != 0) asm volatile("s_nop 15\n\ts_nop 7" ::: "memory");
        E(acc, cur, wr, wc, fr, fq);
        if (!has_next) break;
#pragma unroll
        for (int a = 0; a < 2; ++a)
#pragma unroll
            for (int b = 0; b < 2; ++b)
#pragma unroll
                for (int m = 0; m < 4; ++m)
#pragma unroll
                    for (int n = 0; n < 2; ++n) acc[a][b][m][n] = (f32x4){0.f, 0.f, 0.f, 0.f};
        cur = nxt; cA = nA; cB = nB; ++ui;
#pragma unroll
        for (int h = 0; h < 2; ++h)
#pragma unroll
            for (int i = 0; i < 2; ++i) offC[h][i] = offN[h][i];
        if (wr == 1) PG8_BAR;
    }
    PG8_WAIT_V(0);
    PG8_BAR;
#undef PG8_SA
#undef PG8_SB
#undef PG8_GLDS
#undef PG8_STAGE
#undef PG8_STAGE_A
#undef PG8_LDA
#undef PG8_LDB
#undef PG8_MMA
#undef PG8_WAIT_V
#undef PG8_WAIT_L
#undef PG8_BAR
#undef PG8_SCHED
}
}

struct EpiInProj {
    static constexpr bool PERM = true;
    bf16_t* seg0; const float* b_gates; float* kpart; f32x2* stats; int pn_off;
    __device__ __forceinline__ void operator()(const f32x4 (&acc)[2][2][4][2], const pg8::Unit& u_, int wr, int wc, int fr, int fq) const {
        pg8::Unit u = u_; u.pn += pn_off;
        const int row0 = u.pm * 256 + wr * 64 + fr;
        if (u.pn < 8) {
            const int ch0 = 128 * u.pn + 16 * wc + 4 * fq;
            f32x4 bv[2];
#pragma unroll
            for (int bj = 0; bj < 2; ++bj) bv[bj] = *(const f32x4*)(b_gates + ch0 + 64 * bj);
#pragma unroll
            for (int ai = 0; ai < 2; ++ai)
#pragma unroll
                for (int m = 0; m < 4; ++m) { bf16_t* rowp = seg0 + (size_t)(row0 + ai * 128 + m * 16) * D + ch0;
#pragma unroll
                    for (int bj = 0; bj < 2; ++bj) { const f32x4 uu = acc[ai][bj][m][0], gg = acc[ai][bj][m][1] + bv[bj];
                        const pg8::f32x2v a = pg8::gelu_pk((pg8::f32x2v){uu[0], uu[1]}), b = pg8::gelu_pk((pg8::f32x2v){uu[2], uu[3]});
                        float sg[4];
#pragma unroll
                        for (int j = 0; j < 4; ++j) sg[j] = __builtin_amdgcn_rcpf(1.0f + __builtin_amdgcn_exp2f(-LOG2E * gg[j]));
                        u32x2 w; w.x = cvt_pk_bf16(a.x * sg[0], a.y * sg[1]); w.y = cvt_pk_bf16(b.x * sg[2], b.y * sg[3]);
                        *(u32x2*)(rowp + 64 * bj) = w; } }
            return;
        }
        const int seg = (u.pn >> 2) - 1;
        const int colt = (u.pn & 3) * 256, col0 = colt + wc * 32 + 8 * fq;
        bf16_t* base = seg0 + (size_t)seg * (SEG_BYTES / 2);
        if (seg == 1) {
#pragma unroll
            for (int ai = 0; ai < 2; ++ai)
#pragma unroll
                for (int m = 0; m < 4; ++m) { bf16_t* rowp = base + (size_t)(row0 + ai * 128 + m * 16) * D + col0; float s1 = 0.f, s2 = 0.f;
#pragma unroll
                    for (int bj = 0; bj < 2; ++bj) { const f32x4 v0 = acc[ai][bj][m][0], v1 = acc[ai][bj][m][1];
                        const pg8::f32x2v a = pg8::gelu_pk((pg8::f32x2v){v0[0], v0[1]}), b = pg8::gelu_pk((pg8::f32x2v){v0[2], v0[3]}), c = pg8::gelu_pk((pg8::f32x2v){v1[0], v1[1]}), d = pg8::gelu_pk((pg8::f32x2v){v1[2], v1[3]});
                        s1 += ((a.x + a.y) + (b.x + b.y)) + ((c.x + c.y) + (d.x + d.y));
                        s2 += ((a.x * a.x + a.y * a.y) + (b.x * b.x + b.y * b.y)) + ((c.x * c.x + c.y * c.y) + (d.x * d.x + d.y * d.y));
                        u32x4 w; w.x = cvt_pk_bf16(a.x, a.y); w.y = cvt_pk_bf16(b.x, b.y); w.z = cvt_pk_bf16(c.x, c.y); w.w = cvt_pk_bf16(d.x, d.y);
                        *(u32x4*)(rowp + bj * 128) = w; }
                    s1 += __shfl_xor(s1, 16); s1 += __shfl_xor(s1, 32); s2 += __shfl_xor(s2, 16); s2 += __shfl_xor(s2, 32);
                    if (fq == 0) stats[(size_t)(row0 + ai * 128 + m * 16) * 16 + (u.pn & 3) * 4 + wc] = (f32x2){s1, s2}; }
        } else if (seg == 5) {
            const float* bp = b_gates + D + col0;
            f32x4 bv[2][2];
#pragma unroll
            for (int bj = 0; bj < 2; ++bj)
#pragma unroll
                for (int n = 0; n < 2; ++n) bv[bj][n] = *(const f32x4*)(bp + bj * 128 + 4 * n);
#pragma unroll
            for (int ai = 0; ai < 2; ++ai)
#pragma unroll
                for (int m = 0; m < 4; ++m) { bf16_t* rowp = base + (size_t)(row0 + ai * 128 + m * 16) * D + col0;
#pragma unroll
                    for (int bj = 0; bj < 2; ++bj) { f32x4 v0 = acc[ai][bj][m][0] + bv[bj][0], v1 = acc[ai][bj][m][1] + bv[bj][1];
#pragma unroll
                        for (int j = 0; j < 4; ++j) { v0[j] = __builtin_amdgcn_rcpf(1.0f + __builtin_amdgcn_exp2f(-LOG2E * v0[j])); v1[j] = __builtin_amdgcn_rcpf(1.0f + __builtin_amdgcn_exp2f(-LOG2E * v1[j])); }
                        u32x2 w; w.x = cvt_pk4_fp8(v0[0], v0[1], v0[2], v0[3]); w.y = cvt_pk4_fp8(v1[0], v1[1], v1[2], v1[3]);
                        *(u32x2*)((unsigned char*)base + (size_t)(row0 + ai * 128 + m * 16) * D + col0 + bj * 128) = w; } }
        } else if (seg == 4) {
            unsigned char* vt = (unsigned char*)base;
            const int pw = 4 * (8 * ((fr >> 2) & 1) + 4 * (fr >> 3) + (fr & 3));
#pragma unroll
            for (int ai = 0; ai < 2; ++ai)
#pragma unroll
                for (int bj = 0; bj < 2; ++bj) {
                    unsigned char* tb = vt + ((size_t)(((u.pm >> 4) * 8 + 2 * (u.pn & 3) + bj) * 64 + 4 * (u.pm & 15) + 2 * ai + wr) * 128 + 32 * wc + 8 * fq) * 64 + pw;
#pragma unroll
                    for (int n = 0; n < 2; ++n)
#pragma unroll
                        for (int i = 0; i < 4; ++i) *(unsigned*)(tb + (4 * n + i) * 64) = cvt_pk4_fp8(acc[ai][bj][0][n][i], acc[ai][bj][1][n][i], acc[ai][bj][2][n][i], acc[ai][bj][3][n][i]); }
        } else {
            if (seg == 3) {
#pragma unroll
                for (int ai = 0; ai < 2; ++ai)
#pragma unroll
                    for (int m = 0; m < 4; ++m)
#pragma unroll
                        for (int bj = 0; bj < 2; ++bj) { const f32x4 v0 = acc[ai][bj][m][0], v1 = acc[ai][bj][m][1];
                            u32x2 w; w.x = cvt_pk4_fp8(v0[0], v0[1], v0[2], v0[3]); w.y = cvt_pk4_fp8(v1[0], v1[1], v1[2], v1[3]);
                            *(u32x2*)((unsigned char*)base + (size_t)(row0 + ai * 128 + m * 16) * D + col0 + bj * 128) = w; }
            } else {
#pragma unroll
            for (int ai = 0; ai < 2; ++ai)
#pragma unroll
                for (int m = 0; m < 4; ++m) { bf16_t* rowp = base + (size_t)(row0 + ai * 128 + m * 16) * D + col0;
#pragma unroll
                    for (int bj = 0; bj < 2; ++bj) { const f32x4 v0 = acc[ai][bj][m][0], v1 = acc[ai][bj][m][1];
                        u32x4 w; w.x = cvt_pk_bf16(v0[0], v0[1]); w.y = cvt_pk_bf16(v0[2], v0[3]); w.z = cvt_pk_bf16(v1[0], v1[1]); w.w = cvt_pk_bf16(v1[2], v1[3]);
                        *(u32x4*)(rowp + bj * 128) = w; } }
            }
            if (seg == 3) {
#pragma unroll
                for (int bj = 0; bj < 2; ++bj)
#pragma unroll
                    for (int n = 0; n < 2; ++n) { f32x4 s = (f32x4){0.f, 0.f, 0.f, 0.f};
#pragma unroll
                        for (int ai = 0; ai < 2; ++ai)
#pragma unroll
                            for (int m = 0; m < 4; ++m) s += acc[ai][bj][m][n];
#pragma unroll
                        for (int o = 1; o < 16; o <<= 1) { s[0] += __shfl_xor(s[0], o); s[1] += __shfl_xor(s[1], o); s[2] += __shfl_xor(s[2], o); s[3] += __shfl_xor(s[3], o); }
                        if (fr == 0) *(f32x4*)(kpart + ((size_t)u.pm * 2 + wr) * D + col0 + bj * 128 + 4 * n) = s; }
            }
        }
    }
};
struct EpiOutProj {
    static constexpr bool PERM = true;
    const float* x; bf16_t* hb;
    __device__ __forceinline__ void operator()(const f32x4 (&acc)[2][2][4][2], const pg8::Unit& u, int wr, int wc, int fr, int fq) const {
        const int row0 = u.pm * 256 + wr * 64 + fr, col0 = u.pn * 256 + wc * 32 + 8 * fq;
#pragma unroll
        for (int ai = 0; ai < 2; ++ai)
#pragma unroll
            for (int m = 0; m < 4; ++m) { const size_t off = (size_t)(row0 + ai * 128 + m * 16) * D + col0;
#pragma unroll
                for (int bj = 0; bj < 2; ++bj) { const f32x4 h0 = *(const f32x4*)(x + off + bj * 128) + acc[ai][bj][m][0], h1 = *(const f32x4*)(x + off + bj * 128 + 4) + acc[ai][bj][m][1];
                    u32x4 w; w.x = cvt_pk_bf16(h0[0], h0[1]); w.y = cvt_pk_bf16(h0[2], h0[3]); w.z = cvt_pk_bf16(h1[0], h1[1]); w.w = cvt_pk_bf16(h1[2], h1[3]);
                    *(u32x4*)(hb + off + bj * 128) = w; } }
    }
};
struct EpiMoe1 {
    static constexpr bool PERM = true;
    unsigned char* hid;
    const float* rsp; const unsigned* cnt;
    __device__ __forceinline__ void operator()(const f32x4 (&acc)[2][2][4][2], const pg8::Unit& u, int wr, int wc, int fr, int fq) const {
        const int hc0 = 128 * u.pn + 16 * wc + 4 * fq;
        const int ce = __builtin_amdgcn_readfirstlane((int)cnt[64 * u.ex]);
        float rsv[2][4];
#pragma unroll
        for (int ai = 0; ai < 2; ++ai)
#pragma unroll
            for (int m = 0; m < 4; ++m) { const int p = u.rt * 256 + ai * 128 + wr * 64 + m * 16 + fr; rsv[ai][m] = p < ce ? rsp[u.ex * LCAP + p] : 0.f; }
#pragma unroll
        for (int ai = 0; ai < 2; ++ai)
#pragma unroll
            for (int m = 0; m < 4; ++m) { const int r = ai * 128 + wr * 64 + m * 16 + fr; const float rs = rsv[ai][m];
                unsigned char* rowp = hid + (size_t)(u.pm * 256 + r) * DEXP + hc0;
#pragma unroll
                for (int bj = 0; bj < 2; ++bj) { const f32x4 a = acc[ai][bj][m][0] * rs, b = acc[ai][bj][m][1] * rs; f32x4 o;
#pragma unroll
                    for (int j = 0; j < 4; ++j) { const float sg = __builtin_amdgcn_rcpf(1.0f + __builtin_amdgcn_exp2f(-LOG2E * a[j])); o[j] = a[j] * sg * b[j]; }
                    *(unsigned*)(rowp + bj * 64) = cvt_pk4_fp8(o[0], o[1], o[2], o[3]); } }
    }
};
struct EpiMoe2 {
    static constexpr bool PERM = true;
    unsigned char* yp;
    __device__ __forceinline__ void operator()(const f32x4 (&acc)[2][2][4][2], const pg8::Unit& u, int wr, int wc, int fr, int fq) const {
        const int row0 = u.pm * 256 + wr * 64 + fr, col0 = u.pn * 256 + wc * 32 + 8 * fq;
#pragma unroll
        for (int ai = 0; ai < 2; ++ai)
#pragma unroll
            for (int m = 0; m < 4; ++m) { unsigned char* rowp = yp + (size_t)(row0 + ai * 128 + m * 16) * D + col0;
#pragma unroll
                for (int bj = 0; bj < 2; ++bj) { const f32x4 v0 = acc[ai][bj][m][0] * 16.0f, v1 = acc[ai][bj][m][1] * 16.0f;
                    u32x2 w; w.x = cvt_pk4_fp8(v0[0], v0[1], v0[2], v0[3]); w.y = cvt_pk4_fp8(v1[0], v1[1], v1[2], v1[3]);
                    *(u32x2*)(rowp + bj * 128) = w; } }
    }
};

struct Args {
    const float* x; const float* norm_mix_g; const float* w_in; const float* b_gates; const float* ln_g; const float* ln_b; const float* w_spatial; const float* b_spatial;
    const float* rel_bias; const float* w_out; const float* norm_ffn_g; const float* w_gr; const float* b_gr; const float* w_er; const float* b_er;
    const float* w1; const float* w3; const float* w2; const float* norm_final_g;
    float* out; unsigned char* ws; int ph_lo, ph_hi; int rep_mask, pad;
};
struct Frame { LAS unsigned char* lds; int tid, lane, wave, vcu, G; };
__device__ __forceinline__ Args load_args() {
#if defined(__HIP_DEVICE_COMPILE__)
    const __attribute__((address_space(4))) Args* p = (const __attribute__((address_space(4))) Args*)__builtin_amdgcn_kernarg_segment_ptr(); asm volatile("" : "+s"(p));
    Args r; __builtin_memcpy(&r, (const Args*)p, sizeof(Args)); return r;
#else
    return Args{};
#endif
}

__device__ __forceinline__ unsigned off_b(unsigned row, unsigned ch) { return 256u * row + 16u * (ch ^ (((row & 3) << 2) | ((row >> 2) & 3))); }
__device__ __forceinline__ int crow(int r, int hi) { return (r & 3) + 8 * (r >> 2) + 4 * hi; }
__device__ __forceinline__ s16x4 lds_tr(LAS const unsigned char* p) { typedef short v4i16_t __attribute__((ext_vector_type(4))); return __builtin_bit_cast(s16x4, __builtin_amdgcn_ds_read_tr16_b64_v4i16((LAS v4i16_t*)p)); }

struct TDesc { const float* src; int N, k0, n0; unsigned char* dst; int ldd  ; int rmk  , which; float scale  ; };
__device__ __forceinline__ int tdesc_row(const TDesc& d, int n) {
    if (d.rmk == 0) return n;
    if (d.rmk == 3) return 8 * (n >> 2) + 4 * d.which + (n & 3);
    const int sg = n >> 10, j = n & 1023; const int r = sg == 0 ? 8 * (j >> 2) + (j & 3) : sg == 5 ? 8 * (j >> 2) + 4 + (j & 3) : sg == 6 ? 6144 + j : 1024 + n;
    return d.rmk == 1 ? r : r - 3072;
}
__device__ __forceinline__ void titem_load(const TDesc& d, f32x4 (&v)[8], int lane) {
    const float* p = d.src + (size_t)(d.k0 + (lane >> 4)) * d.N + d.n0 + 4 * (lane & 15);
#pragma unroll
    for (int i = 0; i < 8; ++i) v[i] = __builtin_nontemporal_load((const f32x4*)(p + (size_t)(4 * i) * d.N));
}
__device__ __forceinline__ void titem_store(const TDesc& d, const f32x4 (&v)[8], LAS float* scr  , int lane) {
#pragma unroll
    for (int i = 0; i < 8; ++i) *(LAS f32x4*)(scr + (4 * i + (lane >> 4)) * 68 + 4 * (lane & 15)) = v[i];
    LDS_WAIT(); asm volatile("" ::: "memory");
    if (d.scale != 0.f) {
#pragma unroll
        for (int q = 0; q < 2; ++q) { const int n = (lane >> 1) + 32 * q, kh = lane & 1; const LAS float* sp = scr + (16 * kh) * 68 + n; float f[16];
#pragma unroll
            for (int j = 0; j < 16; ++j) f[j] = sp[j * 68] * d.scale;
            u32x4 o; o.x = cvt_pk4_fp8(f[0], f[1], f[2], f[3]); o.y = cvt_pk4_fp8(f[4], f[5], f[6], f[7]); o.z = cvt_pk4_fp8(f[8], f[9], f[10], f[11]); o.w = cvt_pk4_fp8(f[12], f[13], f[14], f[15]);
            *(u32x4*)(d.dst + (size_t)tdesc_row(d, d.n0 + n) * d.ldd + d.k0 + 16 * kh) = o; }
    } else {
#pragma unroll
        for (int q = 0; q < 4; ++q) { const int n = (lane >> 2) + 16 * q, kq = lane & 3; const LAS float* sp = scr + (8 * kq) * 68 + n; float f[8];
#pragma unroll
            for (int j = 0; j < 8; ++j) f[j] = sp[j * 68];
            u32x4 o; o.x = cvt_pk_bf16(f[0], f[1]); o.y = cvt_pk_bf16(f[2], f[3]); o.z = cvt_pk_bf16(f[4], f[5]); o.w = cvt_pk_bf16(f[6], f[7]);
            *(u32x4*)(d.dst + (size_t)tdesc_row(d, d.n0 + n) * d.ldd + (size_t)(d.k0 + 8 * kq) * 2) = o; }
    }
    LDS_WAIT(); asm volatile("" ::: "memory");
}
template <class Gen>
__device__ __forceinline__ void titems_run(const Gen& gen, int first, int stride, int end, LAS float* scr, int lane) {
    for (int it = first; it < end; it += 4 * stride) {
        const bool h1 = it + stride < end, h2 = it + 2 * stride < end, h3 = it + 3 * stride < end;
        const TDesc d0 = gen(it), d1 = gen(h1 ? it + stride : it), d2 = gen(h2 ? it + 2 * stride : it), d3 = gen(h3 ? it + 3 * stride : it);
        f32x4 v0[8], v1[8], v2[8], v3[8];
        titem_load(d0, v0, lane); if (h1) titem_load(d1, v1, lane); if (h2) titem_load(d2, v2, lane); if (h3) titem_load(d3, v3, lane);
        titem_store(d0, v0, scr, lane); if (h1) titem_store(d1, v1, scr, lane); if (h2) titem_store(d2, v2, scr, lane); if (h3) titem_store(d3, v3, scr, lane);
    }
}
template <class RowMap>
__device__ __forceinline__ void transpose_item_fp8(const float* W, int N, int k0, int n0, unsigned char* dst, int ldd, LAS float* scr, int lane, RowMap rm, float scale) {
#pragma unroll 8
    for (int i = 0; i < 32; ++i) { const int kk = 2 * i + (lane >> 5); scr[kk * 33 + (lane & 31)] = W[(size_t)(k0 + kk) * N + n0 + (lane & 31)]; }
    LDS_WAIT(); asm volatile("" ::: "memory");
    const int c = lane & 7;
#pragma unroll
    for (int j = 0; j < 4; ++j) { const int n = (lane >> 3) + 8 * j; const LAS float* s = scr + (8 * c) * 33 + n;
        u32x2 o; o.x = cvt_pk4_fp8(s[0 * 33] * scale, s[1 * 33] * scale, s[2 * 33] * scale, s[3 * 33] * scale); o.y = cvt_pk4_fp8(s[4 * 33] * scale, s[5 * 33] * scale, s[6 * 33] * scale, s[7 * 33] * scale);
        *(u32x2*)(dst + (size_t)rm(n0 + n) * ldd + k0 + 8 * c) = o; }
    LDS_WAIT(); asm volatile("" ::: "memory");
}
template <class RowMap>
__device__ __forceinline__ void transpose_item(const float* W, int N, int k0, int n0, bf16_t* dst, int ldd, LAS float* scr, int lane, RowMap rm) {
#pragma unroll 8
    for (int i = 0; i < 32; ++i) { const int kk = 2 * i + (lane >> 5); scr[kk * 33 + (lane & 31)] = W[(size_t)(k0 + kk) * N + n0 + (lane & 31)]; }
    LDS_WAIT(); asm volatile("" ::: "memory");
    const int c = lane & 7;
#pragma unroll
    for (int j = 0; j < 4; ++j) { const int n = (lane >> 3) + 8 * j; const LAS float* s = scr + (8 * c) * 33 + n;
        u32x4 o; o.x = cvt_pk_bf16(s[0 * 33], s[1 * 33]); o.y = cvt_pk_bf16(s[2 * 33], s[3 * 33]); o.z = cvt_pk_bf16(s[4 * 33], s[5 * 33]); o.w = cvt_pk_bf16(s[6 * 33], s[7 * 33]);
        *(u32x4*)(dst + (size_t)rm(n0 + n) * ldd + k0 + 8 * c) = o; }
    LDS_WAIT(); asm volatile("" ::: "memory");
}
struct RmId { __device__ __forceinline__ int operator()(int n) const { return n; } };
struct RmWin { __device__ __forceinline__ int operator()(int n) const { const int sg = n >> 10, j = n & 1023;
    return sg == 0 ? 8 * (j >> 2) + (j & 3) : sg == 5 ? 8 * (j >> 2) + 4 + (j & 3) : sg == 6 ? 6144 + j : 1024 + n; } };
struct RmWin8 { __device__ __forceinline__ int operator()(int n) const { return RmWin{}(n) - 3072; } };
struct RmW13 { int which; __device__ __forceinline__ int operator()(int j) const { return 8 * (j >> 2) + 4 * which + (j & 3); } };

__device__ __forceinline__ void p0_prologue(const Frame& F, const Args& a) {
    unsigned char* ws = a.ws;
    LAS float* scr = (LAS float*)(F.lds + F.wave * 16384);
    const int gw = F.vcu * NWAVES + F.wave, NGW = F.G * NWAVES;
    bf16_t* win_t = (bf16_t*)(ws + WS_WIN); bf16_t* wout_t = (bf16_t*)(ws + WS_WOUT);
    constexpr int I_IN = (D / 32) * (NCOL / 64), I_OUT = (D / 32) * (D / 64);
    { const float* w_in = a.w_in; unsigned char* wsb_ = ws;
      auto gen = [=](int it) -> TDesc {
          TDesc d; const int nblk = NCOL / 64, kb = it / nblk, nb = it % nblk; const int sg = (64 * nb) >> 10; const bool bf = (sg == 0 || sg == 1 || sg == 5);
          d.src = w_in; d.N = NCOL; d.k0 = 32 * kb; d.n0 = 64 * nb; d.dst = wsb_ + (bf ? WS_WIN : WS_WIN8); d.ldd = bf ? D * 2 : D; d.rmk = bf ? 1 : 2; d.which = 0; d.scale = bf ? 0.f : 32.0f;
          return d; };
      titems_run(gen, gw, NGW, I_IN, scr, F.lane); }
    { const float* w_out = a.w_out; unsigned char* wsb_ = ws;
      auto gen = [=](int it) -> TDesc {
          TDesc d; const int nblk = D / 64, kb = it / nblk, nb = it % nblk;
          d.src = w_out; d.N = D; d.k0 = 32 * kb; d.n0 = 64 * nb; d.dst = wsb_ + WS_WOUT; d.ldd = D * 2; d.rmk = 0; d.which = 0; d.scale = 0.f;
          return d; };
      titems_run(gen, gw, NGW, I_OUT, scr, F.lane); }
    bf16_t* xn = (bf16_t*)a.out;
    f32x4 gv[4];
#pragma unroll
    for (int j = 0; j < 4; ++j) gv[j] = *((const f32x4*)a.norm_mix_g + F.lane + 64 * j);
    for (int m = gw; m < T; m += NGW) {
        const f32x4* xr = (const f32x4*)(a.x + (size_t)m * D) + F.lane;
        f32x4 v[4]; float s = 0.f;
#pragma unroll
        for (int j = 0; j < 4; ++j) { v[j] = __builtin_nontemporal_load(xr + 64 * j); s += (v[j].x * v[j].x + v[j].y * v[j].y) + (v[j].z * v[j].z + v[j].w * v[j].w); }
        const float rs = 1.0f / sqrtf(wave_sum(s) * (1.f / D) + NORM_EPS);
        u32x2* o8 = (u32x2*)(xn + (size_t)m * D) + F.lane;
#pragma unroll
        for (int j = 0; j < 4; ++j) { const f32x4 y = v[j] * rs * gv[j]; u32x2 w; w.x = cvt_pk_bf16(y.x, y.y); w.y = cvt_pk_bf16(y.z, y.w); o8[64 * j] = w;
            ((unsigned*)(ws + WS_XN8 + (size_t)m * D))[F.lane + 64 * j] = cvt_pk4_fp8(y.x, y.y, y.z, y.w); }
    }
    { bf16_t* rwh = (bf16_t*)(ws + WS_RW); bf16_t* rwl = rwh + 48 * D;
      for (int i = (blockIdx.x * NTHREADS + F.tid) * 2; i < 48 * D; i += F.G * NTHREADS * 2) {
          const int c = i >> 10, k = i & 1023; float v0 = 0.f, v1 = 0.f;
          if (c < 32) { v0 = a.norm_ffn_g[k] * a.w_er[((size_t)(c >> 3) * D + k) * 8 + (c & 7)]; v1 = a.norm_ffn_g[k + 1] * a.w_er[((size_t)(c >> 3) * D + k + 1) * 8 + (c & 7)]; }
          else if (c < 36) { v0 = a.norm_ffn_g[k] * a.w_gr[k * 4 + (c - 32)]; v1 = a.norm_ffn_g[k + 1] * a.w_gr[(k + 1) * 4 + (c - 32)]; }
          const unsigned hi = cvt_pk_bf16(v0, v1);
          *(unsigned*)(rwh + i) = hi; *(unsigned*)(rwl + i) = cvt_pk_bf16(v0 - bf_lo(hi), v1 - bf_hi(hi)); } }
    bf16_t* wsb = (bf16_t*)(ws + WS_WSB);
    for (int i = (blockIdx.x * NTHREADS + F.tid) * 2; i < 8 * 128 * 128; i += F.G * NTHREADS * 2) {
        const int s = i & 127, t = (i >> 7) & 127;
        const float v0 = (s <= t) ? a.w_spatial[i] : 0.f, v1 = (s + 1 <= t) ? a.w_spatial[i + 1] : 0.f;
        *(unsigned*)(wsb + i) = cvt_pk_bf16(v0, v1);
    }
}

constexpr int GM_WSL = 98304, GM_STAT = 90112;
__device__ __forceinline__ void gmlp_load_ws(const Frame& F, const Args& a, int g) {
    const bf16_t* wsb = (const bf16_t*)(a.ws + WS_WSB);
    for (int i = F.tid; i < 128 * 16; i += NTHREADS) { const int row = i >> 4, ch = i & 15; *(LAS u32x4*)(F.lds + GM_WSL + off_b(row, ch)) = *(const u32x4*)(wsb + ((size_t)g * 128 + row) * 128 + ch * 8); }
}
__device__ __forceinline__ void gmlp_chunk(const Frame& F, const Args& a, int row0, int g, const bool live) {
    asm volatile("" : "+s"(row0), "+s"(g));
    int tid_ = F.tid; asm volatile("" : "+v"(tid_));
    unsigned char* ws = a.ws;
    bf16_t* Ub = (bf16_t*)(ws + WS_U); const bf16_t* VG = (const bf16_t*)(ws + WS_VG);
    const f32x2* stats = (const f32x2*)(ws + WS_STAT);
    LAS unsigned char* VN = F.lds;
    LAS unsigned char* WSL = F.lds + GM_WSL;
    LAS float* MEAN = (LAS float*)(F.lds + GM_STAT); LAS float* RSTD = MEAN + 128;
    const int lane = tid_ & 63, wid = __builtin_amdgcn_readfirstlane(tid_ >> 6), r32 = lane & 31, hh = lane >> 5;
    const int mych = tid_ & 15;
    const f32x4 lg0 = *(const f32x4*)(a.ln_g + g * 128 + mych * 8), lg1 = *(const f32x4*)(a.ln_g + g * 128 + mych * 8 + 4);
    const f32x4 lb0 = *(const f32x4*)(a.ln_b + g * 128 + mych * 8), lb1 = *(const f32x4*)(a.ln_b + g * 128 + mych * 8 + 4);
    const int tt = wid >> 1, cp = wid & 1;
    const float bsp = a.b_spatial[g * 128 + tt * 32 + r32];
    __syncthreads();
    if (tid_ < 128) { const f32x2* sp = stats + (size_t)(row0 + tid_) * 16; float s1 = 0.f, s2 = 0.f;
#pragma unroll
        for (int j = 0; j < 16; ++j) { const f32x2 v = sp[j]; s1 += v.x; s2 += v.y; }
        const float mean = s1 * (1.f / 1024.f), var = s2 * (1.f / 1024.f) - mean * mean;
        MEAN[tid_] = mean; RSTD[tid_] = 1.0f / sqrtf(fmaxf(var, 0.f) + NORM_EPS); }
    __syncthreads();
#pragma unroll
    for (int it = 0; it < 4; ++it) { const int s = (tid_ >> 4) + 32 * it;
        const u32x4 raw = *(const u32x4*)(VG + (size_t)(row0 + s) * D + g * 128 + mych * 8);
        const float mu = MEAN[s], rs = RSTD[s];
        f32x4 x0 = (f32x4){bf_lo(raw.x), bf_hi(raw.x), bf_lo(raw.y), bf_hi(raw.y)}, x1 = (f32x4){bf_lo(raw.z), bf_hi(raw.z), bf_lo(raw.w), bf_hi(raw.w)};
        x0 = (x0 - mu) * rs * lg0 + lb0; x1 = (x1 - mu) * rs * lg1 + lb1;
        u32x4 w; w.x = cvt_pk_bf16(x0[0], x0[1]); w.y = cvt_pk_bf16(x0[2], x0[3]); w.z = cvt_pk_bf16(x1[0], x1[1]); w.w = cvt_pk_bf16(x1[2], x1[3]);
        *(LAS u32x4*)(VN + off_b(s, mych)) = w; }
    __syncthreads();
    f32x16 c0 = {}, c1 = {};
    const unsigned blk = (lane >> 4) & 1, q = (lane & 15) >> 2, p = lane & 3;
    for (int ks = 0; ks < 2 * (tt + 1); ++ks) {
        const bf16x8 bfrag = *(const LAS bf16x8*)(WSL + off_b(tt * 32 + r32, 2 * ks + hh));
        bf16x8 af[2];
#pragma unroll
        for (int ct = 0; ct < 2; ++ct) { const int cc = 2 * cp + ct;
            const s16x4 lo = lds_tr(VN + off_b(16 * ks + 8 * hh + q, 4 * cc + 2 * blk + (p >> 1)) + 8 * (p & 1));
            const s16x4 hi = lds_tr(VN + off_b(16 * ks + 8 * hh + 4 + q, 4 * cc + 2 * blk + (p >> 1)) + 8 * (p & 1));
            af[ct] = (bf16x8){lo[0], lo[1], lo[2], lo[3], hi[0], hi[1], hi[2], hi[3]}; }
        c0 = __builtin_amdgcn_mfma_f32_32x32x16_bf16(af[0], bfrag, c0, 0, 0, 0);
        c1 = __builtin_amdgcn_mfma_f32_32x32x16_bf16(af[1], bfrag, c1, 0, 0, 0);
    }
    const size_t rowoff = (size_t)(row0 + tt * 32 + r32) * D + g * 128;
#pragma unroll
    for (int ct = 0; ct < 2; ++ct)
#pragma unroll
        for (int gq = 0; gq < 4; ++gq) { const int c = 32 * (2 * cp + ct) + 8 * gq + 4 * hh;
            const u32x2 uu = *(const u32x2*)(Ub + rowoff + c);
            const f32x16& cc_ = ct ? c1 : c0;
            const float m0 = cc_[4 * gq + 0] + bsp, m1 = cc_[4 * gq + 1] + bsp, m2 = cc_[4 * gq + 2] + bsp, m3 = cc_[4 * gq + 3] + bsp;
            u32x2 o; o.x = cvt_pk_bf16(bf_lo(uu.x) * m0, bf_hi(uu.x) * m1); o.y = cvt_pk_bf16(bf_lo(uu.y) * m2, bf_hi(uu.y) * m3);
            if (live) *(u32x2*)(Ub + rowoff + c) = o; }
}

__constant__ unsigned char T5_BUCKET[128] = {0, 1, 2, 3, 4, 5, 6, 7, 8, 9, 10, 11, 12, 13, 14, 15, 16, 16, 16, 17, 17, 18, 18, 18, 19, 19, 19, 20, 20, 20, 20, 21, 21, 21, 21, 22, 22, 22, 22, 22, 23, 23, 23, 23, 23, 23, 24, 24, 24, 24, 24, 24, 25, 25, 25, 25, 25, 25, 25, 26, 26, 26, 26, 26, 26, 26, 26, 27, 27, 27, 27, 27, 27, 27, 27, 27, 27, 28, 28, 28, 28, 28, 28, 28, 28, 28, 28, 29, 29, 29, 29, 29, 29, 29, 29, 29, 29, 29, 29, 30, 30, 30, 30, 30, 30, 30, 30, 30, 30, 30, 30, 30, 30, 31, 31, 31, 31, 31, 31, 31, 31, 31, 31, 31, 31, 31, 31, 31};
constexpr int AT_KV = 0;
constexpr int AT_KMH = 65536, AT_KML = 73728, AT_TB = 81920;
__device__ __forceinline__ void attn_bh_tables(const Frame& F, const Args& a, int b, int h) {
    LAS unsigned char* lds = F.lds; const int tid = F.tid;
    const float* kpart = (const float*)(a.ws + WS_KPART);
    { const int n = tid >> 5, c4 = (tid & 31) * 4;
      const float* kp = kpart + ((size_t)(b * 16 + n) * 2) * D + h * HD + c4;
      const f32x4 s = (*(const f32x4*)kp + *(const f32x4*)(kp + D)) * (1.0f / 256.0f);
      u32x2 hi; hi.x = cvt_pk_bf16(s[0], s[1]); hi.y = cvt_pk_bf16(s[2], s[3]);
      const f32x4 rsd = (f32x4){s[0] - bf_lo(hi.x), s[1] - bf_hi(hi.x), s[2] - bf_lo(hi.y), s[3] - bf_hi(hi.y)};
      u32x2 lo; lo.x = cvt_pk_bf16(rsd[0], rsd[1]); lo.y = cvt_pk_bf16(rsd[2], rsd[3]);
      const unsigned o = off_b(n, c4 >> 3) + (c4 & 7) * 2, oz = off_b(n + 16, c4 >> 3) + (c4 & 7) * 2;
      *(LAS u32x2*)(lds + AT_KMH + o) = hi; *(LAS u32x2*)(lds + AT_KML + o) = lo;
      *(LAS u32x2*)(lds + AT_KMH + oz) = (u32x2){0u, 0u}; *(LAS u32x2*)(lds + AT_KML + oz) = (u32x2){0u, 0u};
#pragma unroll
      for (int i = 0; i < 3; ++i) { const int j = tid + 512 * i; const int d = 512 - j;
          if (j < 768) ((LAS float*)(lds + AT_TB))[j] = d < 0 ? -INFINITY : a.rel_bias[T5_BUCKET[d > 127 ? 127 : d] * NH + h] * LOG2E - 4.0f; else ((LAS float*)(lds + AT_TB))[j] = -INFINITY; } }
}
__device__ __forceinline__ void attn_unit(const Frame& F, const Args& a, int b, int h, int qb, const bool live) {
    unsigned char* ws = a.ws;
    const bf16_t* Qg = (const bf16_t*)(ws + WS_Q); const unsigned char* K8g = ws + WS_K; const unsigned char* VTg = ws + WS_VA;
    bf16_t* Zg = (bf16_t*)(ws + WS_U); const bf16_t* GBg = (const bf16_t*)(ws + WS_GB);
    const float* kpart = (const float*)(ws + WS_KPART);
    LAS unsigned char* lds = F.lds;
    int lane_ = F.lane, wid_ = F.wave; asm volatile("" : "+v"(lane_), "+s"(wid_));
    const int lane = lane_, wid = wid_, tid = wid * 64 + lane, r32 = lane & 31, hh = lane >> 5;
    const size_t tok_b = (size_t)b * SEQ;
    const int NT = 4 * (qb + 1);
#pragma unroll 1
    for (int cch = ((a.rep_mask >> 10) & 1) ? -2 : 0; cch < 2; ++cch) gmlp_chunk(F, a, (int)tok_b + qb * 256 + 128 * (cch & 1), h, live && cch >= 0);
    asm volatile("s_waitcnt vmcnt(0)" ::: "memory"); __builtin_amdgcn_fence(__ATOMIC_ACQ_REL, "workgroup");
    __syncthreads();
    const unsigned char* ksrc = K8g + (tok_b + 8 * wid + (lane >> 3)) * D + h * HD + 16 * ((lane & 7) ^ ((4 * wid + (lane >> 4)) & 7));
    const unsigned char* vsrc = VTg + (size_t)(b * 8 + h) * (64 * 8192) + (16 * wid + (lane >> 2)) * 64 + 16 * ((lane & 3) ^ ((lane >> 4) & 3));
#define AT_ISSUE(t) do { const int _bo = ((t) & 1) * 32768; \
        __builtin_amdgcn_global_load_lds((const unsigned*)(ksrc + (size_t)(t) * 64 * D), (LAS unsigned*)(lds + AT_KV + _bo + wid * 1024), 16, 0, 0); \
        __builtin_amdgcn_global_load_lds((const unsigned*)(vsrc + (size_t)(t) * 8192), (LAS unsigned*)(lds + AT_KV + _bo + 16384 + wid * 1024), 16, 0, 0); } while (0)
    AT_ISSUE(0);
    const int qi = wid * 32 + r32;
    const size_t qtok = tok_b + (size_t)qb * 256 + qi;
    pg8::i32x8_t q8[2];
    const float QS = 8.0f * 0.08838834764831845f * LOG2E;
    unsigned sel = 0u;
    { f32x16 gacc = {};
#pragma unroll
      for (int ks2 = 0; ks2 < 2; ++ks2) { bf16x8 qraw[4];
#pragma unroll
          for (int e = 0; e < 4; ++e) qraw[e] = *(const bf16x8*)(Qg + qtok * D + h * HD + 64 * ks2 + 32 * hh + 8 * e);
#pragma unroll
          for (int e = 0; e < 4; ++e) { const bf16x8 kh = *(const LAS bf16x8*)(lds + AT_KMH + off_b(r32, 8 * ks2 + 4 * hh + e)), kl = *(const LAS bf16x8*)(lds + AT_KML + off_b(r32, 8 * ks2 + 4 * hh + e));
              gacc = __builtin_amdgcn_mfma_f32_32x32x16_bf16(kh, qraw[e], gacc, 0, 0, 0); gacc = __builtin_amdgcn_mfma_f32_32x32x16_bf16(kl, qraw[e], gacc, 0, 0, 0); }
#pragma unroll
          for (int e = 0; e < 4; ++e) { const bf16x8 qq = qraw[e]; const u32x4 qw = __builtin_bit_cast(u32x4, qq);
              q8[ks2][2 * e] = (int)cvt_pk4_fp8(QS * bf_lo(qw.x), QS * bf_hi(qw.x), QS * bf_lo(qw.y), QS * bf_hi(qw.y)); q8[ks2][2 * e + 1] = (int)cvt_pk4_fp8(QS * bf_lo(qw.z), QS * bf_hi(qw.z), QS * bf_lo(qw.w), QS * bf_hi(qw.w)); } }
      float gv[16];
#pragma unroll
      for (int aa = 0; aa < 2; ++aa)
#pragma unroll
          for (int i = 0; i < 4; ++i) { const float own = gacc[4 * aa + i], oth = __shfl_xor(own, 32);
              gv[8 * aa + i] = hh ? oth : own; gv[8 * aa + 4 + i] = hh ? own : oth; }
#pragma unroll
      for (int n = 0; n < 16; ++n) if (n >= qb) gv[n] = -INFINITY;
#pragma unroll
      for (int k = 0; k < 3; ++k) { float best = -INFINITY; int bi = -1;
#pragma unroll
          for (int n = 0; n < 16; ++n) { const bool c = !((sel >> n) & 1u) && gv[n] > best; best = c ? gv[n] : best; bi = c ? n : bi; }
          if (bi >= 0) sel |= 1u << bi; } }
    const LAS float* TB = (const LAS float*)(lds + AT_TB);
    const float b31 = TB[512 - 127];
    const LAS float* tbl = TB + (512 - r32 + 4 * hh);
    f32x16 o[4]; o[0] = f32x16{}; o[1] = f32x16{}; o[2] = f32x16{}; o[3] = f32x16{};
    f32x16 o5 = f32x16{};
    const pg8::i32x8_t ones8 = {0x38383838, 0x38383838, 0x38383838, 0x38383838, 0x38383838, 0x38383838, 0x38383838, 0x38383838};
    pg8::i32x8_t p8 = {0, 0, 0, 0, 0, 0, 0, 0};
    f32x16 cbf = {};
    const unsigned kb0 = 128u * r32 + 16u * ((2u * hh) ^ ((r32 >> 1) & 7u));
    const unsigned vb0 = 64u * r32 + 16u * ((2u * hh) ^ ((r32 >> 2) & 3u));
    const int sc1 = 0x7f7f7f7f, scq = 0x7c7c7c7c;
#define AT_MMA_SEED(S, KF, QF) asm volatile("v_mfma_scale_f32_32x32x64_f8f6f4 %0, %1, %2, %5, %3, %4 op_sel_hi:[0,0,0]" : "=&v"(S) : "v"(KF), "v"(QF), "v"(sc1), "v"(scq), "v"(cbf))
#define AT_MMA_ACC(S, KF, QF) asm volatile("v_mfma_scale_f32_32x32x64_f8f6f4 %0, %1, %2, %0, %3, %4 op_sel_hi:[0,0,0]" : "+v"(S) : "v"(KF), "v"(QF), "v"(sc1), "v"(scq))
#define AT_SOFTMAX(S, HI) { float pr[16]; \
            _Pragma("unroll") for (int r = 0; r < 16; ++r) pr[r] = __builtin_amdgcn_exp2f(S[r]); \
            _Pragma("unroll") for (int w = 0; w < 8; ++w) p8[w] = HI ? __builtin_amdgcn_cvt_pk_fp8_f32(pr[w], pr[8 + w], p8[w], true) : __builtin_amdgcn_cvt_pk_fp8_f32(pr[w], pr[8 + w], p8[w], false); }
#define AT_TILE(FAST) { pg8::i32x8_t kf[4]; \
            _Pragma("unroll") for (int i = 0; i < 4; ++i) { const pg8::i32x4_t lo = *(const LAS pg8::i32x4_t*)(lds + (kb ^ (64u * (i & 1))) + (i >> 1) * 4096), hi = *(const LAS pg8::i32x4_t*)(lds + (kb ^ (64u * (i & 1)) ^ 16u) + (i >> 1) * 4096); \
                kf[i] = (pg8::i32x8_t){lo[0], lo[1], lo[2], lo[3], hi[0], hi[1], hi[2], hi[3]}; } \
            f32x16 s0, s1; \
            if (!(FAST)) { const LAS float* tp = tbl + (bfar == -INFINITY ? 768 : 0) + (kj0 - rel - wid * 32); \
                _Pragma("unroll") for (int r = 0; r < 16; ++r) s0[r] = tp[(r & 3) + 8 * (r >> 2)]; \
                _Pragma("unroll") for (int r = 0; r < 16; ++r) s1[r] = tp[32 + (r & 3) + 8 * (r >> 2)]; } \
            asm volatile("s_waitcnt lgkmcnt(0)\n\ts_nop 1" ::: "memory"); \
            if (FAST) { AT_MMA_SEED(s0, kf[0], q8[0]); } else { AT_MMA_ACC(s0, kf[0], q8[0]); } \
            AT_MMA_ACC(s0, kf[1], q8[1]); \
            if (FAST) { AT_MMA_SEED(s1, kf[2], q8[0]); } else { AT_MMA_ACC(s1, kf[2], q8[0]); } \
              \
            asm volatile("v_mfma_scale_f32_32x32x64_f8f6f4 %0, %2, %3, %0, %4, %5 op_sel_hi:[0,0,0]\n\ts_nop 7" : "+v"(s1), "+v"(s0) : "v"(kf[3]), "v"(q8[1]), "v"(sc1), "v"(scq)); \
              \
            pg8::i32x8_t vf[4]; \
            _Pragma("unroll") for (int dt = 0; dt < 4; ++dt) { const pg8::i32x4_t lo = *(const LAS pg8::i32x4_t*)(lds + vb + 2048 * dt), hi = *(const LAS pg8::i32x4_t*)(lds + (vb ^ 16u) + 2048 * dt); \
                vf[dt] = (pg8::i32x8_t){lo[0], lo[1], lo[2], lo[3], hi[0], hi[1], hi[2], hi[3]}; } \
            __builtin_amdgcn_sched_barrier(0); \
            AT_SOFTMAX(s0, false) \
            __builtin_amdgcn_sched_barrier(0); \
            AT_SOFTMAX(s1, true) \
            __builtin_amdgcn_sched_barrier(0); \
              \
            asm volatile("s_waitcnt lgkmcnt(0)\n\ts_nop 3" ::: "memory"); \
            _Pragma("unroll") for (int dt = 0; dt < 4; ++dt) \
                asm volatile("v_mfma_f32_32x32x64_f8f6f4 %0, %1, %2, %0" : "+v"(o[dt]) : "v"(p8), "v"(vf[dt])); \
            asm volatile("v_mfma_f32_32x32x64_f8f6f4 %0, %1, %2, %0" : "+v"(o5) : "v"(p8), "v"(ones8)); \
            __builtin_amdgcn_sched_barrier(0); }
#define AT_STEP(FAST) { \
        if (t + 1 < NT) { AT_ISSUE(t + 1); asm volatile("s_waitcnt vmcnt(2)" ::: "memory"); } else { asm volatile("s_waitcnt vmcnt(0)" ::: "memory"); } \
        __builtin_amdgcn_s_barrier(); asm volatile("" ::: "memory"); \
        const int n = t >> 2, kj0 = (t & 3) * 64; \
        unsigned kb = kb0 + AT_KV + (t & 1) * 32768, vb = vb0 + AT_KV + (t & 1) * 32768 + 16384; \
        asm volatile("" : "+v"(kb), "+v"(vb));                                    \
        const int rel = (n == qb) ? 0 : 256;                                      \
        const float bfar = (n == qb || ((sel >> n) & 1u)) ? b31 : -INFINITY;      \
        AT_TILE(FAST) \
        asm volatile("s_waitcnt lgkmcnt(0)" ::: "memory"); __builtin_amdgcn_s_barrier(); asm volatile("" ::: "memory"); }
    const int T1 = qb > 0 ? 4 * (qb - 1) : 0;
#pragma unroll 1
    for (int pass = (a.rep_mask >> 11) & 1; pass >= 0; --pass) {
    int t = 0;
#pragma unroll 1
    while (t < T1) {
        { const float bf = ((sel >> (t >> 2)) & 1u) ? b31 : -INFINITY;
#pragma unroll
          for (int r = 0; r < 16; ++r) cbf[r] = bf; }
#pragma unroll 1
        for (int j = 0; j < 4; ++j, ++t) AT_STEP(1)
    }
    asm volatile("s_nop 15\n\ts_nop 7" : "+v"(o[0]), "+v"(o[1]), "+v"(o[2]), "+v"(o[3]), "+v"(o5));
#pragma unroll 1
    for (; t < NT; ++t) AT_STEP(0)
    asm volatile("s_nop 15\n\ts_nop 7" : "+v"(o[0]), "+v"(o[1]), "+v"(o[2]), "+v"(o[3]), "+v"(o5));
    if (pass) { AT_ISSUE(0); }
    }
#undef AT_STEP
#undef AT_TILE
#undef AT_SOFTMAX
#undef AT_MMA_ACC
#undef AT_MMA_SEED
    asm volatile("s_nop 15\n\ts_nop 15" ::: "memory");
    { LAS unsigned char* stg = lds + AT_KV + wid * 8192;
#pragma unroll
      for (int r = 0; r < 16; ++r) { const int qrow = crow(r, hh); const float li = __builtin_amdgcn_rcpf(o5[r]);
#pragma unroll
          for (int dt = 0; dt < 4; ++dt) *(LAS bf16_t*)(stg + qrow * 256 + (32 * dt + r32) * 2) = (bf16_t)(cvt_pk_bf16(o[dt][r] * li, 0.f) & 0xffffu); }
      asm volatile("s_waitcnt lgkmcnt(0)" ::: "memory");
      const size_t rowbase = (tok_b + (size_t)qb * 256 + wid * 32) * D + h * HD;
#pragma unroll
      for (int i = 0; i < 8; ++i) { const int row = 4 * i + (lane >> 4), ch = lane & 15;
          const u32x4 yv = *(const LAS u32x4*)(stg + row * 256 + ch * 16);
          const size_t off = rowbase + (size_t)row * D + ch * 8;
          const u32x4 zv = *(const u32x4*)(Zg + off); const u32x2 g8 = *(const u32x2*)((const unsigned char*)GBg + off);
          u32x4 ov;
          { const f32x2 g0 = __builtin_amdgcn_cvt_pk_f32_fp8((int)g8.x, false), g1 = __builtin_amdgcn_cvt_pk_f32_fp8((int)g8.x, true), g2 = __builtin_amdgcn_cvt_pk_f32_fp8((int)g8.y, false), g3 = __builtin_amdgcn_cvt_pk_f32_fp8((int)g8.y, true);
            ov.x = cvt_pk_bf16(bf_lo(zv.x) + g0[0] * bf_lo(yv.x), bf_hi(zv.x) + g0[1] * bf_hi(yv.x)); ov.y = cvt_pk_bf16(bf_lo(zv.y) + g1[0] * bf_lo(yv.y), bf_hi(zv.y) + g1[1] * bf_hi(yv.y));
            ov.z = cvt_pk_bf16(bf_lo(zv.z) + g2[0] * bf_lo(yv.z), bf_hi(zv.z) + g2[1] * bf_hi(yv.z)); ov.w = cvt_pk_bf16(bf_lo(zv.w) + g3[0] * bf_lo(yv.w), bf_hi(zv.w) + g3[1] * bf_hi(yv.w)); }
          if (live) *(u32x4*)(Zg + off) = ov; }
      asm volatile("s_waitcnt lgkmcnt(0)" ::: "memory"); }
#undef AT_ISSUE
}
__device__ __forceinline__ void p3_attention(const Frame& F, const Args& a, const bool live) {
    for (int v = F.vcu; v < 256; v += F.G) {
        const int bh = v >> 3, s = v & 7;
        __syncthreads(); gmlp_load_ws(F, a, bh & 7); attn_bh_tables(F, a, bh >> 3, bh & 7);
#pragma unroll 1
        for (int uu = 0; uu < 2; ++uu) attn_unit(F, a, bh >> 3, bh & 7, uu ? s : 15 - s, live);
    }
}

constexpr int P5_CTR_OFF = MISC_OFF + 256;
__device__ __forceinline__ void p5_router(const Frame& F, const Args& a, const bool live) {
    unsigned char* ws = a.ws;
    const int lane = F.lane, wid = F.wave;
    const bf16_t* H = (const bf16_t*)(ws + WS_HB); unsigned char* xn2 = ws + WS_XN2;
    unsigned* cnt = (unsigned*)(ws + WS_CTL) + CW_CNT; int* list = (int*)(ws + WS_LIST); int* inv = (int*)(ws + WS_INV); float* wtok = (float*)(ws + WS_WTOK); float* rsp = (float*)(ws + WS_RSP);
    LAS unsigned* ctr = (LAS unsigned*)(F.lds + P5_CTR_OFF);
    if (F.tid == 0) *ctr = 0u;
    __syncthreads();
    if (wid < 4) {
        const bf16_t* rwh = (const bf16_t*)(ws + WS_RW); const bf16_t* rwl = rwh + 48 * D;
        LAS float* scr = (LAS float*)(F.lds + wid * 16384 + 8704);
        for (int tile = F.vcu * 4 + wid; tile < T / 16; tile += F.G * 4) {
        const int row0 = tile * 16, r = lane & 15, kq = lane >> 4;
        const bf16_t* hrow = H + (size_t)(row0 + r) * D + 8 * kq;
        const bf16_t* bh = rwh + (size_t)r * D + 8 * kq; const bf16_t* bl = rwl + (size_t)r * D + 8 * kq;
        f32x4 acc[3]; acc[0] = (f32x4){0.f, 0.f, 0.f, 0.f}; acc[1] = acc[0]; acc[2] = acc[0];
        float ssq = 0.f;
        const float* gp = a.norm_ffn_g + 8 * kq;
        unsigned char* orow = xn2 + (size_t)(row0 + r) * D + 8 * kq;
#pragma unroll 4
        for (int ks = 0; ks < 32; ++ks) {
            const u32x4 hi = *(const u32x4*)(hrow + 32 * ks);
            const f32x4 x0 = (f32x4){bf_lo(hi.x), bf_hi(hi.x), bf_lo(hi.y), bf_hi(hi.y)}, x1 = (f32x4){bf_lo(hi.z), bf_hi(hi.z), bf_lo(hi.w), bf_hi(hi.w)};
            ssq += ((x0[0] * x0[0] + x0[1] * x0[1]) + (x0[2] * x0[2] + x0[3] * x0[3])) + ((x1[0] * x1[0] + x1[1] * x1[1]) + (x1[2] * x1[2] + x1[3] * x1[3]));
            const bf16x8 ah = __builtin_bit_cast(bf16x8, hi);
            { const f32x4 y0 = x0 * *(const f32x4*)(gp + 32 * ks), y1 = x1 * *(const f32x4*)(gp + 32 * ks + 4);
              u32x2 w; w.x = cvt_pk4_fp8(y0[0], y0[1], y0[2], y0[3]); w.y = cvt_pk4_fp8(y1[0], y1[1], y1[2], y1[3]);
              *(u32x2*)(orow + 32 * ks) = w; }
#pragma unroll
            for (int nt = 0; nt < 3; ++nt) { const bf16x8 wh = *(const bf16x8*)(bh + (size_t)nt * 16 * D + 32 * ks), wlo = *(const bf16x8*)(bl + (size_t)nt * 16 * D + 32 * ks);
                acc[nt] = __builtin_amdgcn_mfma_f32_16x16x32_bf16(ah, wh, acc[nt], 0, 0, 0);
                acc[nt] = __builtin_amdgcn_mfma_f32_16x16x32_bf16(ah, wlo, acc[nt], 0, 0, 0); }
        }
        ssq += __shfl_xor(ssq, 16); ssq += __shfl_xor(ssq, 32);
        const float rs = 1.0f / sqrtf(ssq * (1.f / D) + NORM_EPS);
#pragma unroll
        for (int nt = 0; nt < 3; ++nt)
#pragma unroll
            for (int j = 0; j < 4; ++j) scr[(4 * kq + j) * 49 + 16 * nt + r] = acc[nt][j];
        LDS_WAIT(); asm volatile("" ::: "memory");
        if (lane < 16) {
            const LAS float* lr = scr + lane * 49;
            float gl[4];
#pragma unroll
            for (int g = 0; g < 4; ++g) gl[g] = lr[32 + g] * rs + a.b_gr[g];
            int gi = 0; float gm = gl[0];
#pragma unroll
            for (int g = 1; g < 4; ++g) if (gl[g] > gm) { gm = gl[g]; gi = g; }
            float den = 0.f;
#pragma unroll
            for (int g = 0; g < 4; ++g) den += __expf(gl[g] - gm);
            const float g_w = 1.0f / den;
            float el[8];
#pragma unroll
            for (int e = 0; e < 8; ++e) el[e] = lr[gi * 8 + e] * rs + a.b_er[gi * 8 + e];
            int e0 = 0; float v0 = el[0];
#pragma unroll
            for (int e = 1; e < 8; ++e) if (el[e] > v0) { v0 = el[e]; e0 = e; }
            int e1 = -1; float v1 = -INFINITY;
#pragma unroll
            for (int e = 0; e < 8; ++e) if (e != e0 && el[e] > v1) { v1 = el[e]; e1 = e; }
            const float x1 = __expf(v1 - v0), w0f = g_w / (1.0f + x1), w1f = g_w * x1 / (1.0f + x1);
            if (live) { const int m = row0 + lane;
                const int ex0 = gi * 8 + e0, ex1 = gi * 8 + e1;
                const unsigned p0 = __hip_atomic_fetch_add(cnt + 64 * ex0, 1u, __ATOMIC_RELAXED, __HIP_MEMORY_SCOPE_AGENT);
                const unsigned p1 = __hip_atomic_fetch_add(cnt + 64 * ex1, 1u, __ATOMIC_RELAXED, __HIP_MEMORY_SCOPE_AGENT);
                list[ex0 * LCAP + p0] = m * 2; list[ex1 * LCAP + p1] = m * 2 + 1;
                rsp[ex0 * LCAP + p0] = rs; rsp[ex1 * LCAP + p1] = rs;
                *(int2*)(inv + m * 2) = make_int2(ex0 * LCAP + (int)p0, ex1 * LCAP + (int)p1); *(float2*)(wtok + m * 2) = make_float2(w0f, w1f); }
        }
        LDS_WAIT(); asm volatile("" ::: "memory");
        }
    }
    { LAS float* tscr = (LAS float*)(F.lds + wid * 16384);
      const float* w1 = a.w1; const float* w3 = a.w3; const float* w2 = a.w2; unsigned char* w13 = ws + WS_W13; unsigned char* w2t = ws + WS_W2;
      constexpr int I13 = (D / 32) * (DEXP / 64), I2 = (DEXP / 32) * (D / 64), IPE = 2 * I13 + I2;
      auto gen = [=](int it) -> TDesc {
          TDesc d; const int e = it / IPE; int r = it % IPE;
          if (r < 2 * I13) { const int which = r / I13; r %= I13; const int kb = r / (DEXP / 64), nb = r % (DEXP / 64);
              d.src = (which ? w3 : w1) + (size_t)e * D * DEXP; d.N = DEXP; d.k0 = 32 * kb; d.n0 = 64 * nb; d.dst = w13 + (size_t)e * 512 * D; d.ldd = D; d.rmk = 3; d.which = which; d.scale = 32.0f; }
          else { r -= 2 * I13; const int kb = r / (D / 64), nb = r % (D / 64);
              d.src = w2 + (size_t)e * DEXP * D; d.N = D; d.k0 = 32 * kb; d.n0 = 64 * nb; d.dst = w2t + (size_t)e * D * DEXP; d.ldd = DEXP; d.rmk = 0; d.which = 0; d.scale = 16.0f; }
          return d; };
      const int per_wg = (NEXP * IPE + F.G - 1) / F.G;
      const int base = F.vcu * per_wg;
      const int q4 = per_wg / 24;
      const int restw = (per_wg - 4 * q4 + 3) / 4;
      const int lo_ = wid < 4 ? wid * q4 : 4 * q4 + (wid - 4) * restw;
      int hi_ = wid < 4 ? lo_ + q4 : lo_ + restw; if (hi_ > per_wg) hi_ = per_wg;
      int endi = base + hi_; if (endi > NEXP * IPE) endi = NEXP * IPE;
      titems_run(gen, base + lo_, 1, endi, tscr, lane); }
    __syncthreads();
}

__device__ __forceinline__ void p8_final(const Frame& F, const Args& a, const bool live) {
    const int gw = F.vcu * NWAVES + F.wave, NGW = F.G * NWAVES, lane = F.lane;
    const unsigned char* yp = a.ws + WS_YP;
    const LAS int* pref = (const LAS int*)(F.lds + PREF_OFF);
    f32x4 gv[4];
#pragma unroll
    for (int j = 0; j < 4; ++j) gv[j] = *((const f32x4*)a.norm_final_g + lane + 64 * j);
    for (int m = gw; m < T; m += NGW) {
        f32x4* xr = (f32x4*)(a.out + (size_t)m * D) + lane;
        const u32x2* hr = (const u32x2*)((const bf16_t*)(a.ws + WS_HB) + (size_t)m * D) + lane;
        const int2 iv = *(const int2*)((const int*)(a.ws + WS_INV) + m * 2); const float2 wv = *(const float2*)((const float*)(a.ws + WS_WTOK) + m * 2);
        const int pr0 = 256 * pref[iv.x >> 14] + (iv.x & (LCAP - 1)), pr1 = 256 * pref[iv.y >> 14] + (iv.y & (LCAP - 1));
        const unsigned* y0 = (const unsigned*)(yp + (size_t)pr0 * D) + lane; const unsigned* y1 = (const unsigned*)(yp + (size_t)pr1 * D) + lane;
        const float w0 = wv.x * (1.0f / 16.0f), w1 = wv.y * (1.0f / 16.0f);
        f32x4 v[4]; float s = 0.f;
#pragma unroll
        for (int j = 0; j < 4; ++j) { const unsigned p0 = y0[64 * j], p1 = y1[64 * j];
            const f32x2 a0 = __builtin_amdgcn_cvt_pk_f32_fp8((int)p0, false), a1 = __builtin_amdgcn_cvt_pk_f32_fp8((int)p0, true), b0 = __builtin_amdgcn_cvt_pk_f32_fp8((int)p1, false), b1 = __builtin_amdgcn_cvt_pk_f32_fp8((int)p1, true);
            const u32x2 hb = hr[64 * j];
            v[j] = (f32x4){bf_lo(hb.x), bf_hi(hb.x), bf_lo(hb.y), bf_hi(hb.y)} + (f32x4){w0 * a0[0] + w1 * b0[0], w0 * a0[1] + w1 * b0[1], w0 * a1[0] + w1 * b1[0], w0 * a1[1] + w1 * b1[1]};
            s += (v[j].x * v[j].x + v[j].y * v[j].y) + (v[j].z * v[j].z + v[j].w * v[j].w); }
        const float rs = 1.0f / sqrtf(wave_sum(s) * (1.f / D) + NORM_EPS);
#pragma unroll
        for (int j = 0; j < 4; ++j) if (live) xr[64 * j] = v[j] * rs * gv[j];
    }
}

constexpr int N_PHASES = 9;
__global__ void __launch_bounds__(NTHREADS, 2) mk_fwd(Args args) {
    extern __shared__ __attribute__((aligned(16))) unsigned char lds_raw[];
#define MKFRAME() Frame F; { unsigned l_ = __builtin_amdgcn_mbcnt_hi(~0u, __builtin_amdgcn_mbcnt_lo(~0u, 0u)); asm volatile("" : "+v"(l_)); F.lds = (LAS unsigned char*)lds_raw; F.lane = (int)l_; F.wave = wave0; F.tid = wave0 * 64 + F.lane; \
        F.G = gridDim.x; const int bx_ = blockIdx.x; F.vcu = (F.G % 8 == 0) ? (bx_ % 8) * (F.G / 8) + bx_ / 8 : bx_; }
    LAS unsigned char* const lds0 = (LAS unsigned char*)lds_raw;
    const int wave0 = __builtin_amdgcn_readfirstlane((int)(threadIdx.x >> 6));
    unsigned char* ws = args.ws;
    unsigned* ctl = (unsigned*)(ws + WS_CTL);
    if (threadIdx.x < 64) ((LAS unsigned*)(lds0 + MISC_OFF))[threadIdx.x] = 0u;
    __syncthreads();
    const int lo = args.ph_lo, hi = args.ph_hi, repm = args.rep_mask;
    XcdBarrier bar; bar.bar = ctl + CW_BAR; bar.x = 0; bar.st = nullptr;
    bar = xcd_barrier_post(ctl + CW_BAR, (volatile LAS unsigned*)(lds0 + MISC_OFF));
#ifndef PHASE_MASK
#define PHASE_MASK 0x1ff
#endif
#define IN(k) (((PHASE_MASK >> (k)) & 1) && lo <= (k) && (k) < hi)
#define SEAM(k) do { if (IN(k) && IN((k) + 1)) xcd_barrier(bar); } while (0)
#define REP(k) _Pragma("unroll 1") for (int rep_ = ((repm >> (k)) & 1); rep_ >= 0; --rep_)
#define LIVE (rep_ == 0)

    if (IN(0)) { REP(0) { MKFRAME(); const Args a = load_args(); p0_prologue(F, a); } SEAM(0); }
    if (IN(1)) { REP(1) {
        { MKFRAME(); const Args args = load_args();
          pg8::StaticOrder S; S.init((const bf16_t*)args.out, (const bf16_t*)(ws + WS_WIN), T, 3072, D, F.G, (int)blockIdx.x);
          EpiInProj E{(bf16_t*)(ws + WS_U), args.b_gates, (float*)(ws + WS_KPART), (f32x2*)(ws + WS_STAT), 0};
          pg8::gemm_phase<EpiInProj, pg8::StaticOrder, false, D>(F.lds, F.tid, S, E, nullptr); }
        { MKFRAME(); const Args args = load_args();
          pg8::StaticOrder S; S.init((const bf16_t*)(ws + WS_XN8), (const bf16_t*)(ws + WS_WIN8), T, 4096, D / 2, F.G, (int)blockIdx.x);
          EpiInProj E{(bf16_t*)(ws + WS_U), args.b_gates, (float*)(ws + WS_KPART), (f32x2*)(ws + WS_STAT), 12};
          pg8::gemm_phase<EpiInProj, pg8::StaticOrder, false, D / 2, 0x7a>(F.lds, F.tid, S, E, nullptr); } }
        SEAM(1);
    }
    if (IN(3)) { REP(3) { MKFRAME(); const Args a = load_args(); p3_attention(F, a, LIVE); } SEAM(3); }
    if (IN(4)) { REP(4) {
        MKFRAME(); const Args args = load_args();
        pg8::StaticOrder S; S.init((const bf16_t*)(ws + WS_U), (const bf16_t*)(ws + WS_WOUT), T, D, D, F.G, (int)blockIdx.x);
        EpiOutProj E{args.x, (bf16_t*)(ws + WS_HB)};
        pg8::gemm_phase<EpiOutProj, pg8::StaticOrder, false, D>(F.lds, F.tid, S, E, nullptr); }
        SEAM(4);
    }
    if (IN(5)) { REP(5) { MKFRAME(); const Args a = load_args(); p5_router(F, a, LIVE); } SEAM(5); }
    if (IN(6) || IN(7) || IN(8)) {
        if (threadIdx.x == 0) { LAS int* pref = (LAS int*)(lds0 + PREF_OFF); int acc = 0;
            for (int e = 0; e < NEXP; ++e) { pref[e] = acc; const int c = (int)__hip_atomic_load(ctl + CW_CNT + 64 * e, __ATOMIC_RELAXED, __HIP_MEMORY_SCOPE_AGENT); acc += (c + 255) >> 8; }
            pref[NEXP] = acc; }
        __syncthreads();
    }
    if (IN(6)) { REP(6) {
        typedef pg8::MoeOrder<2, 0, (size_t)512 * D, (size_t)256 * D, D> Ord1;
        typedef pg8::MoeOrder<4, (size_t)256 * DEXP, (size_t)D * DEXP, (size_t)256 * DEXP, 0> Ord2;
        const int G = gridDim.x, total = __builtin_amdgcn_readfirstlane(((const LAS int*)(lds0 + PREF_OFF))[NEXP]);
        const int n1 = 2 * total, r = n1 > G ? n1 - G : 0, early = (n1 > G ? G : n1) / 2;
#pragma unroll 1
        for (int stage = 0; stage < 2; ++stage) {
            MKFRAME();
            Ord1 S; S.pref = (const LAS int*)(F.lds + PREF_OFF); S.c = (int)blockIdx.x; S.A = (const char*)(ws + WS_XN2); S.Bt = (const char*)(ws + WS_W13); S.list = (const int*)(ws + WS_LIST);
            S.first = stage == 0 ? 0 : 2 * early; S.limit = stage == 0 ? 2 * early : n1; S.cbase = 0; S.nwg = stage == 0 ? G : (r > 0 ? r : 1);
            EpiMoe1 E{ws + WS_HID, (const float*)(ws + WS_RSP), ctl + CW_CNT};
            pg8::gemm_phase<EpiMoe1, Ord1, true, D / 2, 0x7a>(F.lds, F.tid, S, E, ctl + CW_CNT);
            if (stage == 0) xcd_barrier(bar);
        }
#pragma unroll 1
        for (int stage = 1; stage < 3; ++stage) {
            MKFRAME();
            Ord2 S; S.pref = (const LAS int*)(F.lds + PREF_OFF); S.c = (int)blockIdx.x; S.A = (const char*)(ws + WS_HID); S.Bt = (const char*)(ws + WS_W2); S.list = (const int*)(ws + WS_LIST);
            S.first = stage == 2 ? 4 * early : 0; S.limit = stage == 1 ? 4 * early : 4 * total; S.cbase = stage == 1 ? r : 0; S.nwg = stage == 1 ? G - r : G;
            EpiMoe2 E{ws + WS_YP};
            pg8::gemm_phase<EpiMoe2, Ord2, false, DEXP / 2, 0x7b>(F.lds, F.tid, S, E, nullptr);
            if (stage == 1) xcd_barrier(bar);
        } }
        SEAM(6);
    }
    if (IN(8)) { REP(8) { MKFRAME(); const Args a = load_args(); p8_final(F, a, LIVE); } }
#undef IN
#undef SEAM
#undef REP
#undef LIVE
}

#ifndef MK_REP_MASK
#define MK_REP_MASK 0x000
#endif
#ifndef MK_SPLIT
#define MK_SPLIT 0
#endif
extern "C" void kernel_launch(void* const* d_in, const int* in_sizes, int n_in, void* d_out, int out_size, void* d_ws, size_t ws_size, hipStream_t stream) {
    static int grid = 0;
    if (grid == 0) {
        if (n_in != 19 || out_size != T * D || ws_size < WS_END) { fprintf(stderr, "kernel_launch: unexpected problem (n_in %d, out %d, ws %zu)\n", n_in, out_size, ws_size); grid = -1; return; }
        int dev = 0, cus = 0, per_cu = 0;
        if (hipGetDevice(&dev) != hipSuccess || hipDeviceGetAttribute(&cus, hipDeviceAttributeMultiprocessorCount, dev) != hipSuccess) { grid = -1; return; }
        if (hipFuncSetAttribute((const void*)mk_fwd, hipFuncAttributeMaxDynamicSharedMemorySize, LDS_BYTES) != hipSuccess) { fprintf(stderr, "kernel_launch: hipFuncSetAttribute failed\n"); grid = -1; return; }
        if (hipOccupancyMaxActiveBlocksPerMultiprocessor(&per_cu, (const void*)mk_fwd, NTHREADS, LDS_BYTES) != hipSuccess || per_cu < 1) fprintf(stderr, "kernel_launch: occupancy query reports %d\n", per_cu);
        (void)hipGetLastError();
        grid = cus;
    }
    if (grid < 0) return;
    if (hipMemsetAsync((char*)d_ws + WS_CTL, 0, CTL_ZERO_BYTES, stream) != hipSuccess) return;
    Args a{};
    a.x = (const float*)d_in[0]; a.norm_mix_g = (const float*)d_in[1]; a.w_in = (const float*)d_in[2]; a.b_gates = (const float*)d_in[3]; a.ln_g = (const float*)d_in[4]; a.ln_b = (const float*)d_in[5];
    a.w_spatial = (const float*)d_in[6]; a.b_spatial = (const float*)d_in[7]; a.rel_bias = (const float*)d_in[8]; a.w_out = (const float*)d_in[9]; a.norm_ffn_g = (const float*)d_in[10];
    a.w_gr = (const float*)d_in[11]; a.b_gr = (const float*)d_in[12]; a.w_er = (const float*)d_in[13]; a.b_er = (const float*)d_in[14]; a.w1 = (const float*)d_in[15]; a.w3 = (const float*)d_in[16]; a.w2 = (const float*)d_in[17];
    a.norm_final_g = (const float*)d_in[18]; a.out = (float*)d_out; a.ws = (unsigned char*)d_ws; a.rep_mask = MK_REP_MASK; a.pad = 0;
#if MK_SPLIT
    for (int p = 0; p < N_PHASES; ++p) { a.ph_lo = p; a.ph_hi = p + 1; hipLaunchKernelGGL(mk_fwd, dim3(grid), dim3(NTHREADS), LDS_BYTES, stream, a); }
#else
    a.ph_lo = 0; a.ph_hi = N_PHASES; hipLaunchKernelGGL(mk_fwd, dim3(grid), dim3(NTHREADS), LDS_BYTES, stream, a);
#endif
}
```

```cpp
#include <hip/hip_runtime.h>
#include <cstdio>
#include <cstdint>

#define LAS __attribute__((address_space(3)))
#define GAS __attribute__((address_space(1)))
typedef unsigned short bf16_t;
typedef short bf16x8 __attribute__((ext_vector_type(8)));
typedef short s16x4 __attribute__((ext_vector_type(4)));
typedef float f32x4 __attribute__((ext_vector_type(4)));
typedef float f32x2 __attribute__((ext_vector_type(2)));
typedef float f32x16 __attribute__((ext_vector_type(16)));
typedef unsigned u32x4 __attribute__((ext_vector_type(4)));
typedef unsigned u32x2 __attribute__((ext_vector_type(2)));

constexpr int T = 16384, D = 1024, NCOL = 7168, SEQ = 4096, NBATCH = 4, NH = 8, HD = 128;
constexpr int NEXP = 32, DEXP = 256, LCAP = 16384;
constexpr float NORM_EPS = 1e-6f;
constexpr float LOG2E = 1.4426950408889634f;
constexpr int NWAVES = 8, NTHREADS = 512;

constexpr size_t MiB = 1u << 20;
constexpr size_t WS_CTL = 0, CTL_ZERO_BYTES = 1 * MiB;
constexpr size_t WS_WIN = 1 * MiB;
constexpr size_t WS_WIN8 = 5 * MiB;
constexpr size_t WS_XN8 = 212 * MiB;
constexpr size_t WS_WOUT = 15 * MiB;
constexpr size_t WS_WSB = 17 * MiB;
constexpr size_t WS_KPART = 17 * MiB + 256 * 1024;
constexpr size_t WS_RW = 17 * MiB + 768 * 1024;
constexpr size_t WS_STAT = 18 * MiB;
constexpr size_t WS_U = 20 * MiB;
constexpr size_t SEG_BYTES = 32 * MiB;
constexpr size_t WS_VG = WS_U + SEG_BYTES, WS_Q = WS_U + 2 * SEG_BYTES, WS_K = WS_U + 3 * SEG_BYTES, WS_VA = WS_U + 4 * SEG_BYTES, WS_GB = WS_U + 5 * SEG_BYTES;
constexpr size_t WS_XN2 = 52 * MiB;
constexpr size_t WS_W13 = 84 * MiB;
constexpr size_t WS_W2 = 116 * MiB;
constexpr size_t WS_HID = 132 * MiB;
constexpr size_t WS_YP = 152 * MiB;
constexpr size_t WS_LIST = 232 * MiB;
constexpr size_t WS_INV = 234 * MiB;
constexpr size_t WS_WTOK = 235 * MiB;
constexpr size_t WS_RSP = 236 * MiB;
constexpr size_t WS_HB = 192 * MiB;
constexpr size_t WS_END = 238 * MiB;
constexpr int CW_BAR = 4096;
constexpr int CW_CNT = 8192;

constexpr int RING_BYTES = 131072;
constexpr int MISC_OFF = RING_BYTES;
constexpr int PREF_OFF = MISC_OFF + 64;
constexpr int LDS_BYTES = 147456;

typedef __bf16 bf16x2_t __attribute__((ext_vector_type(2)));
__device__ __forceinline__ unsigned cvt_pk_bf16(float lo, float hi) { const f32x2 v = {lo, hi}; const bf16x2_t b = __builtin_convertvector(v, bf16x2_t); return __builtin_bit_cast(unsigned, b); }
__device__ __forceinline__ unsigned cvt_pk4_fp8(float a, float b, float c, float d) { unsigned w = 0u; w = (unsigned)__builtin_amdgcn_cvt_pk_fp8_f32(a, b, (int)w, false); w = (unsigned)__builtin_amdgcn_cvt_pk_fp8_f32(c, d, (int)w, true); return w; }
__device__ __forceinline__ float bf_lo(unsigned w) { return __uint_as_float(w << 16); }
__device__ __forceinline__ float bf_hi(unsigned w) { return __uint_as_float(w & 0xffff0000u); }
__device__ __forceinline__ float wave_sum(float v) {
#pragma unroll
    for (int o = 1; o < 64; o <<= 1) v += __shfl_xor(v, o);
    return v;
}
#define LDS_WAIT() asm volatile("s_waitcnt lgkmcnt(0)" ::: "memory")
#define VM_WAIT() asm volatile("s_waitcnt vmcnt(0)" ::: "memory")

#define XB_TMO      128
#define XB_XCNT(j)  (256  + 64 * (j))
#define XB_XSUB(j)  (1280 + 64 * (j))
#define XB_XGEN(j)  (2304 + 64 * (j))
#define XB_TOP      3328
#define XB_TOPGEN   3392
#define XCD_BAR_WORDS 3456
#define XB_SPIN_CAP (1u << 18)
__device__ __forceinline__ unsigned xb_ld(unsigned* p)              { return __hip_atomic_load(p, __ATOMIC_RELAXED, __HIP_MEMORY_SCOPE_AGENT); }
__device__ __forceinline__ unsigned xb_add(unsigned* p, unsigned v) { return __hip_atomic_fetch_add(p, v, __ATOMIC_RELAXED, __HIP_MEMORY_SCOPE_AGENT); }
__device__ __forceinline__ unsigned xb_xcc_id() { return (unsigned)__builtin_amdgcn_s_getreg((3 << 11) | 20) & 0xFu; }
#define XB_SPIN(cond, bar) do { unsigned _sp = 0; while (cond) { __builtin_amdgcn_s_sleep(1); \
    if ((++_sp & 255u) == 0u) { if (xb_ld(&(bar)[XB_TMO])) break; if (_sp > XB_SPIN_CAP) { atomicAdd(&(bar)[XB_TMO], 1u); break; } } } } while (0)
struct XcdBarrier { unsigned* bar; unsigned x; volatile LAS unsigned* st; };
__device__ __forceinline__ XcdBarrier xcd_barrier_post(unsigned* bar, volatile LAS unsigned* st) {
    XcdBarrier b; b.bar = bar; b.x = xb_xcc_id(); b.st = st;
    if (threadIdx.x == 0) (void)xb_add(&bar[XB_XCNT(b.x)], 1u);
    return b;
}
__device__ __forceinline__ void xcd_barrier_complete(unsigned* bar, unsigned x, unsigned& nloc, unsigned& nx) {
    const unsigned G = gridDim.x * gridDim.y * gridDim.z;
    unsigned sum, cnt, mine, sp = 0u;
    for (;;) {
        sum = 0u; cnt = 0u; mine = 0u;
#pragma unroll
        for (unsigned j = 0; j < 16; ++j) { const unsigned c = xb_ld(&bar[XB_XCNT(j)]); sum += c; cnt += (c > 0u) ? 1u : 0u; mine = (j == x) ? c : mine; }
        if (sum == G) break;
        __builtin_amdgcn_s_sleep(1);
        if ((++sp & 255u) == 0u) { if (xb_ld(&bar[XB_TMO])) break; if (sp > XB_SPIN_CAP) { atomicAdd(&bar[XB_TMO], 1u); break; } }
    }
    nloc = mine > 0u ? mine : 1u; nx = cnt > 0u ? cnt : 1u;
}
__device__ __forceinline__ void xcd_barrier(const XcdBarrier& b) {
    asm volatile("s_waitcnt vmcnt(0)" ::: "memory");
    __syncthreads();
    if (threadIdx.x == 0) {
        unsigned* bar = b.bar;
        __builtin_amdgcn_s_waitcnt(0);
        unsigned nloc = b.st[0], nx = b.st[1];
        if (nloc == 0u) { xcd_barrier_complete(bar, b.x, nloc, nx); b.st[0] = nloc; b.st[1] = nx; }
        const unsigned old = xb_add(&bar[XB_XSUB(b.x)], 1u);
        const unsigned gen = old / nloc;
        if (old + 1u == (gen + 1u) * nloc) {
            __builtin_amdgcn_fence(__ATOMIC_RELEASE, "agent");
            asm volatile("s_waitcnt vmcnt(0)" ::: "memory");
            const unsigned og = xb_add(&bar[XB_TOP], 1u);
            const unsigned tg = og / nx;
            if (og + 1u == (tg + 1u) * nx) xb_add(&bar[XB_TOPGEN], 1u);
            else XB_SPIN(xb_ld(&bar[XB_TOPGEN]) == tg, bar);
            __builtin_amdgcn_fence(__ATOMIC_ACQUIRE, "agent");
            xb_add(&bar[XB_XGEN(b.x)], 1u);
            asm volatile("s_waitcnt vmcnt(0)" ::: "memory");
        } else {
            XB_SPIN(xb_ld(&bar[XB_XGEN(b.x)]) == gen, bar);
            __builtin_amdgcn_fence(__ATOMIC_ACQUIRE, "agent");
            asm volatile("s_waitcnt vmcnt(0)" ::: "memory");
        }
    }
    __syncthreads();
}

namespace pg8 {
constexpr int BM = 256, BK = 64, HALF = 128, HTB = HALF * BK * 2, STAGE_BYTES = 8 * HTB, NXCD = 8, WGM = 8;
__host__ __device__ __forceinline__ int lds_byte(int r, int c) { const int st = (r >> 4) * 2 + (c >> 5), rr = r & 15, cc = c & 31, ob = rr * 64 + cc * 2; return st * 1024 + (ob ^ (((ob >> 9) & 1) << 5)); }
__host__ __device__ __forceinline__ void stage_rc(int b, int& R, int& C) { const int st = b / 1024, sb = b % 1024, swz = sb ^ (((sb >> 9) & 1) << 5); R = (st >> 1) * 16 + swz / 64; C = (st & 1) * 32 + (swz % 64) / 2; }
__host__ __device__ __forceinline__ int perm32(int rho) { const int n = rho >> 4, i = rho & 15; return 8 * (i >> 2) + 4 * n + (i & 3); }

struct Unit { int pm, pn, ex, rt; };

struct StaticOrder {
    int nM, nN, nwg, G, c; const char* A; const char* Bt; size_t tstep;
    __device__ void init(const bf16_t* A_, const bf16_t* Bt_, int M, int N, int K, int G_, int c_) { nM = M / BM; nN = N / BM; nwg = nM * nN; G = G_; c = c_; A = (const char*)A_; Bt = (const char*)Bt_; tstep = (size_t)BM * K * 2; }
    __device__ bool next(int i, Unit& u) const {
        const long L = (long)i * G + c; if (L >= nwg) return false;
        int wgid = (int)L; { const int q = nwg / NXCD, r = nwg % NXCD, xcd = wgid % NXCD, off = wgid / NXCD; wgid = (xcd < r ? xcd * (q + 1) : r * (q + 1) + (xcd - r) * q) + off; }
        const int nig = WGM * nN, gid = wgid / nig, fm = gid * WGM, gsz = (nM - fm) < WGM ? (nM - fm) : WGM;
        u.pm = fm + ((wgid % nig) % gsz); u.pn = (wgid % nig) / gsz; u.ex = 0; u.rt = 0; return true;
    }
    __device__ __forceinline__ const char* abase(const Unit& u) const { return A + (size_t)u.pm * tstep; }
    __device__ __forceinline__ const char* bbase(const Unit& u) const { return Bt + (size_t)u.pn * tstep; }
    __device__ __forceinline__ unsigned arow_off(const Unit&, int) const { return 0u; }
};
template <int npn, size_t a_tstep, size_t b_estep, size_t b_tstep, unsigned rowbytes>
struct MoeOrder {
    const LAS int* pref; int c; const char* A; const char* Bt; const int* list;
    int first, limit, cbase, nwg;
    __device__ bool next(int i, Unit& u) const {
        if (c < cbase || c >= cbase + nwg) return false;
        const long L = (long)first + (long)i * nwg + (c - cbase);
        if (L >= (long)limit) return false;
        const int tl = (int)(L / npn); u.pn = (int)(L % npn); u.pm = tl;
        const int ln = (int)__builtin_amdgcn_mbcnt_hi(~0u, __builtin_amdgcn_mbcnt_lo(~0u, 0u));
        const int mine = pref[ln & 31];
        const unsigned long long m = __ballot(ln >= 1 && ln < NEXP && mine <= tl);
        const int e = __builtin_popcountll(m);
        u.ex = e; u.rt = tl - __builtin_amdgcn_readlane(mine, e); return true;
    }
    __device__ __forceinline__ const char* abase(const Unit& u) const { return A + (size_t)u.pm * a_tstep; }
    __device__ __forceinline__ const char* bbase(const Unit& u) const { return Bt + (size_t)u.ex * b_estep + (size_t)u.pn * b_tstep; }
    __device__ __forceinline__ unsigned arow_off(const Unit& u, int r, int cnt_e) const {
        int p = u.rt * 256 + r; p = p < cnt_e ? p : 0;
        const int ent = list[u.ex * LCAP + p];
        return (unsigned)(ent >> 1) * rowbytes;
    }
};

typedef float f32x2v __attribute__((ext_vector_type(2)));
typedef int i32x4_t __attribute__((ext_vector_type(4)));
typedef int i32x8_t __attribute__((ext_vector_type(8)));
__device__ __forceinline__ f32x2v gelu_pk(f32x2v v) {
    const f32x2v av = __builtin_elementwise_abs(v), d = av * 0.2316418882f + 1.0f;
    f32x2v t; t.x = __builtin_amdgcn_rcpf(d.x); t.y = __builtin_amdgcn_rcpf(d.y);
    f32x2v q = t * 0.5307027145f + (-0.7265760135f); q = q * t + 0.7107068705f; q = q * t + (-0.142248368f); q = q * t + 0.127414796f; q = q * t;
    const f32x2v s = (v * v) * (-0.72134752044f);
    f32x2v e; e.x = __builtin_amdgcn_exp2f(s.x); e.y = __builtin_amdgcn_exp2f(s.y);
    const f32x2v m = v * (q * e), r = v - m;
    f32x2v o; o.x = v.x < 0.f ? m.x : r.x; o.y = v.y < 0.f ? m.y : r.y; return o;
}

template <class Epi, class Sched, bool GATHER, int K, int WSCALE = 0>
__device__ __forceinline__ void gemm_phase(LAS unsigned char* lds, const int tid, const Sched& S, const Epi& E, const unsigned* cnts) {
    const int wid = __builtin_amdgcn_readfirstlane(tid >> 6), lane = tid & 63, wr = wid >> 2, wc = wid & 3, fr = lane & 15, fq = lane >> 4;
    const int nt = K / BK;
    unsigned voffA[2], voffB[2]; int stR[2];
#pragma unroll
    for (int i = 0; i < 2; ++i) { int R, C; stage_rc(tid * 16 + i * 8192, R, C); const int Rb = Epi::PERM ? ((R & ~31) + perm32(R & 31)) : R;
        voffA[i] = GATHER ? (unsigned)(C * 2) : (unsigned)(R * K + C) * 2u; voffB[i] = (unsigned)(Rb * K + C) * 2u; stR[i] = R; }
    const size_t kstep = (size_t)(BK * 2);
    const size_t hstep = (size_t)HALF * K * 2;
    const unsigned ldsw = (unsigned)wid * 1024u;
    const int aoff = lds_byte(wr * 64 + fr, fq * 8), boff = lds_byte(wc * 32 + fr, fq * 8);
#define PG8_SA(b, h) (((b) * 2 + (h)) * HTB)
#define PG8_SB(b, h) ((4 + (b) * 2 + (h)) * HTB)
#define PG8_GLDS(gp, bufoff, i) __builtin_amdgcn_global_load_lds((const unsigned*)(gp), (LAS unsigned*)(lds + (bufoff) + ldsw + (i) * 8192), 16, 0, 0)
#define PG8_STAGE(bufoff, gbase, voff) do { _Pragma("unroll") for (int _i = 0; _i < 2; ++_i) PG8_GLDS((const char*)(gbase) + (voff)[_i], bufoff, _i); } while (0)
#define PG8_STAGE_A(bufoff, H, NX, KO) do { _Pragma("unroll") for (int _i = 0; _i < 2; ++_i) { \
        if constexpr (GATHER) { const unsigned _o = (NX) ? offN[H][_i] : offC[H][_i]; PG8_GLDS(gA + _o + voffA[_i] + (KO), bufoff, _i); } \
        else { PG8_GLDS(((NX) ? nA : cA) + (H) * hstep + voffA[_i] + (KO), bufoff, _i); } } } while (0)
#define PG8_LDA(dst, b, h) do { _Pragma("unroll") for (int m = 0; m < 4; ++m) { dst[m].lo = *(const LAS i32x4_t*)(lds + PG8_SA(b, h) + aoff + m * 2048); dst[m].hi = *(const LAS i32x4_t*)(lds + PG8_SA(b, h) + aoff + m * 2048 + 1024); } } while (0)
#define PG8_LDB(dst, b, h) do { _Pragma("unroll") for (int n = 0; n < 2; ++n) { dst[n].lo = *(const LAS i32x4_t*)(lds + PG8_SB(b, h) + boff + n * 2048); dst[n].hi = *(const LAS i32x4_t*)(lds + PG8_SB(b, h) + boff + n * 2048 + 1024); } } while (0)
#define PG8_MMA(ai, bj, At, Bt) do { __builtin_amdgcn_s_setprio(1); if constexpr (WSCALE != 0) asm volatile("s_nop 3" ::: "memory");     \
        _Pragma("unroll") for (int m = 0; m < 4; ++m) _Pragma("unroll") for (int n = 0; n < 2; ++n) { \
        if constexpr (WSCALE != 0) { asm volatile("v_mfma_scale_f32_16x16x128_f8f6f4 %0, %1, %2, %0, %3, %4 op_sel_hi:[0,0,0]" : "+v"(acc[ai][bj][m][n]) : "v"(Bt[n]), "v"(At[m]), "v"(wscale_v), "v"(ascale_v)); } \
        else { const i32x4_t bl_ = Bt[n].lo, bh_ = Bt[n].hi, al_ = At[m].lo, ah_ = At[m].hi;     \
               acc[ai][bj][m][n] = __builtin_amdgcn_mfma_f32_16x16x32_bf16(__builtin_bit_cast(bf16x8, bl_), __builtin_bit_cast(bf16x8, al_), acc[ai][bj][m][n], 0, 0, 0); \
               acc[ai][bj][m][n] = __builtin_amdgcn_mfma_f32_16x16x32_bf16(__builtin_bit_cast(bf16x8, bh_), __builtin_bit_cast(bf16x8, ah_), acc[ai][bj][m][n], 0, 0, 0); } } \
        __builtin_amdgcn_s_setprio(0); } while (0)
#define PG8_WAIT_V(n) asm volatile("s_waitcnt vmcnt(" #n ")" ::: "memory")
#define PG8_WAIT_L(n) asm volatile("s_waitcnt lgkmcnt(" #n ")" ::: "memory")
#define PG8_BAR __builtin_amdgcn_s_barrier()
#define PG8_SCHED __builtin_amdgcn_sched_barrier(0)
    Unit cur, nxt; int ui = 0;
    if (!S.next(0, cur)) return;
    f32x4 acc[2][2][4][2];
#pragma unroll
    for (int a = 0; a < 2; ++a)
#pragma unroll
        for (int b = 0; b < 2; ++b)
#pragma unroll
            for (int m = 0; m < 4; ++m)
#pragma unroll
                for (int n = 0; n < 2; ++n) acc[a][b][m][n] = (f32x4){0.f, 0.f, 0.f, 0.f};
    i32x8_t At[4], B0[2], B1[2];
    const int wscale_v = WSCALE * 0x01010101, ascale_v = 0x7f7f7f7f;
    const char* gA = S.A;
    const char* cA = S.abase(cur); const char* cB = S.bbase(cur);
    const char* nA = cA;
    unsigned offC[2][2], offN[2][2];
    if constexpr (GATHER) {
        const int ce = __builtin_amdgcn_readfirstlane((int)cnts[64 * cur.ex]);
#pragma unroll
        for (int h = 0; h < 2; ++h)
#pragma unroll
            for (int i = 0; i < 2; ++i) { offC[h][i] = S.arow_off(cur, stR[i] + h * HALF, ce); offN[h][i] = offC[h][i]; }
    } else {
#pragma unroll
        for (int h = 0; h < 2; ++h)
#pragma unroll
            for (int i = 0; i < 2; ++i) { offC[h][i] = 0u; offN[h][i] = 0u; }
    }
    PG8_STAGE(PG8_SB(0, 0), cB, voffB); PG8_STAGE(PG8_SB(0, 1), cB + hstep, voffB); PG8_STAGE_A(PG8_SA(0, 0), 0, false, 0); PG8_STAGE_A(PG8_SA(0, 1), 1, false, 0);
    if (wr == 1) PG8_BAR;
    PG8_WAIT_V(2); PG8_BAR;
    PG8_STAGE(PG8_SB(1, 0), cB + kstep, voffB); PG8_STAGE_A(PG8_SA(1, 0), 0, false, kstep); PG8_STAGE(PG8_SB(1, 1), cB + hstep + kstep, voffB);
    PG8_WAIT_V(6); PG8_BAR;
    for (;;) {
        const bool has_next = S.next(ui + 1, nxt);
        nA = has_next ? S.abase(nxt) : cA; const char* nB = has_next ? S.bbase(nxt) : cB;
        if constexpr (GATHER) {
            if (has_next) { const int ce = __builtin_amdgcn_readfirstlane((int)cnts[64 * nxt.ex]);
#pragma unroll
                for (int h = 0; h < 2; ++h)
#pragma unroll
                    for (int i = 0; i < 2; ++i) offN[h][i] = S.arow_off(nxt, stR[i] + h * HALF, ce);
            } else {
#pragma unroll
                for (int h = 0; h < 2; ++h)
#pragma unroll
                    for (int i = 0; i < 2; ++i) offN[h][i] = offC[h][i];
            }
        }
#pragma unroll 1
        for (int t = 0; t < nt; t += 2) {
            const bool last = (t == nt - 2);
            const size_t k1 = (size_t)(t + 1) * kstep;
            const size_t k2 = last ? 0 : (size_t)(t + 2) * kstep, k3 = k2 + kstep;
            const char* b2 = last ? nB : cB + (size_t)(t + 2) * kstep; const char* b3 = b2 + kstep;
            PG8_LDB(B0, 0, 0); PG8_LDB(B1, 0, 1); PG8_SCHED; PG8_LDA(At, 0, 0); PG8_STAGE_A(PG8_SA(1, 1), 1, false, k1);
            PG8_WAIT_V(8); PG8_WAIT_L(0); PG8_BAR; PG8_MMA(0, 0, At, B0); PG8_MMA(0, 1, At, B1); PG8_BAR; PG8_SCHED;
            PG8_LDA(At, 0, 1); PG8_STAGE(PG8_SB(0, 0), b2, voffB); PG8_STAGE(PG8_SB(0, 1), b2 + hstep, voffB); PG8_STAGE_A(PG8_SA(0, 0), 0, last, k2);
            PG8_WAIT_V(8); PG8_WAIT_L(0); PG8_BAR; PG8_MMA(1, 0, At, B0); PG8_MMA(1, 1, At, B1); PG8_BAR; PG8_SCHED;
            PG8_LDB(B0, 1, 0); PG8_LDB(B1, 1, 1); PG8_SCHED; PG8_LDA(At, 1, 0); PG8_STAGE_A(PG8_SA(0, 1), 1, last, k2);
            PG8_WAIT_V(8); PG8_WAIT_L(0); PG8_BAR; PG8_MMA(0, 0, At, B0); PG8_MMA(0, 1, At, B1); PG8_BAR; PG8_SCHED;
            PG8_LDA(At, 1, 1); PG8_STAGE(PG8_SB(1, 0), b3, voffB); PG8_STAGE(PG8_SB(1, 1), b3 + hstep, voffB); PG8_STAGE_A(PG8_SA(1, 0), 0, last, k3);
            PG8_WAIT_V(8); PG8_WAIT_L(0); PG8_BAR; PG8_MMA(1, 0, At, B0); PG8_MMA(1, 1, At, B1); PG8_BAR; PG8_SCHED;
        }
        if (wr == 0) PG8_BAR;
        if constexpr (WSCALE != 0) asm volatile("s_nop 15\n\ts_nop 7" ::: "memory");
        E(acc, cur, wr, wc, fr, fq);
        if (!has_next) break;
#pragma unroll
        for (int a = 0; a < 2; ++a)
#pragma unroll
            for (int b = 0; b < 2; ++b)
#pragma unroll
                for (int m = 0; m < 4; ++m)
#pragma unroll
                    for (int n = 0; n < 2; ++n) acc[a][b][m][n] = (f32x4){0.f, 0.f, 0.f, 0.f};
        cur = nxt; cA = nA; cB = nB; ++ui;
#pragma unroll
        for (int h = 0; h < 2; ++h)
#pragma unroll
            for (int i = 0; i < 2; ++i) offC[h][i] = offN[h][i];
        if (wr == 1) PG8_BAR;
    }
    PG8_WAIT_V(0);
    PG8_BAR;
#undef PG8_SA
#undef PG8_SB
#undef PG8_GLDS
#undef PG8_STAGE
#undef PG8_STAGE_A
#undef PG8_LDA
#undef PG8_LDB
#undef PG8_MMA
#undef PG8_WAIT_V
#undef PG8_WAIT_L
#undef PG8_BAR
#undef PG8_SCHED
}
}

struct EpiInProj {
    static constexpr bool PERM = true;
    bf16_t* seg0; const float* b_gates; float* kpart; f32x2* stats; int pn_off;
    __device__ __forceinline__ void operator()(const f32x4 (&acc)[2][2][4][2], const pg8::Unit& u_, int wr, int wc, int fr, int fq) const {
        pg8::Unit u = u_; u.pn += pn_off;
        const int row0 = u.pm * 256 + wr * 64 + fr;
        if (u.pn < 8) {
            const int ch0 = 128 * u.pn + 16 * wc + 4 * fq;
            f32x4 bv[2];
#pragma unroll
            for (int bj = 0; bj < 2; ++bj) bv[bj] = *(const f32x4*)(b_gates + ch0 + 64 * bj);
#pragma unroll
            for (int ai = 0; ai < 2; ++ai)
#pragma unroll
                for (int m = 0; m < 4; ++m) { bf16_t* rowp = seg0 + (size_t)(row0 + ai * 128 + m * 16) * D + ch0;
#pragma unroll
                    for (int bj = 0; bj < 2; ++bj) { const f32x4 uu = acc[ai][bj][m][0], gg = acc[ai][bj][m][1] + bv[bj];
                        const pg8::f32x2v a = pg8::gelu_pk((pg8::f32x2v){uu[0], uu[1]}), b = pg8::gelu_pk((pg8::f32x2v){uu[2], uu[3]});
                        float sg[4];
#pragma unroll
                        for (int j = 0; j < 4; ++j) sg[j] = __builtin_amdgcn_rcpf(1.0f + __builtin_amdgcn_exp2f(-LOG2E * gg[j]));
                        u32x2 w; w.x = cvt_pk_bf16(a.x * sg[0], a.y * sg[1]); w.y = cvt_pk_bf16(b.x * sg[2], b.y * sg[3]);
                        *(u32x2*)(rowp + 64 * bj) = w; } }
            return;
        }
        const int seg = (u.pn >> 2) - 1;
        const int colt = (u.pn & 3) * 256, col0 = colt + wc * 32 + 8 * fq;
        bf16_t* base = seg0 + (size_t)seg * (SEG_BYTES / 2);
        if (seg == 1) {
#pragma unroll
            for (int ai = 0; ai < 2; ++ai)
#pragma unroll
                for (int m = 0; m < 4; ++m) { bf16_t* rowp = base + (size_t)(row0 + ai * 128 + m * 16) * D + col0; float s1 = 0.f, s2 = 0.f;
#pragma unroll
                    for (int bj = 0; bj < 2; ++bj) { const f32x4 v0 = acc[ai][bj][m][0], v1 = acc[ai][bj][m][1];
                        const pg8::f32x2v a = pg8::gelu_pk((pg8::f32x2v){v0[0], v0[1]}), b = pg8::gelu_pk((pg8::f32x2v){v0[2], v0[3]}), c = pg8::gelu_pk((pg8::f32x2v){v1[0], v1[1]}), d = pg8::gelu_pk((pg8::f32x2v){v1[2], v1[3]});
                        s1 += ((a.x + a.y) + (b.x + b.y)) + ((c.x + c.y) + (d.x + d.y));
                        s2 += ((a.x * a.x + a.y * a.y) + (b.x * b.x + b.y * b.y)) + ((c.x * c.x + c.y * c.y) + (d.x * d.x + d.y * d.y));
                        u32x4 w; w.x = cvt_pk_bf16(a.x, a.y); w.y = cvt_pk_bf16(b.x, b.y); w.z = cvt_pk_bf16(c.x, c.y); w.w = cvt_pk_bf16(d.x, d.y);
                        *(u32x4*)(rowp + bj * 128) = w; }
                    s1 += __shfl_xor(s1, 16); s1 += __shfl_xor(s1, 32); s2 += __shfl_xor(s2, 16); s2 += __shfl_xor(s2, 32);
                    if (fq == 0) stats[(size_t)(row0 + ai * 128 + m * 16) * 16 + (u.pn & 3) * 4 + wc] = (f32x2){s1, s2}; }
        } else if (seg == 5) {
            const float* bp = b_gates + D + col0;
            f32x4 bv[2][2];
#pragma unroll
            for (int bj = 0; bj < 2; ++bj)
#pragma unroll
                for (int n = 0; n < 2; ++n) bv[bj][n] = *(const f32x4*)(bp + bj * 128 + 4 * n);
#pragma unroll
            for (int ai = 0; ai < 2; ++ai)
#pragma unroll
                for (int m = 0; m < 4; ++m) { bf16_t* rowp = base + (size_t)(row0 + ai * 128 + m * 16) * D + col0;
#pragma unroll
                    for (int bj = 0; bj < 2; ++bj) { f32x4 v0 = acc[ai][bj][m][0] + bv[bj][0], v1 = acc[ai][bj][m][1] + bv[bj][1];
#pragma unroll
                        for (int j = 0; j < 4; ++j) { v0[j] = __builtin_amdgcn_rcpf(1.0f + __builtin_amdgcn_exp2f(-LOG2E * v0[j])); v1[j] = __builtin_amdgcn_rcpf(1.0f + __builtin_amdgcn_exp2f(-LOG2E * v1[j])); }
                        u32x2 w; w.x = cvt_pk4_fp8(v0[0], v0[1], v0[2], v0[3]); w.y = cvt_pk4_fp8(v1[0], v1[1], v1[2], v1[3]);
                        *(u32x2*)((unsigned char*)base + (size_t)(row0 + ai * 128 + m * 16) * D + col0 + bj * 128) = w; } }
        } else if (seg == 4) {
            unsigned char* vt = (unsigned char*)base;
            const int pw = 4 * (8 * ((fr >> 2) & 1) + 4 * (fr >> 3) + (fr & 3));
#pragma unroll
            for (int ai = 0; ai < 2; ++ai)
#pragma unroll
                for (int bj = 0; bj < 2; ++bj) {
                    unsigned char* tb = vt + ((size_t)(((u.pm >> 4) * 8 + 2 * (u.pn & 3) + bj) * 64 + 4 * (u.pm & 15) + 2 * ai + wr) * 128 + 32 * wc + 8 * fq) * 64 + pw;
#pragma unroll
                    for (int n = 0; n < 2; ++n)
#pragma unroll
                        for (int i = 0; i < 4; ++i) *(unsigned*)(tb + (4 * n + i) * 64) = cvt_pk4_fp8(acc[ai][bj][0][n][i], acc[ai][bj][1][n][i], acc[ai][bj][2][n][i], acc[ai][bj][3][n][i]); }
        } else {
            if (seg == 3) {
#pragma unroll
                for (int ai = 0; ai < 2; ++ai)
#pragma unroll
                    for (int m = 0; m < 4; ++m)
#pragma unroll
                        for (int bj = 0; bj < 2; ++bj) { const f32x4 v0 = acc[ai][bj][m][0], v1 = acc[ai][bj][m][1];
                            u32x2 w; w.x = cvt_pk4_fp8(v0[0], v0[1], v0[2], v0[3]); w.y = cvt_pk4_fp8(v1[0], v1[1], v1[2], v1[3]);
                            *(u32x2*)((unsigned char*)base + (size_t)(row0 + ai * 128 + m * 16) * D + col0 + bj * 128) = w; }
            } else {
#pragma unroll
            for (int ai = 0; ai < 2; ++ai)
#pragma unroll
                for (int m = 0; m < 4; ++m) { bf16_t* rowp = base + (size_t)(row0 + ai * 128 + m * 16) * D + col0;
#pragma unroll
                    for (int bj = 0; bj < 2; ++bj) { const f32x4 v0 = acc[ai][bj][m][0], v1 = acc[ai][bj][m][1];
                        u32x4 w; w.x = cvt_pk_bf16(v0[0], v0[1]); w.y = cvt_pk_bf16(v0[2], v0[3]); w.z = cvt_pk_bf16(v1[0], v1[1]); w.w = cvt_pk_bf16(v1[2], v1[3]);
                        *(u32x4*)(rowp + bj * 128) = w; } }
            }
            if (seg == 3) {
#pragma unroll
                for (int bj = 0; bj < 2; ++bj)
#pragma unroll
                    for (int n = 0; n < 2; ++n) { f32x4 s = (f32x4){0.f, 0.f, 0.f, 0.f};
#pragma unroll
                        for (int ai = 0; ai < 2; ++ai)
#pragma unroll
                            for (int m = 0; m < 4; ++m) s += acc[ai][bj][m][n];
#pragma unroll
                        for (int o = 1; o < 16; o <<= 1) { s[0] += __shfl_xor(s[0], o); s[1] += __shfl_xor(s[1], o); s[2] += __shfl_xor(s[2], o); s[3] += __shfl_xor(s[3], o); }
                        if (fr == 0) *(f32x4*)(kpart + ((size_t)u.pm * 2 + wr) * D + col0 + bj * 128 + 4 * n) = s; }
            }
        }
    }
};
struct EpiOutProj {
    static constexpr bool PERM = true;
    const float* x; bf16_t* hb;
    __device__ __forceinline__ void operator()(const f32x4 (&acc)[2][2][4][2], const pg8::Unit& u, int wr, int wc, int fr, int fq) const {
        const int row0 = u.pm * 256 + wr * 64 + fr, col0 = u.pn * 256 + wc * 32 + 8 * fq;
#pragma unroll
        for (int ai = 0; ai < 2; ++ai)
#pragma unroll
            for (int m = 0; m < 4; ++m) { const size_t off = (size_t)(row0 + ai * 128 + m * 16) * D + col0;
#pragma unroll
                for (int bj = 0; bj < 2; ++bj) { const f32x4 h0 = *(const f32x4*)(x + off + bj * 128) + acc[ai][bj][m][0], h1 = *(const f32x4*)(x + off + bj * 128 + 4) + acc[ai][bj][m][1];
                    u32x4 w; w.x = cvt_pk_bf16(h0[0], h0[1]); w.y = cvt_pk_bf16(h0[2], h0[3]); w.z = cvt_pk_bf16(h1[0], h1[1]); w.w = cvt_pk_bf16(h1[2], h1[3]);
                    *(u32x4*)(hb + off + bj * 128) = w; } }
    }
};
struct EpiMoe1 {
    static constexpr bool PERM = true;
    unsigned char* hid;
    const float* rsp; const unsigned* cnt;
    __device__ __forceinline__ void operator()(const f32x4 (&acc)[2][2][4][2], const pg8::Unit& u, int wr, int wc, int fr, int fq) const {
        const int hc0 = 128 * u.pn + 16 * wc + 4 * fq;
        const int ce = __builtin_amdgcn_readfirstlane((int)cnt[64 * u.ex]);
        float rsv[2][4];
#pragma unroll
        for (int ai = 0; ai < 2; ++ai)
#pragma unroll
            for (int m = 0; m < 4; ++m) { const int p = u.rt * 256 + ai * 128 + wr * 64 + m * 16 + fr; rsv[ai][m] = p < ce ? rsp[u.ex * LCAP + p] : 0.f; }
#pragma unroll
        for (int ai = 0; ai < 2; ++ai)
#pragma unroll
            for (int m = 0; m < 4; ++m) { const int r = ai * 128 + wr * 64 + m * 16 + fr; const float rs = rsv[ai][m];
                unsigned char* rowp = hid + (size_t)(u.pm * 256 + r) * DEXP + hc0;
#pragma unroll
                for (int bj = 0; bj < 2; ++bj) { const f32x4 a = acc[ai][bj][m][0] * rs, b = acc[ai][bj][m][1] * rs; f32x4 o;
#pragma unroll
                    for (int j = 0; j < 4; ++j) { const float sg = __builtin_amdgcn_rcpf(1.0f + __builtin_amdgcn_exp2f(-LOG2E * a[j])); o[j] = a[j] * sg * b[j]; }
                    *(unsigned*)(rowp + bj * 64) = cvt_pk4_fp8(o[0], o[1], o[2], o[3]); } }
    }
};
struct EpiMoe2 {
    static constexpr bool PERM = true;
    unsigned char* yp;
    __device__ __forceinline__ void operator()(const f32x4 (&acc)[2][2][4][2], const pg8::Unit& u, int wr, int wc, int fr, int fq) const {
        const int row0 = u.pm * 256 + wr * 64 + fr, col0 = u.pn * 256 + wc * 32 + 8 * fq;
#pragma unroll
        for (int ai = 0; ai < 2; ++ai)
#pragma unroll
            for (int m = 0; m < 4; ++m) { unsigned char* rowp = yp + (size_t)(row0 + ai * 128 + m * 16) * D + col0;
#pragma unroll
                for (int bj = 0; bj < 2; ++bj) { const f32x4 v0 = acc[ai][bj][m][0] * 16.0f, v1 = acc[ai][bj][m][1] * 16.0f;
                    u32x2 w; w.x = cvt_pk4_fp8(v0[0], v0[1], v0[2], v0[3]); w.y = cvt_pk4_fp8(v1[0], v1[1], v1[2], v1[3]);
                    *(u32x2*)(rowp + bj * 128) = w; } }
    }
};

struct Args {
    const float* x; const float* norm_mix_g; const float* w_in; const float* b_gates; const float* ln_g; const float* ln_b; const float* w_spatial; const float* b_spatial;
    const float* rel_bias; const float* w_out; const float* norm_ffn_g; const float* w_gr; const float* b_gr; const float* w_er; const float* b_er;
    const float* w1; const float* w3; const float* w2; const float* norm_final_g;
    float* out; unsigned char* ws; int ph_lo, ph_hi; int rep_mask, pad;
};
struct Frame { LAS unsigned char* lds; int tid, lane, wave, vcu, G; };
__device__ __forceinline__ Args load_args() {
#if defined(__HIP_DEVICE_COMPILE__)
    const __attribute__((address_space(4))) Args* p = (const __attribute__((address_space(4))) Args*)__builtin_amdgcn_kernarg_segment_ptr(); asm volatile("" : "+s"(p));
    Args r; __builtin_memcpy(&r, (const Args*)p, sizeof(Args)); return r;
#else
    return Args{};
#endif
}

__device__ __forceinline__ unsigned off_b(unsigned row, unsigned ch) { return 256u * row + 16u * (ch ^ (((row & 3) << 2) | ((row >> 2) & 3))); }
__device__ __forceinline__ int crow(int r, int hi) { return (r & 3) + 8 * (r >> 2) + 4 * hi; }
__device__ __forceinline__ s16x4 lds_tr(LAS const unsigned char* p) { typedef short v4i16_t __attribute__((ext_vector_type(4))); return __builtin_bit_cast(s16x4, __builtin_amdgcn_ds_read_tr16_b64_v4i16((LAS v4i16_t*)p)); }

struct TDesc { const float* src; int N, k0, n0; unsigned char* dst; int ldd  ; int rmk  , which; float scale  ; };
__device__ __forceinline__ int tdesc_row(const TDesc& d, int n) {
    if (d.rmk == 0) return n;
    if (d.rmk == 3) return 8 * (n >> 2) + 4 * d.which + (n & 3);
    const int sg = n >> 10, j = n & 1023; const int r = sg == 0 ? 8 * (j >> 2) + (j & 3) : sg == 5 ? 8 * (j >> 2) + 4 + (j & 3) : sg == 6 ? 6144 + j : 1024 + n;
    return d.rmk == 1 ? r : r - 2048;
}
__device__ __forceinline__ void titem_load(const TDesc& d, f32x4 (&v)[8], int lane) {
    const float* p = d.src + (size_t)(d.k0 + (lane >> 4)) * d.N + d.n0 + 4 * (lane & 15);
#pragma unroll
    for (int i = 0; i < 8; ++i) v[i] = __builtin_nontemporal_load((const f32x4*)(p + (size_t)(4 * i) * d.N));
}
__device__ __forceinline__ void titem_store(const TDesc& d, const f32x4 (&v)[8], LAS float* scr  , int lane) {
#pragma unroll
    for (int i = 0; i < 8; ++i) *(LAS f32x4*)(scr + (4 * i + (lane >> 4)) * 68 + 4 * (lane & 15)) = v[i];
    LDS_WAIT(); asm volatile("" ::: "memory");
    if (d.scale != 0.f) {
#pragma unroll
        for (int q = 0; q < 2; ++q) { const int n = (lane >> 1) + 32 * q, kh = lane & 1; const LAS float* sp = scr + (16 * kh) * 68 + n; float f[16];
#pragma unroll
            for (int j = 0; j < 16; ++j) f[j] = sp[j * 68] * d.scale;
            u32x4 o; o.x = cvt_pk4_fp8(f[0], f[1], f[2], f[3]); o.y = cvt_pk4_fp8(f[4], f[5], f[6], f[7]); o.z = cvt_pk4_fp8(f[8], f[9], f[10], f[11]); o.w = cvt_pk4_fp8(f[12], f[13], f[14], f[15]);
            *(u32x4*)(d.dst + (size_t)tdesc_row(d, d.n0 + n) * d.ldd + d.k0 + 16 * kh) = o; }
    } else {
#pragma unroll
        for (int q = 0; q < 4; ++q) { const int n = (lane >> 2) + 16 * q, kq = lane & 3; const LAS float* sp = scr + (8 * kq) * 68 + n; float f[8];
#pragma unroll
            for (int j = 0; j < 8; ++j) f[j] = sp[j * 68];
            u32x4 o; o.x = cvt_pk_bf16(f[0], f[1]); o.y = cvt_pk_bf16(f[2], f[3]); o.z = cvt_pk_bf16(f[4], f[5]); o.w = cvt_pk_bf16(f[6], f[7]);
            *(u32x4*)(d.dst + (size_t)tdesc_row(d, d.n0 + n) * d.ldd + (size_t)(d.k0 + 8 * kq) * 2) = o; }
    }
    LDS_WAIT(); asm volatile("" ::: "memory");
}
template <class Gen>
__device__ __forceinline__ void titems_run(const Gen& gen, int first, int stride, int end, LAS float* scr, int lane) {
    for (int it = first; it < end; it += 4 * stride) {
        const bool h1 = it + stride < end, h2 = it + 2 * stride < end, h3 = it + 3 * stride < end;
        const TDesc d0 = gen(it), d1 = gen(h1 ? it + stride : it), d2 = gen(h2 ? it + 2 * stride : it), d3 = gen(h3 ? it + 3 * stride : it);
        f32x4 v0[8], v1[8], v2[8], v3[8];
        titem_load(d0, v0, lane); if (h1) titem_load(d1, v1, lane); if (h2) titem_load(d2, v2, lane); if (h3) titem_load(d3, v3, lane);
        titem_store(d0, v0, scr, lane); if (h1) titem_store(d1, v1, scr, lane); if (h2) titem_store(d2, v2, scr, lane); if (h3) titem_store(d3, v3, scr, lane);
    }
}
template <class RowMap>
__device__ __forceinline__ void transpose_item_fp8(const float* W, int N, int k0, int n0, unsigned char* dst, int ldd, LAS float* scr, int lane, RowMap rm, float scale) {
#pragma unroll 8
    for (int i = 0; i < 32; ++i) { const int kk = 2 * i + (lane >> 5); scr[kk * 33 + (lane & 31)] = W[(size_t)(k0 + kk) * N + n0 + (lane & 31)]; }
    LDS_WAIT(); asm volatile("" ::: "memory");
    const int c = lane & 7;
#pragma unroll
    for (int j = 0; j < 4; ++j) { const int n = (lane >> 3) + 8 * j; const LAS float* s = scr + (8 * c) * 33 + n;
        u32x2 o; o.x = cvt_pk4_fp8(s[0 * 33] * scale, s[1 * 33] * scale, s[2 * 33] * scale, s[3 * 33] * scale); o.y = cvt_pk4_fp8(s[4 * 33] * scale, s[5 * 33] * scale, s[6 * 33] * scale, s[7 * 33] * scale);
        *(u32x2*)(dst + (size_t)rm(n0 + n) * ldd + k0 + 8 * c) = o; }
    LDS_WAIT(); asm volatile("" ::: "memory");
}
template <class RowMap>
__device__ __forceinline__ void transpose_item(const float* W, int N, int k0, int n0, bf16_t* dst, int ldd, LAS float* scr, int lane, RowMap rm) {
#pragma unroll 8
    for (int i = 0; i < 32; ++i) { const int kk = 2 * i + (lane >> 5); scr[kk * 33 + (lane & 31)] = W[(size_t)(k0 + kk) * N + n0 + (lane & 31)]; }
    LDS_WAIT(); asm volatile("" ::: "memory");
    const int c = lane & 7;
#pragma unroll
    for (int j = 0; j < 4; ++j) { const int n = (lane >> 3) + 8 * j; const LAS float* s = scr + (8 * c) * 33 + n;
        u32x4 o; o.x = cvt_pk_bf16(s[0 * 33], s[1 * 33]); o.y = cvt_pk_bf16(s[2 * 33], s[3 * 33]); o.z = cvt_pk_bf16(s[4 * 33], s[5 * 33]); o.w = cvt_pk_bf16(s[6 * 33], s[7 * 33]);
        *(u32x4*)(dst + (size_t)rm(n0 + n) * ldd + k0 + 8 * c) = o; }
    LDS_WAIT(); asm volatile("" ::: "memory");
}
struct RmId { __device__ __forceinline__ int operator()(int n) const { return n; } };
struct RmWin { __device__ __forceinline__ int operator()(int n) const { const int sg = n >> 10, j = n & 1023;
    return sg == 0 ? 8 * (j >> 2) + (j & 3) : sg == 5 ? 8 * (j >> 2) + 4 + (j & 3) : sg == 6 ? 6144 + j : 1024 + n; } };
struct RmWin8 { __device__ __forceinline__ int operator()(int n) const { return RmWin{}(n) - 2048; } };
struct RmW13 { int which; __device__ __forceinline__ int operator()(int j) const { return 8 * (j >> 2) + 4 * which + (j & 3); } };

__device__ __forceinline__ void p0_prologue(const Frame& F, const Args& a) {
    unsigned char* ws = a.ws;
    LAS float* scr = (LAS float*)(F.lds + F.wave * 16384);
    const int gw = F.vcu * NWAVES + F.wave, NGW = F.G * NWAVES;
    bf16_t* win_t = (bf16_t*)(ws + WS_WIN); bf16_t* wout_t = (bf16_t*)(ws + WS_WOUT);
    constexpr int I_IN = (D / 32) * (NCOL / 64), I_OUT = (D / 32) * (D / 64);
    { const float* w_in = a.w_in; unsigned char* wsb_ = ws;
      auto gen = [=](int it) -> TDesc {
          TDesc d; const int nblk = NCOL / 64, kb = it / nblk, nb = it % nblk; const int sg = (64 * nb) >> 10; const bool bf = (sg == 0 || sg == 5);
          d.src = w_in; d.N = NCOL; d.k0 = 32 * kb; d.n0 = 64 * nb; d.dst = wsb_ + (bf ? WS_WIN : WS_WIN8); d.ldd = bf ? D * 2 : D; d.rmk = bf ? 1 : 2; d.which = 0; d.scale = bf ? 0.f : 32.0f;
          return d; };
      titems_run(gen, gw, NGW, I_IN, scr, F.lane); }
    { const float* w_out = a.w_out; unsigned char* wsb_ = ws;
      auto gen = [=](int it) -> TDesc {
          TDesc d; const int nblk = D / 64, kb = it / nblk, nb = it % nblk;
          d.src = w_out; d.N = D; d.k0 = 32 * kb; d.n0 = 64 * nb; d.dst = wsb_ + WS_WOUT; d.ldd = D * 2; d.rmk = 0; d.which = 0; d.scale = 0.f;
          return d; };
      titems_run(gen, gw, NGW, I_OUT, scr, F.lane); }
    bf16_t* xn = (bf16_t*)a.out;
    f32x4 gv[4];
#pragma unroll
    for (int j = 0; j < 4; ++j) gv[j] = *((const f32x4*)a.norm_mix_g + F.lane + 64 * j);
    for (int m = gw; m < T; m += NGW) {
        const f32x4* xr = (const f32x4*)(a.x + (size_t)m * D) + F.lane;
        f32x4 v[4]; float s = 0.f;
#pragma unroll
        for (int j = 0; j < 4; ++j) { v[j] = __builtin_nontemporal_load(xr + 64 * j); s += (v[j].x * v[j].x + v[j].y * v[j].y) + (v[j].z * v[j].z + v[j].w * v[j].w); }
        const float rs = 1.0f / sqrtf(wave_sum(s) * (1.f / D) + NORM_EPS);
        u32x2* o8 = (u32x2*)(xn + (size_t)m * D) + F.lane;
#pragma unroll
        for (int j = 0; j < 4; ++j) { const f32x4 y = v[j] * rs * gv[j]; u32x2 w; w.x = cvt_pk_bf16(y.x, y.y); w.y = cvt_pk_bf16(y.z, y.w); o8[64 * j] = w;
            ((unsigned*)(ws + WS_XN8 + (size_t)m * D))[F.lane + 64 * j] = cvt_pk4_fp8(y.x, y.y, y.z, y.w); }
    }
    { bf16_t* rwh = (bf16_t*)(ws + WS_RW); bf16_t* rwl = rwh + 48 * D;
      for (int i = (blockIdx.x * NTHREADS + F.tid) * 2; i < 48 * D; i += F.G * NTHREADS * 2) {
          const int c = i >> 10, k = i & 1023; float v0 = 0.f, v1 = 0.f;
          if (c < 32) { v0 = a.norm_ffn_g[k] * a.w_er[((size_t)(c >> 3) * D + k) * 8 + (c & 7)]; v1 = a.norm_ffn_g[k + 1] * a.w_er[((size_t)(c >> 3) * D + k + 1) * 8 + (c & 7)]; }
          else if (c < 36) { v0 = a.norm_ffn_g[k] * a.w_gr[k * 4 + (c - 32)]; v1 = a.norm_ffn_g[k + 1] * a.w_gr[(k + 1) * 4 + (c - 32)]; }
          const unsigned hi = cvt_pk_bf16(v0, v1);
          *(unsigned*)(rwh + i) = hi; *(unsigned*)(rwl + i) = cvt_pk_bf16(v0 - bf_lo(hi), v1 - bf_hi(hi)); } }
    bf16_t* wsb = (bf16_t*)(ws + WS_WSB);
    for (int i = (blockIdx.x * NTHREADS + F.tid) * 2; i < 8 * 128 * 128; i += F.G * NTHREADS * 2) {
        const int s = i & 127, t = (i >> 7) & 127;
        const float v0 = (s <= t) ? a.w_spatial[i] : 0.f, v1 = (s + 1 <= t) ? a.w_spatial[i + 1] : 0.f;
        *(unsigned*)(wsb + i) = cvt_pk_bf16(v0, v1);
    }
}

constexpr int GM_WSL = 98304, GM_STAT = 90112;
__device__ __forceinline__ void gmlp_load_ws(const Frame& F, const Args& a, int g) {
    const bf16_t* wsb = (const bf16_t*)(a.ws + WS_WSB);
    for (int i = F.tid; i < 128 * 16; i += NTHREADS) { const int row = i >> 4, ch = i & 15; *(LAS u32x4*)(F.lds + GM_WSL + off_b(row, ch)) = *(const u32x4*)(wsb + ((size_t)g * 128 + row) * 128 + ch * 8); }
}
__device__ __forceinline__ void gmlp_chunk(const Frame& F, const Args& a, int row0, int g, const bool live) {
    asm volatile("" : "+s"(row0), "+s"(g));
    int tid_ = F.tid; asm volatile("" : "+v"(tid_));
    unsigned char* ws = a.ws;
    bf16_t* Ub = (bf16_t*)(ws + WS_U); const bf16_t* VG = (const bf16_t*)(ws + WS_VG);
    const f32x2* stats = (const f32x2*)(ws + WS_STAT);
    LAS unsigned char* VN = F.lds;
    LAS unsigned char* WSL = F.lds + GM_WSL;
    LAS float* MEAN = (LAS float*)(F.lds + GM_STAT); LAS float* RSTD = MEAN + 128;
    const int lane = tid_ & 63, wid = __builtin_amdgcn_readfirstlane(tid_ >> 6), r32 = lane & 31, hh = lane >> 5;
    const int mych = tid_ & 15;
    const f32x4 lg0 = *(const f32x4*)(a.ln_g + g * 128 + mych * 8), lg1 = *(const f32x4*)(a.ln_g + g * 128 + mych * 8 + 4);
    const f32x4 lb0 = *(const f32x4*)(a.ln_b + g * 128 + mych * 8), lb1 = *(const f32x4*)(a.ln_b + g * 128 + mych * 8 + 4);
    const int tt = wid >> 1, cp = wid & 1;
    const float bsp = a.b_spatial[g * 128 + tt * 32 + r32];
    __syncthreads();
    if (tid_ < 128) { const f32x2* sp = stats + (size_t)(row0 + tid_) * 16; float s1 = 0.f, s2 = 0.f;
#pragma unroll
        for (int j = 0; j < 16; ++j) { const f32x2 v = sp[j]; s1 += v.x; s2 += v.y; }
        const float mean = s1 * (1.f / 1024.f), var = s2 * (1.f / 1024.f) - mean * mean;
        MEAN[tid_] = mean; RSTD[tid_] = 1.0f / sqrtf(fmaxf(var, 0.f) + NORM_EPS); }
    __syncthreads();
#pragma unroll
    for (int it = 0; it < 4; ++it) { const int s = (tid_ >> 4) + 32 * it;
        const u32x4 raw = *(const u32x4*)(VG + (size_t)(row0 + s) * D + g * 128 + mych * 8);
        const float mu = MEAN[s], rs = RSTD[s];
        f32x4 x0 = (f32x4){bf_lo(raw.x), bf_hi(raw.x), bf_lo(raw.y), bf_hi(raw.y)}, x1 = (f32x4){bf_lo(raw.z), bf_hi(raw.z), bf_lo(raw.w), bf_hi(raw.w)};
        x0 = (x0 - mu) * rs * lg0 + lb0; x1 = (x1 - mu) * rs * lg1 + lb1;
        u32x4 w; w.x = cvt_pk_bf16(x0[0], x0[1]); w.y = cvt_pk_bf16(x0[2], x0[3]); w.z = cvt_pk_bf16(x1[0], x1[1]); w.w = cvt_pk_bf16(x1[2], x1[3]);
        *(LAS u32x4*)(VN + off_b(s, mych)) = w; }
    __syncthreads();
    f32x16 c0 = {}, c1 = {};
    const unsigned blk = (lane >> 4) & 1, q = (lane & 15) >> 2, p = lane & 3;
    for (int ks = 0; ks < 2 * (tt + 1); ++ks) {
        const bf16x8 bfrag = *(const LAS bf16x8*)(WSL + off_b(tt * 32 + r32, 2 * ks + hh));
        bf16x8 af[2];
#pragma unroll
        for (int ct = 0; ct < 2; ++ct) { const int cc = 2 * cp + ct;
            const s16x4 lo = lds_tr(VN + off_b(16 * ks + 8 * hh + q, 4 * cc + 2 * blk + (p >> 1)) + 8 * (p & 1));
            const s16x4 hi = lds_tr(VN + off_b(16 * ks + 8 * hh + 4 + q, 4 * cc + 2 * blk + (p >> 1)) + 8 * (p & 1));
            af[ct] = (bf16x8){lo[0], lo[1], lo[2], lo[3], hi[0], hi[1], hi[2], hi[3]}; }
        c0 = __builtin_amdgcn_mfma_f32_32x32x16_bf16(af[0], bfrag, c0, 0, 0, 0);
        c1 = __builtin_amdgcn_mfma_f32_32x32x16_bf16(af[1], bfrag, c1, 0, 0, 0);
    }
    const size_t rowoff = (size_t)(row0 + tt * 32 + r32) * D + g * 128;
#pragma unroll
    for (int ct = 0; ct < 2; ++ct)
#pragma unroll
        for (int gq = 0; gq < 4; ++gq) { const int c = 32 * (2 * cp + ct) + 8 * gq + 4 * hh;
            const u32x2 uu = *(const u32x2*)(Ub + rowoff + c);
            const f32x16& cc_ = ct ? c1 : c0;
            const float m0 = cc_[4 * gq + 0] + bsp, m1 = cc_[4 * gq + 1] + bsp, m2 = cc_[4 * gq + 2] + bsp, m3 = cc_[4 * gq + 3] + bsp;
            u32x2 o; o.x = cvt_pk_bf16(bf_lo(uu.x) * m0, bf_hi(uu.x) * m1); o.y = cvt_pk_bf16(bf_lo(uu.y) * m2, bf_hi(uu.y) * m3);
            if (live) *(u32x2*)(Ub + rowoff + c) = o; }
}

__constant__ unsigned char T5_BUCKET[128] = {0, 1, 2, 3, 4, 5, 6, 7, 8, 9, 10, 11, 12, 13, 14, 15, 16, 16, 16, 17, 17, 18, 18, 18, 19, 19, 19, 20, 20, 20, 20, 21, 21, 21, 21, 22, 22, 22, 22, 22, 23, 23, 23, 23, 23, 23, 24, 24, 24, 24, 24, 24, 25, 25, 25, 25, 25, 25, 25, 26, 26, 26, 26, 26, 26, 26, 26, 27, 27, 27, 27, 27, 27, 27, 27, 27, 27, 28, 28, 28, 28, 28, 28, 28, 28, 28, 28, 29, 29, 29, 29, 29, 29, 29, 29, 29, 29, 29, 29, 30, 30, 30, 30, 30, 30, 30, 30, 30, 30, 30, 30, 30, 30, 31, 31, 31, 31, 31, 31, 31, 31, 31, 31, 31, 31, 31, 31, 31};
constexpr int AT_KV = 0;
constexpr int AT_KMH = 65536, AT_KML = 73728, AT_TB = 81920;
__device__ __forceinline__ void attn_bh_tables(const Frame& F, const Args& a, int b, int h) {
    LAS unsigned char* lds = F.lds; const int tid = F.tid;
    const float* kpart = (const float*)(a.ws + WS_KPART);
    { const int n = tid >> 5, c4 = (tid & 31) * 4;
      const float* kp = kpart + ((size_t)(b * 16 + n) * 2) * D + h * HD + c4;
      const f32x4 s = (*(const f32x4*)kp + *(const f32x4*)(kp + D)) * (1.0f / 256.0f);
      u32x2 hi; hi.x = cvt_pk_bf16(s[0], s[1]); hi.y = cvt_pk_bf16(s[2], s[3]);
      const f32x4 rsd = (f32x4){s[0] - bf_lo(hi.x), s[1] - bf_hi(hi.x), s[2] - bf_lo(hi.y), s[3] - bf_hi(hi.y)};
      u32x2 lo; lo.x = cvt_pk_bf16(rsd[0], rsd[1]); lo.y = cvt_pk_bf16(rsd[2], rsd[3]);
      const unsigned o = off_b(n, c4 >> 3) + (c4 & 7) * 2, oz = off_b(n + 16, c4 >> 3) + (c4 & 7) * 2;
      *(LAS u32x2*)(lds + AT_KMH + o) = hi; *(LAS u32x2*)(lds + AT_KML + o) = lo;
      *(LAS u32x2*)(lds + AT_KMH + oz) = (u32x2){0u, 0u}; *(LAS u32x2*)(lds + AT_KML + oz) = (u32x2){0u, 0u};
#pragma unroll
      for (int i = 0; i < 3; ++i) { const int j = tid + 512 * i; const int d = 512 - j;
          if (j < 768) ((LAS float*)(lds + AT_TB))[j] = d < 0 ? -INFINITY : a.rel_bias[T5_BUCKET[d > 127 ? 127 : d] * NH + h] * LOG2E - 4.0f; else ((LAS float*)(lds + AT_TB))[j] = -INFINITY; } }
}
__device__ __forceinline__ void attn_unit(const Frame& F, const Args& a, int b, int h, int qb, const bool live) {
    unsigned char* ws = a.ws;
    const bf16_t* Qg = (const bf16_t*)(ws + WS_Q); const unsigned char* K8g = ws + WS_K; const unsigned char* VTg = ws + WS_VA;
    bf16_t* Zg = (bf16_t*)(ws + WS_U); const bf16_t* GBg = (const bf16_t*)(ws + WS_GB);
    const float* kpart = (const float*)(ws + WS_KPART);
    LAS unsigned char* lds = F.lds;
    int lane_ = F.lane, wid_ = F.wave; asm volatile("" : "+v"(lane_), "+s"(wid_));
    const int lane = lane_, wid = wid_, tid = wid * 64 + lane, r32 = lane & 31, hh = lane >> 5;
    const size_t tok_b = (size_t)b * SEQ;
    const int NT = 4 * (qb + 1);
#pragma unroll 1
    for (int cch = ((a.rep_mask >> 10) & 1) ? -2 : 0; cch < 2; ++cch) gmlp_chunk(F, a, (int)tok_b + qb * 256 + 128 * (cch & 1), h, live && cch >= 0);
    asm volatile("s_waitcnt vmcnt(0)" ::: "memory"); __builtin_amdgcn_fence(__ATOMIC_ACQ_REL, "workgroup");
    __syncthreads();
    const unsigned char* ksrc = K8g + (tok_b + 8 * wid + (lane >> 3)) * D + h * HD + 16 * ((lane & 7) ^ ((4 * wid + (lane >> 4)) & 7));
    const unsigned char* vsrc = VTg + (size_t)(b * 8 + h) * (64 * 8192) + (16 * wid + (lane >> 2)) * 64 + 16 * ((lane & 3) ^ ((lane >> 4) & 3));
#define AT_ISSUE(t) do { const int _bo = ((t) & 1) * 32768; \
        __builtin_amdgcn_global_load_lds((const unsigned*)(ksrc + (size_t)(t) * 64 * D), (LAS unsigned*)(lds + AT_KV + _bo + wid * 1024), 16, 0, 0); \
        __builtin_amdgcn_global_load_lds((const unsigned*)(vsrc + (size_t)(t) * 8192), (LAS unsigned*)(lds + AT_KV + _bo + 16384 + wid * 1024), 16, 0, 0); } while (0)
    AT_ISSUE(0);
    const int qi = wid * 32 + r32;
    const size_t qtok = tok_b + (size_t)qb * 256 + qi;
    pg8::i32x8_t q8[2];
    const float QS = 8.0f * 0.08838834764831845f * LOG2E;
    unsigned sel = 0u;
    { f32x16 gacc = {};
#pragma unroll
      for (int ks2 = 0; ks2 < 2; ++ks2) { bf16x8 qraw[4];
#pragma unroll
          for (int e = 0; e < 4; ++e) qraw[e] = *(const bf16x8*)(Qg + qtok * D + h * HD + 64 * ks2 + 32 * hh + 8 * e);
#pragma unroll
          for (int e = 0; e < 4; ++e) { const bf16x8 kh = *(const LAS bf16x8*)(lds + AT_KMH + off_b(r32, 8 * ks2 + 4 * hh + e)), kl = *(const LAS bf16x8*)(lds + AT_KML + off_b(r32, 8 * ks2 + 4 * hh + e));
              gacc = __builtin_amdgcn_mfma_f32_32x32x16_bf16(kh, qraw[e], gacc, 0, 0, 0); gacc = __builtin_amdgcn_mfma_f32_32x32x16_bf16(kl, qraw[e], gacc, 0, 0, 0); }
#pragma unroll
          for (int e = 0; e < 4; ++e) { const bf16x8 qq = qraw[e]; const u32x4 qw = __builtin_bit_cast(u32x4, qq);
              q8[ks2][2 * e] = (int)cvt_pk4_fp8(QS * bf_lo(qw.x), QS * bf_hi(qw.x), QS * bf_lo(qw.y), QS * bf_hi(qw.y)); q8[ks2][2 * e + 1] = (int)cvt_pk4_fp8(QS * bf_lo(qw.z), QS * bf_hi(qw.z), QS * bf_lo(qw.w), QS * bf_hi(qw.w)); } }
      float gv[16];
#pragma unroll
      for (int aa = 0; aa < 2; ++aa)
#pragma unroll
          for (int i = 0; i < 4; ++i) { const float own = gacc[4 * aa + i], oth = __shfl_xor(own, 32);
              gv[8 * aa + i] = hh ? oth : own; gv[8 * aa + 4 + i] = hh ? own : oth; }
#pragma unroll
      for (int n = 0; n < 16; ++n) if (n >= qb) gv[n] = -INFINITY;
#pragma unroll
      for (int k = 0; k < 3; ++k) { float best = -INFINITY; int bi = -1;
#pragma unroll
          for (int n = 0; n < 16; ++n) { const bool c = !((sel >> n) & 1u) && gv[n] > best; best = c ? gv[n] : best; bi = c ? n : bi; }
          if (bi >= 0) sel |= 1u << bi; } }
    const LAS float* TB = (const LAS float*)(lds + AT_TB);
    const float b31 = TB[512 - 127];
    const LAS float* tbl = TB + (512 - r32 + 4 * hh);
    f32x16 o[4]; o[0] = f32x16{}; o[1] = f32x16{}; o[2] = f32x16{}; o[3] = f32x16{};
    f32x16 o5 = f32x16{};
    const pg8::i32x8_t ones8 = {0x38383838, 0x38383838, 0x38383838, 0x38383838, 0x38383838, 0x38383838, 0x38383838, 0x38383838};
    pg8::i32x8_t p8 = {0, 0, 0, 0, 0, 0, 0, 0};
    f32x16 cbf = {};
    const unsigned kb0 = 128u * r32 + 16u * ((2u * hh) ^ ((r32 >> 1) & 7u));
    const unsigned vb0 = 64u * r32 + 16u * ((2u * hh) ^ ((r32 >> 2) & 3u));
    const int sc1 = 0x7f7f7f7f, scq = 0x7c7c7c7c;
#define AT_MMA_SEED(S, KF, QF) asm volatile("v_mfma_scale_f32_32x32x64_f8f6f4 %0, %1, %2, %5, %3, %4 op_sel_hi:[0,0,0]" : "=&v"(S) : "v"(KF), "v"(QF), "v"(sc1), "v"(scq), "v"(cbf))
#define AT_MMA_ACC(S, KF, QF) asm volatile("v_mfma_scale_f32_32x32x64_f8f6f4 %0, %1, %2, %0, %3, %4 op_sel_hi:[0,0,0]" : "+v"(S) : "v"(KF), "v"(QF), "v"(sc1), "v"(scq))
#define AT_SOFTMAX(S, HI) { float pr[16]; \
            _Pragma("unroll") for (int r = 0; r < 16; ++r) pr[r] = __builtin_amdgcn_exp2f(S[r]); \
            _Pragma("unroll") for (int w = 0; w < 8; ++w) p8[w] = HI ? __builtin_amdgcn_cvt_pk_fp8_f32(pr[w], pr[8 + w], p8[w], true) : __builtin_amdgcn_cvt_pk_fp8_f32(pr[w], pr[8 + w], p8[w], false); }
#define AT_TILE(FAST) { pg8::i32x8_t kf[4]; \
            _Pragma("unroll") for (int i = 0; i < 4; ++i) { const pg8::i32x4_t lo = *(const LAS pg8::i32x4_t*)(lds + (kb ^ (64u * (i & 1))) + (i >> 1) * 4096), hi = *(const LAS pg8::i32x4_t*)(lds + (kb ^ (64u * (i & 1)) ^ 16u) + (i >> 1) * 4096); \
                kf[i] = (pg8::i32x8_t){lo[0], lo[1], lo[2], lo[3], hi[0], hi[1], hi[2], hi[3]}; } \
            f32x16 s0, s1; \
            if (!(FAST)) { const LAS float* tp = tbl + (bfar == -INFINITY ? 768 : 0) + (kj0 - rel - wid * 32); \
                _Pragma("unroll") for (int r = 0; r < 16; ++r) s0[r] = tp[(r & 3) + 8 * (r >> 2)]; \
                _Pragma("unroll") for (int r = 0; r < 16; ++r) s1[r] = tp[32 + (r & 3) + 8 * (r >> 2)]; } \
            asm volatile("s_waitcnt lgkmcnt(0)\n\ts_nop 1" ::: "memory"); \
            if (FAST) { AT_MMA_SEED(s0, kf[0], q8[0]); } else { AT_MMA_ACC(s0, kf[0], q8[0]); } \
            AT_MMA_ACC(s0, kf[1], q8[1]); \
            if (FAST) { AT_MMA_SEED(s1, kf[2], q8[0]); } else { AT_MMA_ACC(s1, kf[2], q8[0]); } \
              \
            asm volatile("v_mfma_scale_f32_32x32x64_f8f6f4 %0, %2, %3, %0, %4, %5 op_sel_hi:[0,0,0]\n\ts_nop 7" : "+v"(s1), "+v"(s0) : "v"(kf[3]), "v"(q8[1]), "v"(sc1), "v"(scq)); \
              \
            pg8::i32x8_t vf[4]; \
            _Pragma("unroll") for (int dt = 0; dt < 4; ++dt) { const pg8::i32x4_t lo = *(const LAS pg8::i32x4_t*)(lds + vb + 2048 * dt), hi = *(const LAS pg8::i32x4_t*)(lds + (vb ^ 16u) + 2048 * dt); \
                vf[dt] = (pg8::i32x8_t){lo[0], lo[1], lo[2], lo[3], hi[0], hi[1], hi[2], hi[3]}; } \
            __builtin_amdgcn_sched_barrier(0); \
            AT_SOFTMAX(s0, false) \
            __builtin_amdgcn_sched_barrier(0); \
            AT_SOFTMAX(s1, true) \
            __builtin_amdgcn_sched_barrier(0); \
              \
            asm volatile("s_waitcnt lgkmcnt(0)\n\ts_nop 3" ::: "memory"); \
            _Pragma("unroll") for (int dt = 0; dt < 4; ++dt) \
                asm volatile("v_mfma_f32_32x32x64_f8f6f4 %0, %1, %2, %0" : "+v"(o[dt]) : "v"(p8), "v"(vf[dt])); \
            asm volatile("v_mfma_f32_32x32x64_f8f6f4 %0, %1, %2, %0" : "+v"(o5) : "v"(p8), "v"(ones8)); \
            __builtin_amdgcn_sched_barrier(0); }
#define AT_STEP(FAST) { \
        if (t + 1 < NT) { AT_ISSUE(t + 1); asm volatile("s_waitcnt vmcnt(2)" ::: "memory"); } else { asm volatile("s_waitcnt vmcnt(0)" ::: "memory"); } \
        __builtin_amdgcn_s_barrier(); asm volatile("" ::: "memory"); \
        const int n = t >> 2, kj0 = (t & 3) * 64; \
        unsigned kb = kb0 + AT_KV + (t & 1) * 32768, vb = vb0 + AT_KV + (t & 1) * 32768 + 16384; \
        asm volatile("" : "+v"(kb), "+v"(vb));                                    \
        const int rel = (n == qb) ? 0 : 256;                                      \
        const float bfar = (n == qb || ((sel >> n) & 1u)) ? b31 : -INFINITY;      \
        AT_TILE(FAST) \
        asm volatile("s_waitcnt lgkmcnt(0)" ::: "memory"); __builtin_amdgcn_s_barrier(); asm volatile("" ::: "memory"); }
    const int T1 = qb > 0 ? 4 * (qb - 1) : 0;
#pragma unroll 1
    for (int pass = (a.rep_mask >> 11) & 1; pass >= 0; --pass) {
    int t = 0;
#pragma unroll 1
    while (t < T1) {
        { const float bf = ((sel >> (t >> 2)) & 1u) ? b31 : -INFINITY;
#pragma unroll
          for (int r = 0; r < 16; ++r) cbf[r] = bf; }
#pragma unroll 1
        for (int j = 0; j < 4; ++j, ++t) AT_STEP(1)
    }
    asm volatile("s_nop 15\n\ts_nop 7" : "+v"(o[0]), "+v"(o[1]), "+v"(o[2]), "+v"(o[3]), "+v"(o5));
#pragma unroll 1
    for (; t < NT; ++t) AT_STEP(0)
    asm volatile("s_nop 15\n\ts_nop 7" : "+v"(o[0]), "+v"(o[1]), "+v"(o[2]), "+v"(o[3]), "+v"(o5));
    if (pass) { AT_ISSUE(0); }
    }
#undef AT_STEP
#undef AT_TILE
#undef AT_SOFTMAX
#undef AT_MMA_ACC
#undef AT_MMA_SEED
    asm volatile("s_nop 15\n\ts_nop 15" ::: "memory");
    { LAS unsigned char* stg = lds + AT_KV + wid * 8192;
#pragma unroll
      for (int r = 0; r < 16; ++r) { const int qrow = crow(r, hh); const float li = __builtin_amdgcn_rcpf(o5[r]);
#pragma unroll
          for (int dt = 0; dt < 4; ++dt) *(LAS bf16_t*)(stg + qrow * 256 + (32 * dt + r32) * 2) = (bf16_t)(cvt_pk_bf16(o[dt][r] * li, 0.f) & 0xffffu); }
      asm volatile("s_waitcnt lgkmcnt(0)" ::: "memory");
      const size_t rowbase = (tok_b + (size_t)qb * 256 + wid * 32) * D + h * HD;
#pragma unroll
      for (int i = 0; i < 8; ++i) { const int row = 4 * i + (lane >> 4), ch = lane & 15;
          const u32x4 yv = *(const LAS u32x4*)(stg + row * 256 + ch * 16);
          const size_t off = rowbase + (size_t)row * D + ch * 8;
          const u32x4 zv = *(const u32x4*)(Zg + off); const u32x2 g8 = *(const u32x2*)((const unsigned char*)GBg + off);
          u32x4 ov;
          { const f32x2 g0 = __builtin_amdgcn_cvt_pk_f32_fp8((int)g8.x, false), g1 = __builtin_amdgcn_cvt_pk_f32_fp8((int)g8.x, true), g2 = __builtin_amdgcn_cvt_pk_f32_fp8((int)g8.y, false), g3 = __builtin_amdgcn_cvt_pk_f32_fp8((int)g8.y, true);
            ov.x = cvt_pk_bf16(bf_lo(zv.x) + g0[0] * bf_lo(yv.x), bf_hi(zv.x) + g0[1] * bf_hi(yv.x)); ov.y = cvt_pk_bf16(bf_lo(zv.y) + g1[0] * bf_lo(yv.y), bf_hi(zv.y) + g1[1] * bf_hi(yv.y));
            ov.z = cvt_pk_bf16(bf_lo(zv.z) + g2[0] * bf_lo(yv.z), bf_hi(zv.z) + g2[1] * bf_hi(yv.z)); ov.w = cvt_pk_bf16(bf_lo(zv.w) + g3[0] * bf_lo(yv.w), bf_hi(zv.w) + g3[1] * bf_hi(yv.w)); }
          if (live) *(u32x4*)(Zg + off) = ov; }
      asm volatile("s_waitcnt lgkmcnt(0)" ::: "memory"); }
#undef AT_ISSUE
}
__device__ __forceinline__ void p3_attention(const Frame& F, const Args& a, const bool live) {
    for (int v = F.vcu; v < 256; v += F.G) {
        const int bh = v >> 3, s = v & 7;
        __syncthreads(); gmlp_load_ws(F, a, bh & 7); attn_bh_tables(F, a, bh >> 3, bh & 7);
#pragma unroll 1
        for (int uu = 0; uu < 2; ++uu) attn_unit(F, a, bh >> 3, bh & 7, uu ? s : 15 - s, live);
    }
}

constexpr int P5_CTR_OFF = MISC_OFF + 256;
__device__ __forceinline__ void p5_router(const Frame& F, const Args& a, const bool live) {
    unsigned char* ws = a.ws;
    const int lane = F.lane, wid = F.wave;
    const bf16_t* H = (const bf16_t*)(ws + WS_HB); unsigned char* xn2 = ws + WS_XN2;
    unsigned* cnt = (unsigned*)(ws + WS_CTL) + CW_CNT; int* list = (int*)(ws + WS_LIST); int* inv = (int*)(ws + WS_INV); float* wtok = (float*)(ws + WS_WTOK); float* rsp = (float*)(ws + WS_RSP);
    LAS unsigned* ctr = (LAS unsigned*)(F.lds + P5_CTR_OFF);
    if (F.tid == 0) *ctr = 0u;
    __syncthreads();
    if (wid < 4) {
        const bf16_t* rwh = (const bf16_t*)(ws + WS_RW); const bf16_t* rwl = rwh + 48 * D;
        LAS float* scr = (LAS float*)(F.lds + wid * 16384 + 8704);
        for (int tile = F.vcu * 4 + wid; tile < T / 16; tile += F.G * 4) {
        const int row0 = tile * 16, r = lane & 15, kq = lane >> 4;
        const bf16_t* hrow = H + (size_t)(row0 + r) * D + 8 * kq;
        const bf16_t* bh = rwh + (size_t)r * D + 8 * kq; const bf16_t* bl = rwl + (size_t)r * D + 8 * kq;
        f32x4 acc[3]; acc[0] = (f32x4){0.f, 0.f, 0.f, 0.f}; acc[1] = acc[0]; acc[2] = acc[0];
        float ssq = 0.f;
        const float* gp = a.norm_ffn_g + 8 * kq;
        unsigned char* orow = xn2 + (size_t)(row0 + r) * D + 8 * kq;
#pragma unroll 4
        for (int ks = 0; ks < 32; ++ks) {
            const u32x4 hi = *(const u32x4*)(hrow + 32 * ks);
            const f32x4 x0 = (f32x4){bf_lo(hi.x), bf_hi(hi.x), bf_lo(hi.y), bf_hi(hi.y)}, x1 = (f32x4){bf_lo(hi.z), bf_hi(hi.z), bf_lo(hi.w), bf_hi(hi.w)};
            ssq += ((x0[0] * x0[0] + x0[1] * x0[1]) + (x0[2] * x0[2] + x0[3] * x0[3])) + ((x1[0] * x1[0] + x1[1] * x1[1]) + (x1[2] * x1[2] + x1[3] * x1[3]));
            const bf16x8 ah = __builtin_bit_cast(bf16x8, hi);
            { const f32x4 y0 = x0 * *(const f32x4*)(gp + 32 * ks), y1 = x1 * *(const f32x4*)(gp + 32 * ks + 4);
              u32x2 w; w.x = cvt_pk4_fp8(y0[0], y0[1], y0[2], y0[3]); w.y = cvt_pk4_fp8(y1[0], y1[1], y1[2], y1[3]);
              *(u32x2*)(orow + 32 * ks) = w; }
#pragma unroll
            for (int nt = 0; nt < 3; ++nt) { const bf16x8 wh = *(const bf16x8*)(bh + (size_t)nt * 16 * D + 32 * ks), wlo = *(const bf16x8*)(bl + (size_t)nt * 16 * D + 32 * ks);
                acc[nt] = __builtin_amdgcn_mfma_f32_16x16x32_bf16(ah, wh, acc[nt], 0, 0, 0);
                acc[nt] = __builtin_amdgcn_mfma_f32_16x16x32_bf16(ah, wlo, acc[nt], 0, 0, 0); }
        }
        ssq += __shfl_xor(ssq, 16); ssq += __shfl_xor(ssq, 32);
        const float rs = 1.0f / sqrtf(ssq * (1.f / D) + NORM_EPS);
#pragma unroll
        for (int nt = 0; nt < 3; ++nt)
#pragma unroll
            for (int j = 0; j < 4; ++j) scr[(4 * kq + j) * 49 + 16 * nt + r] = acc[nt][j];
        LDS_WAIT(); asm volatile("" ::: "memory");
        if (lane < 16) {
            const LAS float* lr = scr + lane * 49;
            float gl[4];
#pragma unroll
            for (int g = 0; g < 4; ++g) gl[g] = lr[32 + g] * rs + a.b_gr[g];
            int gi = 0; float gm = gl[0];
#pragma unroll
            for (int g = 1; g < 4; ++g) if (gl[g] > gm) { gm = gl[g]; gi = g; }
            float den = 0.f;
#pragma unroll
            for (int g = 0; g < 4; ++g) den += __expf(gl[g] - gm);
            const float g_w = 1.0f / den;
            float el[8];
#pragma unroll
            for (int e = 0; e < 8; ++e) el[e] = lr[gi * 8 + e] * rs + a.b_er[gi * 8 + e];
            int e0 = 0; float v0 = el[0];
#pragma unroll
            for (int e = 1; e < 8; ++e) if (el[e] > v0) { v0 = el[e]; e0 = e; }
            int e1 = -1; float v1 = -INFINITY;
#pragma unroll
            for (int e = 0; e < 8; ++e) if (e != e0 && el[e] > v1) { v1 = el[e]; e1 = e; }
            const float x1 = __expf(v1 - v0), w0f = g_w / (1.0f + x1), w1f = g_w * x1 / (1.0f + x1);
            if (live) { const int m = row0 + lane;
                const int ex0 = gi * 8 + e0, ex1 = gi * 8 + e1;
                const unsigned p0 = __hip_atomic_fetch_add(cnt + 64 * ex0, 1u, __ATOMIC_RELAXED, __HIP_MEMORY_SCOPE_AGENT);
                const unsigned p1 = __hip_atomic_fetch_add(cnt + 64 * ex1, 1u, __ATOMIC_RELAXED, __HIP_MEMORY_SCOPE_AGENT);
                list[ex0 * LCAP + p0] = m * 2; list[ex1 * LCAP + p1] = m * 2 + 1;
                rsp[ex0 * LCAP + p0] = rs; rsp[ex1 * LCAP + p1] = rs;
                *(int2*)(inv + m * 2) = make_int2(ex0 * LCAP + (int)p0, ex1 * LCAP + (int)p1); *(float2*)(wtok + m * 2) = make_float2(w0f, w1f); }
        }
        LDS_WAIT(); asm volatile("" ::: "memory");
        }
    }
    { LAS float* tscr = (LAS float*)(F.lds + wid * 16384);
      const float* w1 = a.w1; const float* w3 = a.w3; const float* w2 = a.w2; unsigned char* w13 = ws + WS_W13; unsigned char* w2t = ws + WS_W2;
      constexpr int I13 = (D / 32) * (DEXP / 64), I2 = (DEXP / 32) * (D / 64), IPE = 2 * I13 + I2;
      auto gen = [=](int it) -> TDesc {
          TDesc d; const int e = it / IPE; int r = it % IPE;
          if (r < 2 * I13) { const int which = r / I13; r %= I13; const int kb = r / (DEXP / 64), nb = r % (DEXP / 64);
              d.src = (which ? w3 : w1) + (size_t)e * D * DEXP; d.N = DEXP; d.k0 = 32 * kb; d.n0 = 64 * nb; d.dst = w13 + (size_t)e * 512 * D; d.ldd = D; d.rmk = 3; d.which = which; d.scale = 32.0f; }
          else { r -= 2 * I13; const int kb = r / (D / 64), nb = r % (D / 64);
              d.src = w2 + (size_t)e * DEXP * D; d.N = D; d.k0 = 32 * kb; d.n0 = 64 * nb; d.dst = w2t + (size_t)e * D * DEXP; d.ldd = DEXP; d.rmk = 0; d.which = 0; d.scale = 16.0f; }
          return d; };
      const int per_wg = (NEXP * IPE + F.G - 1) / F.G;
      const int base = F.vcu * per_wg;
      const int q4 = per_wg / 24;
      const int restw = (per_wg - 4 * q4 + 3) / 4;
      const int lo_ = wid < 4 ? wid * q4 : 4 * q4 + (wid - 4) * restw;
      int hi_ = wid < 4 ? lo_ + q4 : lo_ + restw; if (hi_ > per_wg) hi_ = per_wg;
      int endi = base + hi_; if (endi > NEXP * IPE) endi = NEXP * IPE;
      titems_run(gen, base + lo_, 1, endi, tscr, lane); }
    __syncthreads();
}

__device__ __forceinline__ void p8_final(const Frame& F, const Args& a, const bool live) {
    const int gw = F.vcu * NWAVES + F.wave, NGW = F.G * NWAVES, lane = F.lane;
    const unsigned char* yp = a.ws + WS_YP;
    const LAS int* pref = (const LAS int*)(F.lds + PREF_OFF);
    f32x4 gv[4];
#pragma unroll
    for (int j = 0; j < 4; ++j) gv[j] = *((const f32x4*)a.norm_final_g + lane + 64 * j);
    for (int m = gw; m < T; m += NGW) {
        f32x4* xr = (f32x4*)(a.out + (size_t)m * D) + lane;
        const u32x2* hr = (const u32x2*)((const bf16_t*)(a.ws + WS_HB) + (size_t)m * D) + lane;
        const int2 iv = *(const int2*)((const int*)(a.ws + WS_INV) + m * 2); const float2 wv = *(const float2*)((const float*)(a.ws + WS_WTOK) + m * 2);
        const int pr0 = 256 * pref[iv.x >> 14] + (iv.x & (LCAP - 1)), pr1 = 256 * pref[iv.y >> 14] + (iv.y & (LCAP - 1));
        const unsigned* y0 = (const unsigned*)(yp + (size_t)pr0 * D) + lane; const unsigned* y1 = (const unsigned*)(yp + (size_t)pr1 * D) + lane;
        const float w0 = wv.x * (1.0f / 16.0f), w1 = wv.y * (1.0f / 16.0f);
        f32x4 v[4]; float s = 0.f;
#pragma unroll
        for (int j = 0; j < 4; ++j) { const unsigned p0 = y0[64 * j], p1 = y1[64 * j];
            const f32x2 a0 = __builtin_amdgcn_cvt_pk_f32_fp8((int)p0, false), a1 = __builtin_amdgcn_cvt_pk_f32_fp8((int)p0, true), b0 = __builtin_amdgcn_cvt_pk_f32_fp8((int)p1, false), b1 = __builtin_amdgcn_cvt_pk_f32_fp8((int)p1, true);
            const u32x2 hb = hr[64 * j];
            v[j] = (f32x4){bf_lo(hb.x), bf_hi(hb.x), bf_lo(hb.y), bf_hi(hb.y)} + (f32x4){w0 * a0[0] + w1 * b0[0], w0 * a0[1] + w1 * b0[1], w0 * a1[0] + w1 * b1[0], w0 * a1[1] + w1 * b1[1]};
            s += (v[j].x * v[j].x + v[j].y * v[j].y) + (v[j].z * v[j].z + v[j].w * v[j].w); }
        const float rs = 1.0f / sqrtf(wave_sum(s) * (1.f / D) + NORM_EPS);
#pragma unroll
        for (int j = 0; j < 4; ++j) if (live) xr[64 * j] = v[j] * rs * gv[j];
    }
}

constexpr int N_PHASES = 9;
__global__ void __launch_bounds__(NTHREADS, 2) mk_fwd(Args args) {
    extern __shared__ __attribute__((aligned(16))) unsigned char lds_raw[];
#define MKFRAME() Frame F; { unsigned l_ = __builtin_amdgcn_mbcnt_hi(~0u, __builtin_amdgcn_mbcnt_lo(~0u, 0u)); asm volatile("" : "+v"(l_)); F.lds = (LAS unsigned char*)lds_raw; F.lane = (int)l_; F.wave = wave0; F.tid = wave0 * 64 + F.lane; \
        F.G = gridDim.x; const int bx_ = blockIdx.x; F.vcu = (F.G % 8 == 0) ? (bx_ % 8) * (F.G / 8) + bx_ / 8 : bx_; }
    LAS unsigned char* const lds0 = (LAS unsigned char*)lds_raw;
    const int wave0 = __builtin_amdgcn_readfirstlane((int)(threadIdx.x >> 6));
    unsigned char* ws = args.ws;
    unsigned* ctl = (unsigned*)(ws + WS_CTL);
    if (threadIdx.x < 64) ((LAS unsigned*)(lds0 + MISC_OFF))[threadIdx.x] = 0u;
    __syncthreads();
    const int lo = args.ph_lo, hi = args.ph_hi, repm = args.rep_mask;
    XcdBarrier bar; bar.bar = ctl + CW_BAR; bar.x = 0; bar.st = nullptr;
    bar = xcd_barrier_post(ctl + CW_BAR, (volatile LAS unsigned*)(lds0 + MISC_OFF));
#ifndef PHASE_MASK
#define PHASE_MASK 0x1ff
#endif
#define IN(k) (((PHASE_MASK >> (k)) & 1) && lo <= (k) && (k) < hi)
#define SEAM(k) do { if (IN(k) && IN((k) + 1)) xcd_barrier(bar); } while (0)
#define REP(k) _Pragma("unroll 1") for (int rep_ = ((repm >> (k)) & 1); rep_ >= 0; --rep_)
#define LIVE (rep_ == 0)

    if (IN(0)) { REP(0) { MKFRAME(); const Args a = load_args(); p0_prologue(F, a); } SEAM(0); }
    if (IN(1)) { REP(1) {
        { MKFRAME(); const Args args = load_args();
          pg8::StaticOrder S; S.init((const bf16_t*)args.out, (const bf16_t*)(ws + WS_WIN), T, 2048, D, F.G, (int)blockIdx.x);
          EpiInProj E{(bf16_t*)(ws + WS_U), args.b_gates, (float*)(ws + WS_KPART), (f32x2*)(ws + WS_STAT), 0};
          pg8::gemm_phase<EpiInProj, pg8::StaticOrder, false, D>(F.lds, F.tid, S, E, nullptr); }
        { MKFRAME(); const Args args = load_args();
          pg8::StaticOrder S; S.init((const bf16_t*)(ws + WS_XN8), (const bf16_t*)(ws + WS_WIN8), T, 5120, D / 2, F.G, (int)blockIdx.x);
          EpiInProj E{(bf16_t*)(ws + WS_U), args.b_gates, (float*)(ws + WS_KPART), (f32x2*)(ws + WS_STAT), 8};
          pg8::gemm_phase<EpiInProj, pg8::StaticOrder, false, D / 2, 0x7a>(F.lds, F.tid, S, E, nullptr); } }
        SEAM(1);
    }
    if (IN(3)) { REP(3) { MKFRAME(); const Args a = load_args(); p3_attention(F, a, LIVE); } SEAM(3); }
    if (IN(4)) { REP(4) {
        MKFRAME(); const Args args = load_args();
        pg8::StaticOrder S; S.init((const bf16_t*)(ws + WS_U), (const bf16_t*)(ws + WS_WOUT), T, D, D, F.G, (int)blockIdx.x);
        EpiOutProj E{args.x, (bf16_t*)(ws + WS_HB)};
        pg8::gemm_phase<EpiOutProj, pg8::StaticOrder, false, D>(F.lds, F.tid, S, E, nullptr); }
        SEAM(4);
    }
    if (IN(5)) { REP(5) { MKFRAME(); const Args a = load_args(); p5_router(F, a, LIVE); } SEAM(5); }
    if (IN(6) || IN(7) || IN(8)) {
        if (threadIdx.x == 0) { LAS int* pref = (LAS int*)(lds0 + PREF_OFF); int acc = 0;
            for (int e = 0; e < NEXP; ++e) { pref[e] = acc; const int c = (int)__hip_atomic_load(ctl + CW_CNT + 64 * e, __ATOMIC_RELAXED, __HIP_MEMORY_SCOPE_AGENT); acc += (c + 255) >> 8; }
            pref[NEXP] = acc; }
        __syncthreads();
    }
    if (IN(6)) { REP(6) {
        typedef pg8::MoeOrder<2, 0, (size_t)512 * D, (size_t)256 * D, D> Ord1;
        typedef pg8::MoeOrder<4, (size_t)256 * DEXP, (size_t)D * DEXP, (size_t)256 * DEXP, 0> Ord2;
        const int G = gridDim.x, total = __builtin_amdgcn_readfirstlane(((const LAS int*)(lds0 + PREF_OFF))[NEXP]);
        const int n1 = 2 * total, r = n1 > G ? n1 - G : 0, early = (n1 > G ? G : n1) / 2;
#pragma unroll 1
        for (int stage = 0; stage < 2; ++stage) {
            MKFRAME();
            Ord1 S; S.pref = (const LAS int*)(F.lds + PREF_OFF); S.c = (int)blockIdx.x; S.A = (const char*)(ws + WS_XN2); S.Bt = (const char*)(ws + WS_W13); S.list = (const int*)(ws + WS_LIST);
            S.first = stage == 0 ? 0 : 2 * early; S.limit = stage == 0 ? 2 * early : n1; S.cbase = 0; S.nwg = stage == 0 ? G : (r > 0 ? r : 1);
            EpiMoe1 E{ws + WS_HID, (const float*)(ws + WS_RSP), ctl + CW_CNT};
            pg8::gemm_phase<EpiMoe1, Ord1, true, D / 2, 0x7a>(F.lds, F.tid, S, E, ctl + CW_CNT);
            if (stage == 0) xcd_barrier(bar);
        }
#pragma unroll 1
        for (int stage = 1; stage < 3; ++stage) {
            MKFRAME();
            Ord2 S; S.pref = (const LAS int*)(F.lds + PREF_OFF); S.c = (int)blockIdx.x; S.A = (const char*)(ws + WS_HID); S.Bt = (const char*)(ws + WS_W2); S.list = (const int*)(ws + WS_LIST);
            S.first = stage == 2 ? 4 * early : 0; S.limit = stage == 1 ? 4 * early : 4 * total; S.cbase = stage == 1 ? r : 0; S.nwg = stage == 1 ? G - r : G;
            EpiMoe2 E{ws + WS_YP};
            pg8::gemm_phase<EpiMoe2, Ord2, false, DEXP / 2, 0x7b>(F.lds, F.tid, S, E, nullptr);
            if (stage == 1) xcd_barrier(bar);
        } }
        SEAM(6);
    }
    if (IN(8)) { REP(8) { MKFRAME(); const Args a = load_args(); p8_final(F, a, LIVE); } }
#undef IN
#undef SEAM
#undef REP
#undef LIVE
}

#ifndef MK_REP_MASK
#define MK_REP_MASK 0x000
#endif
#ifndef MK_SPLIT
#define MK_SPLIT 0
#endif
extern "C" void kernel_launch(void* const* d_in, const int* in_sizes, int n_in, void* d_out, int out_size, void* d_ws, size_t ws_size, hipStream_t stream) {
    static int grid = 0;
    if (grid == 0) {
        if (n_in != 19 || out_size != T * D || ws_size < WS_END) { fprintf(stderr, "kernel_launch: unexpected problem (n_in %d, out %d, ws %zu)\n", n_in, out_size, ws_size); grid = -1; return; }
        int dev = 0, cus = 0, per_cu = 0;
        if (hipGetDevice(&dev) != hipSuccess || hipDeviceGetAttribute(&cus, hipDeviceAttributeMultiprocessorCount, dev) != hipSuccess) { grid = -1; return; }
        if (hipFuncSetAttribute((const void*)mk_fwd, hipFuncAttributeMaxDynamicSharedMemorySize, LDS_BYTES) != hipSuccess) { fprintf(stderr, "kernel_launch: hipFuncSetAttribute failed\n"); grid = -1; return; }
        if (hipOccupancyMaxActiveBlocksPerMultiprocessor(&per_cu, (const void*)mk_fwd, NTHREADS, LDS_BYTES) != hipSuccess || per_cu < 1) fprintf(stderr, "kernel_launch: occupancy query reports %d\n", per_cu);
        (void)hipGetLastError();
        grid = cus;
    }
    if (grid < 0) return;
    if (hipMemsetAsync((char*)d_ws + WS_CTL, 0, CTL_ZERO_BYTES, stream) != hipSuccess) return;
    Args a{};
    a.x = (const float*)d_in[0]; a.norm_mix_g = (const float*)d_in[1]; a.w_in = (const float*)d_in[2]; a.b_gates = (const float*)d_in[3]; a.ln_g = (const float*)d_in[4]; a.ln_b = (const float*)d_in[5];
    a.w_spatial = (const float*)d_in[6]; a.b_spatial = (const float*)d_in[7]; a.rel_bias = (const float*)d_in[8]; a.w_out = (const float*)d_in[9]; a.norm_ffn_g = (const float*)d_in[10];
    a.w_gr = (const float*)d_in[11]; a.b_gr = (const float*)d_in[12]; a.w_er = (const float*)d_in[13]; a.b_er = (const float*)d_in[14]; a.w1 = (const float*)d_in[15]; a.w3 = (const float*)d_in[16]; a.w2 = (const float*)d_in[17];
    a.norm_final_g = (const float*)d_in[18]; a.out = (float*)d_out; a.ws = (unsigned char*)d_ws; a.rep_mask = MK_REP_MASK; a.pad = 0;
#if MK_SPLIT
    for (int p = 0; p < N_PHASES; ++p) { a.ph_lo = p; a.ph_hi = p + 1; hipLaunchKernelGGL(mk_fwd, dim3(grid), dim3(NTHREADS), LDS_BYTES, stream, a); }
#else
    a.ph_lo = 0; a.ph_hi = N_PHASES; hipLaunchKernelGGL(mk_fwd, dim3(grid), dim3(NTHREADS), LDS_BYTES, stream, a);
#endif
}
```

```cpp
#include <hip/hip_runtime.h>
#include <cstdio>
#include <cstdint>

#define LAS __attribute__((address_space(3)))
#define GAS __attribute__((address_space(1)))
typedef unsigned short bf16_t;
typedef short bf16x8 __attribute__((ext_vector_type(8)));
typedef short s16x4 __attribute__((ext_vector_type(4)));
typedef float f32x4 __attribute__((ext_vector_type(4)));
typedef float f32x2 __attribute__((ext_vector_type(2)));
typedef float f32x16 __attribute__((ext_vector_type(16)));
typedef unsigned u32x4 __attribute__((ext_vector_type(4)));
typedef unsigned u32x2 __attribute__((ext_vector_type(2)));

constexpr int T = 16384, D = 1024, NCOL = 7168, SEQ = 4096, NBATCH = 4, NH = 8, HD = 128;
constexpr int NEXP = 32, DEXP = 256, LCAP = 16384;
constexpr float NORM_EPS = 1e-6f;
constexpr float LOG2E = 1.4426950408889634f;
constexpr int NWAVES = 8, NTHREADS = 512;

constexpr size_t MiB = 1u << 20;
constexpr size_t WS_CTL = 0, CTL_ZERO_BYTES = 1 * MiB;
constexpr size_t WS_WIN = 1 * MiB;
constexpr size_t WS_WIN8 = 5 * MiB;
constexpr size_t WS_XN8 = 212 * MiB;
constexpr size_t WS_WOUT = 15 * MiB;
constexpr size_t WS_WSB = 17 * MiB;
constexpr size_t WS_KPART = 17 * MiB + 256 * 1024;
constexpr size_t WS_RW = 17 * MiB + 768 * 1024;
constexpr size_t WS_LPART = 100 * MiB;
constexpr size_t WS_SSQ = 113 * MiB;
constexpr size_t WS_STAT = 18 * MiB;
constexpr size_t WS_U = 20 * MiB;
constexpr size_t SEG_BYTES = 32 * MiB;
constexpr size_t WS_VG = WS_U + SEG_BYTES, WS_Q = WS_U + 2 * SEG_BYTES, WS_K = WS_U + 3 * SEG_BYTES, WS_VA = WS_U + 4 * SEG_BYTES, WS_GB = WS_U + 5 * SEG_BYTES;
constexpr size_t WS_XN2 = 52 * MiB;
constexpr size_t WS_W13 = 84 * MiB;
constexpr size_t WS_W2 = 116 * MiB;
constexpr size_t WS_HID = 132 * MiB;
constexpr size_t WS_YP = 152 * MiB;
constexpr size_t WS_LIST = 232 * MiB;
constexpr size_t WS_INV = 234 * MiB;
constexpr size_t WS_WTOK = 235 * MiB;
constexpr size_t WS_RSP = 236 * MiB;
constexpr size_t WS_HB = 192 * MiB;
constexpr size_t WS_END = 238 * MiB;
constexpr int CW_BAR = 4096;
constexpr int CW_CNT = 8192;

constexpr int RING_BYTES = 131072;
constexpr int MISC_OFF = RING_BYTES;
constexpr int PREF_OFF = MISC_OFF + 64;
constexpr int LDS_BYTES = 163840;
constexpr int RED_OFF = MISC_OFF + 4096, RED_BYTES = 64 * 52 * 4;

typedef __bf16 bf16x2_t __attribute__((ext_vector_type(2)));
__device__ __forceinline__ unsigned cvt_pk_bf16(float lo, float hi) { const f32x2 v = {lo, hi}; const bf16x2_t b = __builtin_convertvector(v, bf16x2_t); return __builtin_bit_cast(unsigned, b); }
__device__ __forceinline__ unsigned cvt_pk4_fp8(float a, float b, float c, float d) { unsigned w = 0u; w = (unsigned)__builtin_amdgcn_cvt_pk_fp8_f32(a, b, (int)w, false); w = (unsigned)__builtin_amdgcn_cvt_pk_fp8_f32(c, d, (int)w, true); return w; }
__device__ __forceinline__ float bf_lo(unsigned w) { return __uint_as_float(w << 16); }
__device__ __forceinline__ float bf_hi(unsigned w) { return __uint_as_float(w & 0xffff0000u); }
__device__ __forceinline__ float wave_sum(float v) {
#pragma unroll
    for (int o = 1; o < 64; o <<= 1) v += __shfl_xor(v, o);
    return v;
}
#define LDS_WAIT() asm volatile("s_waitcnt lgkmcnt(0)" ::: "memory")
#define VM_WAIT() asm volatile("s_waitcnt vmcnt(0)" ::: "memory")

#define XB_TMO      128
#define XB_XCNT(j)  (256  + 64 * (j))
#define XB_XSUB(j)  (1280 + 64 * (j))
#define XB_XGEN(j)  (2304 + 64 * (j))
#define XB_TOP      3328
#define XB_TOPGEN   3392
#define XCD_BAR_WORDS 3456
#define XB_SPIN_CAP (1u << 18)
__device__ __forceinline__ unsigned xb_ld(unsigned* p)              { return __hip_atomic_load(p, __ATOMIC_RELAXED, __HIP_MEMORY_SCOPE_AGENT); }
__device__ __forceinline__ unsigned xb_add(unsigned* p, unsigned v) { return __hip_atomic_fetch_add(p, v, __ATOMIC_RELAXED, __HIP_MEMORY_SCOPE_AGENT); }
__device__ __forceinline__ unsigned xb_xcc_id() { return (unsigned)__builtin_amdgcn_s_getreg((3 << 11) | 20) & 0xFu; }
#define XB_SPIN(cond, bar) do { unsigned _sp = 0; while (cond) { __builtin_amdgcn_s_sleep(1); \
    if ((++_sp & 255u) == 0u) { if (xb_ld(&(bar)[XB_TMO])) break; if (_sp > XB_SPIN_CAP) { atomicAdd(&(bar)[XB_TMO], 1u); break; } } } } while (0)
struct XcdBarrier { unsigned* bar; unsigned x; volatile LAS unsigned* st; };
__device__ __forceinline__ XcdBarrier xcd_barrier_post(unsigned* bar, volatile LAS unsigned* st) {
    XcdBarrier b; b.bar = bar; b.x = xb_xcc_id(); b.st = st;
    if (threadIdx.x == 0) (void)xb_add(&bar[XB_XCNT(b.x)], 1u);
    return b;
}
__device__ __forceinline__ void xcd_barrier_complete(unsigned* bar, unsigned x, unsigned& nloc, unsigned& nx) {
    const unsigned G = gridDim.x * gridDim.y * gridDim.z;
    unsigned sum, cnt, mine, sp = 0u;
    for (;;) {
        sum = 0u; cnt = 0u; mine = 0u;
#pragma unroll
        for (unsigned j = 0; j < 16; ++j) { const unsigned c = xb_ld(&bar[XB_XCNT(j)]); sum += c; cnt += (c > 0u) ? 1u : 0u; mine = (j == x) ? c : mine; }
        if (sum == G) break;
        __builtin_amdgcn_s_sleep(1);
        if ((++sp & 255u) == 0u) { if (xb_ld(&bar[XB_TMO])) break; if (sp > XB_SPIN_CAP) { atomicAdd(&bar[XB_TMO], 1u); break; } }
    }
    nloc = mine > 0u ? mine : 1u; nx = cnt > 0u ? cnt : 1u;
}
__device__ __forceinline__ void xcd_barrier(const XcdBarrier& b) {
    asm volatile("s_waitcnt vmcnt(0)" ::: "memory");
    __syncthreads();
    if (threadIdx.x == 0) {
        unsigned* bar = b.bar;
        __builtin_amdgcn_s_waitcnt(0);
        unsigned nloc = b.st[0], nx = b.st[1];
        if (nloc == 0u) { xcd_barrier_complete(bar, b.x, nloc, nx); b.st[0] = nloc; b.st[1] = nx; }
        const unsigned old = xb_add(&bar[XB_XSUB(b.x)], 1u);
        const unsigned gen = old / nloc;
        if (old + 1u == (gen + 1u) * nloc) {
            __builtin_amdgcn_fence(__ATOMIC_RELEASE, "agent");
            asm volatile("s_waitcnt vmcnt(0)" ::: "memory");
            const unsigned og = xb_add(&bar[XB_TOP], 1u);
            const unsigned tg = og / nx;
            if (og + 1u == (tg + 1u) * nx) xb_add(&bar[XB_TOPGEN], 1u);
            else XB_SPIN(xb_ld(&bar[XB_TOPGEN]) == tg, bar);
            __builtin_amdgcn_fence(__ATOMIC_ACQUIRE, "agent");
            xb_add(&bar[XB_XGEN(b.x)], 1u);
            asm volatile("s_waitcnt vmcnt(0)" ::: "memory");
        } else {
            XB_SPIN(xb_ld(&bar[XB_XGEN(b.x)]) == gen, bar);
            __builtin_amdgcn_fence(__ATOMIC_ACQUIRE, "agent");
            asm volatile("s_waitcnt vmcnt(0)" ::: "memory");
        }
    }
    __syncthreads();
}

namespace pg8 {
constexpr int BM = 256, BK = 64, HALF = 128, HTB = HALF * BK * 2, STAGE_BYTES = 8 * HTB, NXCD = 8, WGM = 8;
__host__ __device__ __forceinline__ int lds_byte(int r, int c) { const int st = (r >> 4) * 2 + (c >> 5), rr = r & 15, cc = c & 31, ob = rr * 64 + cc * 2; return st * 1024 + (ob ^ (((ob >> 9) & 1) << 5)); }
__host__ __device__ __forceinline__ void stage_rc(int b, int& R, int& C) { const int st = b / 1024, sb = b % 1024, swz = sb ^ (((sb >> 9) & 1) << 5); R = (st >> 1) * 16 + swz / 64; C = (st & 1) * 32 + (swz % 64) / 2; }
__host__ __device__ __forceinline__ int perm32(int rho) { const int n = rho >> 4, i = rho & 15; return 8 * (i >> 2) + 4 * n + (i & 3); }

struct Unit { int pm, pn, ex, rt; };

struct StaticOrder {
    int nM, nN, nwg, G, c; const char* A; const char* Bt; size_t tstep;
    __device__ void init(const bf16_t* A_, const bf16_t* Bt_, int M, int N, int K, int G_, int c_) { nM = M / BM; nN = N / BM; nwg = nM * nN; G = G_; c = c_; A = (const char*)A_; Bt = (const char*)Bt_; tstep = (size_t)BM * K * 2; }
    __device__ bool next(int i, Unit& u) const {
        const long L = (long)i * G + c; if (L >= nwg) return false;
        int wgid = (int)L; { const int q = nwg / NXCD, r = nwg % NXCD, xcd = wgid % NXCD, off = wgid / NXCD; wgid = (xcd < r ? xcd * (q + 1) : r * (q + 1) + (xcd - r) * q) + off; }
        const int nig = WGM * nN, gid = wgid / nig, fm = gid * WGM, gsz = (nM - fm) < WGM ? (nM - fm) : WGM;
        u.pm = fm + ((wgid % nig) % gsz); u.pn = (wgid % nig) / gsz; u.ex = 0; u.rt = 0; return true;
    }
    __device__ __forceinline__ const char* abase(const Unit& u) const { return A + (size_t)u.pm * tstep; }
    __device__ __forceinline__ const char* bbase(const Unit& u) const { return Bt + (size_t)u.pn * tstep; }
    __device__ __forceinline__ unsigned arow_off(const Unit&, int) const { return 0u; }
};
template <int npn, size_t a_tstep, size_t b_estep, size_t b_tstep, unsigned rowbytes>
struct MoeOrder {
    const LAS int* pref; int c; const char* A; const char* Bt; const int* list;
    int first, limit, cbase, nwg;
    __device__ bool next(int i, Unit& u) const {
        if (c < cbase || c >= cbase + nwg) return false;
        const long L = (long)first + (long)i * nwg + (c - cbase);
        if (L >= (long)limit) return false;
        const int tl = (int)(L / npn); u.pn = (int)(L % npn); u.pm = tl;
        const int ln = (int)__builtin_amdgcn_mbcnt_hi(~0u, __builtin_amdgcn_mbcnt_lo(~0u, 0u));
        const int mine = pref[ln & 31];
        const unsigned long long m = __ballot(ln >= 1 && ln < NEXP && mine <= tl);
        const int e = __builtin_popcountll(m);
        u.ex = e; u.rt = tl - __builtin_amdgcn_readlane(mine, e); return true;
    }
    __device__ __forceinline__ const char* abase(const Unit& u) const { return A + (size_t)u.pm * a_tstep; }
    __device__ __forceinline__ const char* bbase(const Unit& u) const { return Bt + (size_t)u.ex * b_estep + (size_t)u.pn * b_tstep; }
    __device__ __forceinline__ unsigned arow_off(const Unit& u, int r, int cnt_e) const {
        int p = u.rt * 256 + r; p = p < cnt_e ? p : 0;
        const int ent = list[u.ex * LCAP + p];
        return (unsigned)(ent >> 1) * rowbytes;
    }
};

typedef float f32x2v __attribute__((ext_vector_type(2)));
typedef int i32x4_t __attribute__((ext_vector_type(4)));
typedef int i32x8_t __attribute__((ext_vector_type(8)));
__device__ __forceinline__ f32x2v gelu_pk(f32x2v v) {
    const f32x2v av = __builtin_elementwise_abs(v), d = av * 0.2316418882f + 1.0f;
    f32x2v t; t.x = __builtin_amdgcn_rcpf(d.x); t.y = __builtin_amdgcn_rcpf(d.y);
    f32x2v q = t * 0.5307027145f + (-0.7265760135f); q = q * t + 0.7107068705f; q = q * t + (-0.142248368f); q = q * t + 0.127414796f; q = q * t;
    const f32x2v s = (v * v) * (-0.72134752044f);
    f32x2v e; e.x = __builtin_amdgcn_exp2f(s.x); e.y = __builtin_amdgcn_exp2f(s.y);
    const f32x2v m = v * (q * e), r = v - m;
    f32x2v o; o.x = v.x < 0.f ? m.x : r.x; o.y = v.y < 0.f ? m.y : r.y; return o;
}

template <class Epi, class Sched, bool GATHER, int K, int WSCALE = 0>
__device__ __forceinline__ void gemm_phase(LAS unsigned char* lds, const int tid, const Sched& S, const Epi& E, const unsigned* cnts) {
    const int wid = __builtin_amdgcn_readfirstlane(tid >> 6), lane = tid & 63, wr = wid >> 2, wc = wid & 3, fr = lane & 15, fq = lane >> 4;
    const int nt = K / BK;
    unsigned voffA[2], voffB[2]; int stR[2];
#pragma unroll
    for (int i = 0; i < 2; ++i) { int R, C; stage_rc(tid * 16 + i * 8192, R, C); const int Rb = Epi::PERM ? ((R & ~31) + perm32(R & 31)) : R;
        voffA[i] = GATHER ? (unsigned)(C * 2) : (unsigned)(R * K + C) * 2u; voffB[i] = (unsigned)(Rb * K + C) * 2u; stR[i] = R; }
    const size_t kstep = (size_t)(BK * 2);
    const size_t hstep = (size_t)HALF * K * 2;
    const unsigned ldsw = (unsigned)wid * 1024u;
    const int aoff = lds_byte(wr * 64 + fr, fq * 8), boff = lds_byte(wc * 32 + fr, fq * 8);
#define PG8_SA(b, h) (((b) * 2 + (h)) * HTB)
#define PG8_SB(b, h) ((4 + (b) * 2 + (h)) * HTB)
#define PG8_GLDS(gp, bufoff, i) __builtin_amdgcn_global_load_lds((const unsigned*)(gp), (LAS unsigned*)(lds + (bufoff) + ldsw + (i) * 8192), 16, 0, 0)
#define PG8_STAGE(bufoff, gbase, voff) do { _Pragma("unroll") for (int _i = 0; _i < 2; ++_i) PG8_GLDS((const char*)(gbase) + (voff)[_i], bufoff, _i); } while (0)
#define PG8_STAGE_A(bufoff, H, NX, KO) do { _Pragma("unroll") for (int _i = 0; _i < 2; ++_i) { \
        if constexpr (GATHER) { const unsigned _o = (NX) ? offN[H][_i] : offC[H][_i]; PG8_GLDS(gA + _o + voffA[_i] + (KO), bufoff, _i); } \
        else { PG8_GLDS(((NX) ? nA : cA) + (H) * hstep + voffA[_i] + (KO), bufoff, _i); } } } while (0)
#define PG8_LDA(dst, b, h) do { _Pragma("unroll") for (int m = 0; m < 4; ++m) { dst[m].lo = *(const LAS i32x4_t*)(lds + PG8_SA(b, h) + aoff + m * 2048); dst[m].hi = *(const LAS i32x4_t*)(lds + PG8_SA(b, h) + aoff + m * 2048 + 1024); } } while (0)
#define PG8_LDB(dst, b, h) do { _Pragma("unroll") for (int n = 0; n < 2; ++n) { dst[n].lo = *(const LAS i32x4_t*)(lds + PG8_SB(b, h) + boff + n * 2048); dst[n].hi = *(const LAS i32x4_t*)(lds + PG8_SB(b, h) + boff + n * 2048 + 1024); } } while (0)
#define PG8_MMA(ai, bj, At, Bt) do { __builtin_amdgcn_s_setprio(1); if constexpr (WSCALE != 0) asm volatile("s_nop 3" ::: "memory");     \
        _Pragma("unroll") for (int m = 0; m < 4; ++m) _Pragma("unroll") for (int n = 0; n < 2; ++n) { \
        if constexpr (WSCALE != 0) { asm volatile("v_mfma_scale_f32_16x16x128_f8f6f4 %0, %1, %2, %0, %3, %4 op_sel_hi:[0,0,0]" : "+v"(acc[ai][bj][m][n]) : "v"(Bt[n]), "v"(At[m]), "v"(wscale_v), "v"(ascale_v)); } \
        else { const i32x4_t bl_ = Bt[n].lo, bh_ = Bt[n].hi, al_ = At[m].lo, ah_ = At[m].hi;     \
               acc[ai][bj][m][n] = __builtin_amdgcn_mfma_f32_16x16x32_bf16(__builtin_bit_cast(bf16x8, bl_), __builtin_bit_cast(bf16x8, al_), acc[ai][bj][m][n], 0, 0, 0); \
               acc[ai][bj][m][n] = __builtin_amdgcn_mfma_f32_16x16x32_bf16(__builtin_bit_cast(bf16x8, bh_), __builtin_bit_cast(bf16x8, ah_), acc[ai][bj][m][n], 0, 0, 0); } } \
        __builtin_amdgcn_s_setprio(0); } while (0)
#define PG8_WAIT_V(n) asm volatile("s_waitcnt vmcnt(" #n ")" ::: "memory")
#define PG8_WAIT_L(n) asm volatile("s_waitcnt lgkmcnt(" #n ")" ::: "memory")
#define PG8_BAR __builtin_amdgcn_s_barrier()
#define PG8_SCHED __builtin_amdgcn_sched_barrier(0)
    Unit cur, nxt; int ui = 0;
    if (!S.next(0, cur)) return;
    f32x4 acc[2][2][4][2];
#pragma unroll
    for (int a = 0; a < 2; ++a)
#pragma unroll
        for (int b = 0; b < 2; ++b)
#pragma unroll
            for (int m = 0; m < 4; ++m)
#pragma unroll
                for (int n = 0; n < 2; ++n) acc[a][b][m][n] = (f32x4){0.f, 0.f, 0.f, 0.f};
    i32x8_t At[4], B0[2], B1[2];
    const int wscale_v = WSCALE * 0x01010101, ascale_v = 0x7f7f7f7f;
    const char* gA = S.A;
    const char* cA = S.abase(cur); const char* cB = S.bbase(cur);
    const char* nA = cA;
    unsigned offC[2][2], offN[2][2];
    if constexpr (GATHER) {
        const int ce = __builtin_amdgcn_readfirstlane((int)cnts[64 * cur.ex]);
#pragma unroll
        for (int h = 0; h < 2; ++h)
#pragma unroll
            for (int i = 0; i < 2; ++i) { offC[h][i] = S.arow_off(cur, stR[i] + h * HALF, ce); offN[h][i] = offC[h][i]; }
    } else {
#pragma unroll
        for (int h = 0; h < 2; ++h)
#pragma unroll
            for (int i = 0; i < 2; ++i) { offC[h][i] = 0u; offN[h][i] = 0u; }
    }
    PG8_STAGE(PG8_SB(0, 0), cB, voffB); PG8_STAGE(PG8_SB(0, 1), cB + hstep, voffB); PG8_STAGE_A(PG8_SA(0, 0), 0, false, 0); PG8_STAGE_A(PG8_SA(0, 1), 1, false, 0);
    if (wr == 1) PG8_BAR;
    PG8_WAIT_V(2); PG8_BAR;
    PG8_STAGE(PG8_SB(1, 0), cB + kstep, voffB); PG8_STAGE_A(PG8_SA(1, 0), 0, false, kstep); PG8_STAGE(PG8_SB(1, 1), cB + hstep + kstep, voffB);
    PG8_WAIT_V(6); PG8_BAR;
    for (;;) {
        const bool has_next = S.next(ui + 1, nxt);
        nA = has_next ? S.abase(nxt) : cA; const char* nB = has_next ? S.bbase(nxt) : cB;
        if constexpr (GATHER) {
            if (has_next) { const int ce = __builtin_amdgcn_readfirstlane((int)cnts[64 * nxt.ex]);
#pragma unroll
                for (int h = 0; h < 2; ++h)
#pragma unroll
                    for (int i = 0; i < 2; ++i) offN[h][i] = S.arow_off(nxt, stR[i] + h * HALF, ce);
            } else {
#pragma unroll
                for (int h = 0; h < 2; ++h)
#pragma unroll
                    for (int i = 0; i < 2; ++i) offN[h][i] = offC[h][i];
            }
        }
#pragma unroll 1
        for (int t = 0; t < nt; t += 2) {
            const bool last = (t == nt - 2);
            const size_t k1 = (size_t)(t + 1) * kstep;
            const size_t k2 = last ? 0 : (size_t)(t + 2) * kstep, k3 = k2 + kstep;
            const char* b2 = last ? nB : cB + (size_t)(t + 2) * kstep; const char* b3 = b2 + kstep;
            PG8_LDB(B0, 0, 0); PG8_LDB(B1, 0, 1); PG8_SCHED; PG8_LDA(At, 0, 0); PG8_STAGE_A(PG8_SA(1, 1), 1, false, k1);
            PG8_WAIT_V(8); PG8_WAIT_L(0); PG8_BAR; PG8_MMA(0, 0, At, B0); PG8_MMA(0, 1, At, B1); PG8_BAR; PG8_SCHED;
            PG8_LDA(At, 0, 1); PG8_STAGE(PG8_SB(0, 0), b2, voffB); PG8_STAGE(PG8_SB(0, 1), b2 + hstep, voffB); PG8_STAGE_A(PG8_SA(0, 0), 0, last, k2);
            PG8_WAIT_V(8); PG8_WAIT_L(0); PG8_BAR; PG8_MMA(1, 0, At, B0); PG8_MMA(1, 1, At, B1); PG8_BAR; PG8_SCHED;
            PG8_LDB(B0, 1, 0); PG8_LDB(B1, 1, 1); PG8_SCHED; PG8_LDA(At, 1, 0); PG8_STAGE_A(PG8_SA(0, 1), 1, last, k2);
            PG8_WAIT_V(8); PG8_WAIT_L(0); PG8_BAR; PG8_MMA(0, 0, At, B0); PG8_MMA(0, 1, At, B1); PG8_BAR; PG8_SCHED;
            PG8_LDA(At, 1, 1); PG8_STAGE(PG8_SB(1, 0), b3, voffB); PG8_STAGE(PG8_SB(1, 1), b3 + hstep, voffB); PG8_STAGE_A(PG8_SA(1, 0), 0, last, k3);
            PG8_WAIT_V(8); PG8_WAIT_L(0); PG8_BAR; PG8_MMA(1, 0, At, B0); PG8_MMA(1, 1, At, B1); PG8_BAR; PG8_SCHED;
        }
        if (wr == 0) PG8_BAR;
        if constexpr (WSCALE != 0) asm volatile("s_nop 15\n\ts_nop 7" ::: "memory");
        E(acc, cur, wr, wc, fr, fq);
        if (!has_next) break;
#pragma unroll
        for (int a = 0; a < 2; ++a)
#pragma unroll
            for (int b = 0; b < 2; ++b)
#pragma unroll
                for (int m = 0; m < 4; ++m)
#pragma unroll
                    for (int n = 0; n < 2; ++n) acc[a][b][m][n] = (f32x4){0.f, 0.f, 0.f, 0.f};
        cur = nxt; cA = nA; cB = nB; ++ui;
#pragma unroll
        for (int h = 0; h < 2; ++h)
#pragma unroll
            for (int i = 0; i < 2; ++i) offC[h][i] = offN[h][i];
        if (wr == 1) PG8_BAR;
    }
    PG8_WAIT_V(0);
    PG8_BAR;
#undef PG8_SA
#undef PG8_SB
#undef PG8_GLDS
#undef PG8_STAGE
#undef PG8_STAGE_A
#undef PG8_LDA
#undef PG8_LDB
#undef PG8_MMA
#undef PG8_WAIT_V
#undef PG8_WAIT_L
#undef PG8_BAR
#undef PG8_SCHED
}
}

struct EpiInProj {
    static constexpr bool PERM = true;
    bf16_t* seg0; const float* b_gates; float* kpart; f32x2* stats; int pn_off;
    __device__ __forceinline__ void operator()(const f32x4 (&acc)[2][2][4][2], const pg8::Unit& u_, int wr, int wc, int fr, int fq) const {
        pg8::Unit u = u_; u.pn += pn_off;
        const int row0 = u.pm * 256 + wr * 64 + fr;
        if (u.pn < 8) {
            const int ch0 = 128 * u.pn + 16 * wc + 4 * fq;
            f32x4 bv[2];
#pragma unroll
            for (int bj = 0; bj < 2; ++bj) bv[bj] = *(const f32x4*)(b_gates + ch0 + 64 * bj);
#pragma unroll
            for (int ai = 0; ai < 2; ++ai)
#pragma unroll
                for (int m = 0; m < 4; ++m) { bf16_t* rowp = seg0 + (size_t)(row0 + ai * 128 + m * 16) * D + ch0;
#pragma unroll
                    for (int bj = 0; bj < 2; ++bj) { const f32x4 uu = acc[ai][bj][m][0], gg = acc[ai][bj][m][1] + bv[bj];
                        const pg8::f32x2v a = pg8::gelu_pk((pg8::f32x2v){uu[0], uu[1]}), b = pg8::gelu_pk((pg8::f32x2v){uu[2], uu[3]});
                        float sg[4];
#pragma unroll
                        for (int j = 0; j < 4; ++j) sg[j] = __builtin_amdgcn_rcpf(1.0f + __builtin_amdgcn_exp2f(-LOG2E * gg[j]));
                        u32x2 w; w.x = cvt_pk_bf16(a.x * sg[0], a.y * sg[1]); w.y = cvt_pk_bf16(b.x * sg[2], b.y * sg[3]);
                        *(u32x2*)(rowp + 64 * bj) = w; } }
            return;
        }
        const int seg = (u.pn >> 2) - 1;
        const int colt = (u.pn & 3) * 256, col0 = colt + wc * 32 + 8 * fq;
        bf16_t* base = seg0 + (size_t)seg * (SEG_BYTES / 2);
        if (seg == 1) {
#pragma unroll
            for (int ai = 0; ai < 2; ++ai)
#pragma unroll
                for (int m = 0; m < 4; ++m) { bf16_t* rowp = base + (size_t)(row0 + ai * 128 + m * 16) * D + col0; float s1 = 0.f, s2 = 0.f;
#pragma unroll
                    for (int bj = 0; bj < 2; ++bj) { const f32x4 v0 = acc[ai][bj][m][0], v1 = acc[ai][bj][m][1];
                        const pg8::f32x2v a = pg8::gelu_pk((pg8::f32x2v){v0[0], v0[1]}), b = pg8::gelu_pk((pg8::f32x2v){v0[2], v0[3]}), c = pg8::gelu_pk((pg8::f32x2v){v1[0], v1[1]}), d = pg8::gelu_pk((pg8::f32x2v){v1[2], v1[3]});
                        s1 += ((a.x + a.y) + (b.x + b.y)) + ((c.x + c.y) + (d.x + d.y));
                        s2 += ((a.x * a.x + a.y * a.y) + (b.x * b.x + b.y * b.y)) + ((c.x * c.x + c.y * c.y) + (d.x * d.x + d.y * d.y));
                        u32x4 w; w.x = cvt_pk_bf16(a.x, a.y); w.y = cvt_pk_bf16(b.x, b.y); w.z = cvt_pk_bf16(c.x, c.y); w.w = cvt_pk_bf16(d.x, d.y);
                        *(u32x4*)(rowp + bj * 128) = w; }
                    s1 += __shfl_xor(s1, 16); s1 += __shfl_xor(s1, 32); s2 += __shfl_xor(s2, 16); s2 += __shfl_xor(s2, 32);
                    if (fq == 0) stats[(size_t)(row0 + ai * 128 + m * 16) * 16 + (u.pn & 3) * 4 + wc] = (f32x2){s1, s2}; }
        } else if (seg == 5) {
            const float* bp = b_gates + D + col0;
            f32x4 bv[2][2];
#pragma unroll
            for (int bj = 0; bj < 2; ++bj)
#pragma unroll
                for (int n = 0; n < 2; ++n) bv[bj][n] = *(const f32x4*)(bp + bj * 128 + 4 * n);
#pragma unroll
            for (int ai = 0; ai < 2; ++ai)
#pragma unroll
                for (int m = 0; m < 4; ++m) { bf16_t* rowp = base + (size_t)(row0 + ai * 128 + m * 16) * D + col0;
#pragma unroll
                    for (int bj = 0; bj < 2; ++bj) { f32x4 v0 = acc[ai][bj][m][0] + bv[bj][0], v1 = acc[ai][bj][m][1] + bv[bj][1];
#pragma unroll
                        for (int j = 0; j < 4; ++j) { v0[j] = __builtin_amdgcn_rcpf(1.0f + __builtin_amdgcn_exp2f(-LOG2E * v0[j])); v1[j] = __builtin_amdgcn_rcpf(1.0f + __builtin_amdgcn_exp2f(-LOG2E * v1[j])); }
                        u32x2 w; w.x = cvt_pk4_fp8(v0[0], v0[1], v0[2], v0[3]); w.y = cvt_pk4_fp8(v1[0], v1[1], v1[2], v1[3]);
                        *(u32x2*)((unsigned char*)base + (size_t)(row0 + ai * 128 + m * 16) * D + col0 + bj * 128) = w; } }
        } else if (seg == 4) {
            unsigned char* vt = (unsigned char*)base;
            const int pw = 4 * (8 * ((fr >> 2) & 1) + 4 * (fr >> 3) + (fr & 3));
#pragma unroll
            for (int ai = 0; ai < 2; ++ai)
#pragma unroll
                for (int bj = 0; bj < 2; ++bj) {
                    unsigned char* tb = vt + ((size_t)(((u.pm >> 4) * 8 + 2 * (u.pn & 3) + bj) * 64 + 4 * (u.pm & 15) + 2 * ai + wr) * 128 + 32 * wc + 8 * fq) * 64 + pw;
#pragma unroll
                    for (int n = 0; n < 2; ++n)
#pragma unroll
                        for (int i = 0; i < 4; ++i) *(unsigned*)(tb + (4 * n + i) * 64) = cvt_pk4_fp8(acc[ai][bj][0][n][i], acc[ai][bj][1][n][i], acc[ai][bj][2][n][i], acc[ai][bj][3][n][i]); }
        } else {
            if (seg == 3) {
#pragma unroll
                for (int ai = 0; ai < 2; ++ai)
#pragma unroll
                    for (int m = 0; m < 4; ++m)
#pragma unroll
                        for (int bj = 0; bj < 2; ++bj) { const f32x4 v0 = acc[ai][bj][m][0], v1 = acc[ai][bj][m][1];
                            u32x2 w; w.x = cvt_pk4_fp8(v0[0], v0[1], v0[2], v0[3]); w.y = cvt_pk4_fp8(v1[0], v1[1], v1[2], v1[3]);
                            *(u32x2*)((unsigned char*)base + (size_t)(row0 + ai * 128 + m * 16) * D + col0 + bj * 128) = w; }
            } else {
#pragma unroll
            for (int ai = 0; ai < 2; ++ai)
#pragma unroll
                for (int m = 0; m < 4; ++m) { bf16_t* rowp = base + (size_t)(row0 + ai * 128 + m * 16) * D + col0;
#pragma unroll
                    for (int bj = 0; bj < 2; ++bj) { const f32x4 v0 = acc[ai][bj][m][0], v1 = acc[ai][bj][m][1];
                        u32x4 w; w.x = cvt_pk_bf16(v0[0], v0[1]); w.y = cvt_pk_bf16(v0[2], v0[3]); w.z = cvt_pk_bf16(v1[0], v1[1]); w.w = cvt_pk_bf16(v1[2], v1[3]);
                        *(u32x4*)(rowp + bj * 128) = w; } }
            }
            if (seg == 3) {
#pragma unroll
                for (int bj = 0; bj < 2; ++bj)
#pragma unroll
                    for (int n = 0; n < 2; ++n) { f32x4 s = (f32x4){0.f, 0.f, 0.f, 0.f};
#pragma unroll
                        for (int ai = 0; ai < 2; ++ai)
#pragma unroll
                            for (int m = 0; m < 4; ++m) s += acc[ai][bj][m][n];
#pragma unroll
                        for (int o = 1; o < 16; o <<= 1) { s[0] += __shfl_xor(s[0], o); s[1] += __shfl_xor(s[1], o); s[2] += __shfl_xor(s[2], o); s[3] += __shfl_xor(s[3], o); }
                        if (fr == 0) *(f32x4*)(kpart + ((size_t)u.pm * 2 + wr) * D + col0 + bj * 128 + 4 * n) = s; }
            }
        }
    }
};
struct EpiOutProj {
    static constexpr bool PERM = true;
    const float* x; bf16_t* hb; const float* gffn; unsigned char* xn2; const bf16_t* rwh; float* lpart; float* ssqp; LAS unsigned char* red;
    __device__ __forceinline__ void operator()(const f32x4 (&acc)[2][2][4][2], const pg8::Unit& u, int wr, int wc, int fr, int fq) const {
        asm volatile("" : "+v"(fr), "+v"(fq));
        const int row0 = u.pm * 256 + wr * 64 + fr, col0 = u.pn * 256 + wc * 32 + 8 * fq, lane = fq * 16 + fr;
        const bf16_t* rwl = rwh + 48 * D;
        LAS float* R = (LAS float*)(red + wr * RED_BYTES);
        u32x4 hw[2][2][4]; float ssq[2][4];
#pragma unroll
        for (int ai = 0; ai < 2; ++ai)
#pragma unroll
            for (int m = 0; m < 4; ++m) ssq[ai][m] = 0.f;
#pragma unroll
        for (int bj = 0; bj < 2; ++bj) {
            const f32x4 g0 = *(const f32x4*)(gffn + col0 + 128 * bj), g1 = *(const f32x4*)(gffn + col0 + 128 * bj + 4);
#pragma unroll
            for (int ai = 0; ai < 2; ++ai)
#pragma unroll
                for (int m = 0; m < 4; ++m) { const size_t off = (size_t)(row0 + ai * 128 + m * 16) * D + col0 + bj * 128;
                    const f32x4 h0 = *(const f32x4*)(x + off) + acc[ai][bj][m][0], h1 = *(const f32x4*)(x + off + 4) + acc[ai][bj][m][1];
                    u32x4 w; w.x = cvt_pk_bf16(h0[0], h0[1]); w.y = cvt_pk_bf16(h0[2], h0[3]); w.z = cvt_pk_bf16(h1[0], h1[1]); w.w = cvt_pk_bf16(h1[2], h1[3]);
                    *(u32x4*)(hb + off) = w; hw[ai][bj][m] = w;
                    const f32x4 r0 = (f32x4){bf_lo(w.x), bf_hi(w.x), bf_lo(w.y), bf_hi(w.y)}, r1 = (f32x4){bf_lo(w.z), bf_hi(w.z), bf_lo(w.w), bf_hi(w.w)};
                    ssq[ai][m] += ((r0[0] * r0[0] + r0[1] * r0[1]) + (r0[2] * r0[2] + r0[3] * r0[3])) + ((r1[0] * r1[0] + r1[1] * r1[1]) + (r1[2] * r1[2] + r1[3] * r1[3]));
                    const f32x4 y0 = r0 * g0, y1 = r1 * g1;
                    u32x2 w8; w8.x = cvt_pk4_fp8(y0[0], y0[1], y0[2], y0[3]); w8.y = cvt_pk4_fp8(y1[0], y1[1], y1[2], y1[3]);
                    *(u32x2*)(xn2 + off) = w8; }
        }
        asm volatile("" ::: "memory");
#pragma unroll
        for (int ai = 0; ai < 2; ++ai) {
            f32x4 lacc[4][3];
#pragma unroll
            for (int m = 0; m < 4; ++m)
#pragma unroll
                for (int nt = 0; nt < 3; ++nt) lacc[m][nt] = (f32x4){0.f, 0.f, 0.f, 0.f};
#pragma unroll
            for (int bj = 0; bj < 2; ++bj) {
                bf16x8 bh[3], bl[3];
#pragma unroll
                for (int nt = 0; nt < 3; ++nt) { bh[nt] = *(const bf16x8*)(rwh + (size_t)(16 * nt + fr) * D + col0 + 128 * bj); bl[nt] = *(const bf16x8*)(rwl + (size_t)(16 * nt + fr) * D + col0 + 128 * bj); }
#pragma unroll
                for (int m = 0; m < 4; ++m) { const u32x4 w = hw[ai][bj][m]; const bf16x8 af = __builtin_bit_cast(bf16x8, w);
#pragma unroll
                    for (int nt = 0; nt < 3; ++nt) { lacc[m][nt] = __builtin_amdgcn_mfma_f32_16x16x32_bf16(af, bh[nt], lacc[m][nt], 0, 0, 0); lacc[m][nt] = __builtin_amdgcn_mfma_f32_16x16x32_bf16(af, bl[nt], lacc[m][nt], 0, 0, 0); } }
            }
            float sq[4];
#pragma unroll
            for (int m = 0; m < 4; ++m) { sq[m] = ssq[ai][m]; sq[m] += __shfl_xor(sq[m], 16); sq[m] += __shfl_xor(sq[m], 32); }
#pragma unroll 1
            for (int wcr = 0; wcr < 4; ++wcr) {
                if (wc == wcr) {
#pragma unroll
                    for (int m = 0; m < 4; ++m) {
#pragma unroll
                        for (int nt = 0; nt < 3; ++nt)
#pragma unroll
                            for (int j = 0; j < 4; ++j) { LAS float* q = R + (16 * m + 4 * fq + j) * 52 + 16 * nt + fr; const float v = lacc[m][nt][j]; *q = wcr == 0 ? v : *q + v; }
                        if (fq == 0) { LAS float* q = R + (16 * m + fr) * 52 + 48; *q = wcr == 0 ? sq[m] : *q + sq[m]; } } }
                __syncthreads();
            }
            const int grow0 = u.pm * 256 + ai * 128 + wr * 64;
#pragma unroll
            for (int i = 0; i < 3; ++i) { const int q = i * 64 + lane, r = 16 * wc + q / 12, c4 = q % 12;
                *(f32x4*)(lpart + ((size_t)u.pn * T + grow0 + r) * 48 + 4 * c4) = *(const LAS f32x4*)(R + r * 52 + 4 * c4); }
            if (lane < 16) ssqp[(size_t)u.pn * T + grow0 + 16 * wc + lane] = R[(16 * wc + lane) * 52 + 48];
            __syncthreads();
        }
    }
};
struct EpiMoe1 {
    static constexpr bool PERM = true;
    unsigned char* hid;
    const float* rsp; const unsigned* cnt;
    __device__ __forceinline__ void operator()(const f32x4 (&acc)[2][2][4][2], const pg8::Unit& u, int wr, int wc, int fr, int fq) const {
        const int hc0 = 128 * u.pn + 16 * wc + 4 * fq;
        const int ce = __builtin_amdgcn_readfirstlane((int)cnt[64 * u.ex]);
        float rsv[2][4];
#pragma unroll
        for (int ai = 0; ai < 2; ++ai)
#pragma unroll
            for (int m = 0; m < 4; ++m) { const int p = u.rt * 256 + ai * 128 + wr * 64 + m * 16 + fr; rsv[ai][m] = p < ce ? rsp[u.ex * LCAP + p] : 0.f; }
#pragma unroll
        for (int ai = 0; ai < 2; ++ai)
#pragma unroll
            for (int m = 0; m < 4; ++m) { const int r = ai * 128 + wr * 64 + m * 16 + fr; const float rs = rsv[ai][m];
                unsigned char* rowp = hid + (size_t)(u.pm * 256 + r) * DEXP + hc0;
#pragma unroll
                for (int bj = 0; bj < 2; ++bj) { const f32x4 a = acc[ai][bj][m][0] * rs, b = acc[ai][bj][m][1] * rs; f32x4 o;
#pragma unroll
                    for (int j = 0; j < 4; ++j) { const float sg = __builtin_amdgcn_rcpf(1.0f + __builtin_amdgcn_exp2f(-LOG2E * a[j])); o[j] = a[j] * sg * b[j]; }
                    *(unsigned*)(rowp + bj * 64) = cvt_pk4_fp8(o[0], o[1], o[2], o[3]); } }
    }
};
struct EpiMoe2 {
    static constexpr bool PERM = true;
    unsigned char* yp;
    __device__ __forceinline__ void operator()(const f32x4 (&acc)[2][2][4][2], const pg8::Unit& u, int wr, int wc, int fr, int fq) const {
        const int row0 = u.pm * 256 + wr * 64 + fr, col0 = u.pn * 256 + wc * 32 + 8 * fq;
#pragma unroll
        for (int ai = 0; ai < 2; ++ai)
#pragma unroll
            for (int m = 0; m < 4; ++m) { unsigned char* rowp = yp + (size_t)(row0 + ai * 128 + m * 16) * D + col0;
#pragma unroll
                for (int bj = 0; bj < 2; ++bj) { const f32x4 v0 = acc[ai][bj][m][0] * 16.0f, v1 = acc[ai][bj][m][1] * 16.0f;
                    u32x2 w; w.x = cvt_pk4_fp8(v0[0], v0[1], v0[2], v0[3]); w.y = cvt_pk4_fp8(v1[0], v1[1], v1[2], v1[3]);
                    *(u32x2*)(rowp + bj * 128) = w; } }
    }
};

struct Args {
    const float* x; const float* norm_mix_g; const float* w_in; const float* b_gates; const float* ln_g; const float* ln_b; const float* w_spatial; const float* b_spatial;
    const float* rel_bias; const float* w_out; const float* norm_ffn_g; const float* w_gr; const float* b_gr; const float* w_er; const float* b_er;
    const float* w1; const float* w3; const float* w2; const float* norm_final_g;
    float* out; unsigned char* ws; int ph_lo, ph_hi; int rep_mask, pad;
};
struct Frame { LAS unsigned char* lds; int tid, lane, wave, vcu, G; };
__device__ __forceinline__ Args load_args() {
#if defined(__HIP_DEVICE_COMPILE__)
    const __attribute__((address_space(4))) Args* p = (const __attribute__((address_space(4))) Args*)__builtin_amdgcn_kernarg_segment_ptr(); asm volatile("" : "+s"(p));
    Args r; __builtin_memcpy(&r, (const Args*)p, sizeof(Args)); return r;
#else
    return Args{};
#endif
}

__device__ __forceinline__ unsigned off_b(unsigned row, unsigned ch) { return 256u * row + 16u * (ch ^ (((row & 3) << 2) | ((row >> 2) & 3))); }
__device__ __forceinline__ int crow(int r, int hi) { return (r & 3) + 8 * (r >> 2) + 4 * hi; }
__device__ __forceinline__ s16x4 lds_tr(LAS const unsigned char* p) { typedef short v4i16_t __attribute__((ext_vector_type(4))); return __builtin_bit_cast(s16x4, __builtin_amdgcn_ds_read_tr16_b64_v4i16((LAS v4i16_t*)p)); }

struct TDesc { const float* src; int N, k0, n0; unsigned char* dst; int ldd  ; int rmk  , which; float scale  ; };
__device__ __forceinline__ int tdesc_row(const TDesc& d, int n) {
    if (d.rmk == 0) return n;
    if (d.rmk == 3) return 8 * (n >> 2) + 4 * d.which + (n & 3);
    const int sg = n >> 10, j = n & 1023; const int r = sg == 0 ? 8 * (j >> 2) + (j & 3) : sg == 5 ? 8 * (j >> 2) + 4 + (j & 3) : sg == 6 ? 6144 + j : 1024 + n;
    return d.rmk == 1 ? r : r - 2048;
}
__device__ __forceinline__ void titem_load(const TDesc& d, f32x4 (&v)[8], int lane) {
    const float* p = d.src + (size_t)(d.k0 + (lane >> 4)) * d.N + d.n0 + 4 * (lane & 15);
#pragma unroll
    for (int i = 0; i < 8; ++i) v[i] = __builtin_nontemporal_load((const f32x4*)(p + (size_t)(4 * i) * d.N));
}
__device__ __forceinline__ void titem_store(const TDesc& d, const f32x4 (&v)[8], LAS float* scr  , int lane) {
#pragma unroll
    for (int i = 0; i < 8; ++i) *(LAS f32x4*)(scr + (4 * i + (lane >> 4)) * 68 + 4 * (lane & 15)) = v[i];
    LDS_WAIT(); asm volatile("" ::: "memory");
    if (d.scale != 0.f) {
#pragma unroll
        for (int q = 0; q < 2; ++q) { const int n = (lane >> 1) + 32 * q, kh = lane & 1; const LAS float* sp = scr + (16 * kh) * 68 + n; float f[16];
#pragma unroll
            for (int j = 0; j < 16; ++j) f[j] = sp[j * 68] * d.scale;
            u32x4 o; o.x = cvt_pk4_fp8(f[0], f[1], f[2], f[3]); o.y = cvt_pk4_fp8(f[4], f[5], f[6], f[7]); o.z = cvt_pk4_fp8(f[8], f[9], f[10], f[11]); o.w = cvt_pk4_fp8(f[12], f[13], f[14], f[15]);
            *(u32x4*)(d.dst + (size_t)tdesc_row(d, d.n0 + n) * d.ldd + d.k0 + 16 * kh) = o; }
    } else {
#pragma unroll
        for (int q = 0; q < 4; ++q) { const int n = (lane >> 2) + 16 * q, kq = lane & 3; const LAS float* sp = scr + (8 * kq) * 68 + n; float f[8];
#pragma unroll
            for (int j = 0; j < 8; ++j) f[j] = sp[j * 68];
            u32x4 o; o.x = cvt_pk_bf16(f[0], f[1]); o.y = cvt_pk_bf16(f[2], f[3]); o.z = cvt_pk_bf16(f[4], f[5]); o.w = cvt_pk_bf16(f[6], f[7]);
            *(u32x4*)(d.dst + (size_t)tdesc_row(d, d.n0 + n) * d.ldd + (size_t)(d.k0 + 8 * kq) * 2) = o; }
    }
    LDS_WAIT(); asm volatile("" ::: "memory");
}
template <class Gen>
__device__ __forceinline__ void titems_run(const Gen& gen, int first, int stride, int end, LAS float* scr, int lane) {
    for (int it = first; it < end; it += 4 * stride) {
        const bool h1 = it + stride < end, h2 = it + 2 * stride < end, h3 = it + 3 * stride < end;
        const TDesc d0 = gen(it), d1 = gen(h1 ? it + stride : it), d2 = gen(h2 ? it + 2 * stride : it), d3 = gen(h3 ? it + 3 * stride : it);
        f32x4 v0[8], v1[8], v2[8], v3[8];
        titem_load(d0, v0, lane); if (h1) titem_load(d1, v1, lane); if (h2) titem_load(d2, v2, lane); if (h3) titem_load(d3, v3, lane);
        titem_store(d0, v0, scr, lane); if (h1) titem_store(d1, v1, scr, lane); if (h2) titem_store(d2, v2, scr, lane); if (h3) titem_store(d3, v3, scr, lane);
    }
}
template <class RowMap>
__device__ __forceinline__ void transpose_item_fp8(const float* W, int N, int k0, int n0, unsigned char* dst, int ldd, LAS float* scr, int lane, RowMap rm, float scale) {
#pragma unroll 8
    for (int i = 0; i < 32; ++i) { const int kk = 2 * i + (lane >> 5); scr[kk * 33 + (lane & 31)] = W[(size_t)(k0 + kk) * N + n0 + (lane & 31)]; }
    LDS_WAIT(); asm volatile("" ::: "memory");
    const int c = lane & 7;
#pragma unroll
    for (int j = 0; j < 4; ++j) { const int n = (lane >> 3) + 8 * j; const LAS float* s = scr + (8 * c) * 33 + n;
        u32x2 o; o.x = cvt_pk4_fp8(s[0 * 33] * scale, s[1 * 33] * scale, s[2 * 33] * scale, s[3 * 33] * scale); o.y = cvt_pk4_fp8(s[4 * 33] * scale, s[5 * 33] * scale, s[6 * 33] * scale, s[7 * 33] * scale);
        *(u32x2*)(dst + (size_t)rm(n0 + n) * ldd + k0 + 8 * c) = o; }
    LDS_WAIT(); asm volatile("" ::: "memory");
}
template <class RowMap>
__device__ __forceinline__ void transpose_item(const float* W, int N, int k0, int n0, bf16_t* dst, int ldd, LAS float* scr, int lane, RowMap rm) {
#pragma unroll 8
    for (int i = 0; i < 32; ++i) { const int kk = 2 * i + (lane >> 5); scr[kk * 33 + (lane & 31)] = W[(size_t)(k0 + kk) * N + n0 + (lane & 31)]; }
    LDS_WAIT(); asm volatile("" ::: "memory");
    const int c = lane & 7;
#pragma unroll
    for (int j = 0; j < 4; ++j) { const int n = (lane >> 3) + 8 * j; const LAS float* s = scr + (8 * c) * 33 + n;
        u32x4 o; o.x = cvt_pk_bf16(s[0 * 33], s[1 * 33]); o.y = cvt_pk_bf16(s[2 * 33], s[3 * 33]); o.z = cvt_pk_bf16(s[4 * 33], s[5 * 33]); o.w = cvt_pk_bf16(s[6 * 33], s[7 * 33]);
        *(u32x4*)(dst + (size_t)rm(n0 + n) * ldd + k0 + 8 * c) = o; }
    LDS_WAIT(); asm volatile("" ::: "memory");
}
struct RmId { __device__ __forceinline__ int operator()(int n) const { return n; } };
struct RmWin { __device__ __forceinline__ int operator()(int n) const { const int sg = n >> 10, j = n & 1023;
    return sg == 0 ? 8 * (j >> 2) + (j & 3) : sg == 5 ? 8 * (j >> 2) + 4 + (j & 3) : sg == 6 ? 6144 + j : 1024 + n; } };
struct RmWin8 { __device__ __forceinline__ int operator()(int n) const { return RmWin{}(n) - 2048; } };
struct RmW13 { int which; __device__ __forceinline__ int operator()(int j) const { return 8 * (j >> 2) + 4 * which + (j & 3); } };

__device__ __forceinline__ void p0_prologue(const Frame& F, const Args& a) {
    unsigned char* ws = a.ws;
    LAS float* scr = (LAS float*)(F.lds + F.wave * 16384);
    const int gw = F.vcu * NWAVES + F.wave, NGW = F.G * NWAVES;
    bf16_t* win_t = (bf16_t*)(ws + WS_WIN); bf16_t* wout_t = (bf16_t*)(ws + WS_WOUT);
    constexpr int I_IN = (D / 32) * (NCOL / 64), I_OUT = (D / 32) * (D / 64);
    { const float* w_in = a.w_in; unsigned char* wsb_ = ws;
      auto gen = [=](int it) -> TDesc {
          TDesc d; const int nblk = NCOL / 64, kb = it / nblk, nb = it % nblk; const int sg = (64 * nb) >> 10; const bool bf = (sg == 0 || sg == 5);
          d.src = w_in; d.N = NCOL; d.k0 = 32 * kb; d.n0 = 64 * nb; d.dst = wsb_ + (bf ? WS_WIN : WS_WIN8); d.ldd = bf ? D * 2 : D; d.rmk = bf ? 1 : 2; d.which = 0; d.scale = bf ? 0.f : 32.0f;
          return d; };
      titems_run(gen, gw, NGW, I_IN, scr, F.lane); }
    { const float* w_out = a.w_out; unsigned char* wsb_ = ws;
      auto gen = [=](int it) -> TDesc {
          TDesc d; const int nblk = D / 64, kb = it / nblk, nb = it % nblk;
          d.src = w_out; d.N = D; d.k0 = 32 * kb; d.n0 = 64 * nb; d.dst = wsb_ + WS_WOUT; d.ldd = D * 2; d.rmk = 0; d.which = 0; d.scale = 0.f;
          return d; };
      titems_run(gen, gw, NGW, I_OUT, scr, F.lane); }
    bf16_t* xn = (bf16_t*)a.out;
    f32x4 gv[4];
#pragma unroll
    for (int j = 0; j < 4; ++j) gv[j] = *((const f32x4*)a.norm_mix_g + F.lane + 64 * j);
    for (int m = gw; m < T; m += NGW) {
        const f32x4* xr = (const f32x4*)(a.x + (size_t)m * D) + F.lane;
        f32x4 v[4]; float s = 0.f;
#pragma unroll
        for (int j = 0; j < 4; ++j) { v[j] = __builtin_nontemporal_load(xr + 64 * j); s += (v[j].x * v[j].x + v[j].y * v[j].y) + (v[j].z * v[j].z + v[j].w * v[j].w); }
        const float rs = 1.0f / sqrtf(wave_sum(s) * (1.f / D) + NORM_EPS);
        u32x2* o8 = (u32x2*)(xn + (size_t)m * D) + F.lane;
#pragma unroll
        for (int j = 0; j < 4; ++j) { const f32x4 y = v[j] * rs * gv[j]; u32x2 w; w.x = cvt_pk_bf16(y.x, y.y); w.y = cvt_pk_bf16(y.z, y.w); o8[64 * j] = w;
            ((unsigned*)(ws + WS_XN8 + (size_t)m * D))[F.lane + 64 * j] = cvt_pk4_fp8(y.x, y.y, y.z, y.w); }
    }
    { bf16_t* rwh = (bf16_t*)(ws + WS_RW); bf16_t* rwl = rwh + 48 * D;
      for (int i = (blockIdx.x * NTHREADS + F.tid) * 2; i < 48 * D; i += F.G * NTHREADS * 2) {
          const int c = i >> 10, k = i & 1023; float v0 = 0.f, v1 = 0.f;
          if (c < 32) { v0 = a.norm_ffn_g[k] * a.w_er[((size_t)(c >> 3) * D + k) * 8 + (c & 7)]; v1 = a.norm_ffn_g[k + 1] * a.w_er[((size_t)(c >> 3) * D + k + 1) * 8 + (c & 7)]; }
          else if (c < 36) { v0 = a.norm_ffn_g[k] * a.w_gr[k * 4 + (c - 32)]; v1 = a.norm_ffn_g[k + 1] * a.w_gr[(k + 1) * 4 + (c - 32)]; }
          const unsigned hi = cvt_pk_bf16(v0, v1);
          *(unsigned*)(rwh + i) = hi; *(unsigned*)(rwl + i) = cvt_pk_bf16(v0 - bf_lo(hi), v1 - bf_hi(hi)); } }
    bf16_t* wsb = (bf16_t*)(ws + WS_WSB);
    for (int i = (blockIdx.x * NTHREADS + F.tid) * 2; i < 8 * 128 * 128; i += F.G * NTHREADS * 2) {
        const int s = i & 127, t = (i >> 7) & 127;
        const float v0 = (s <= t) ? a.w_spatial[i] : 0.f, v1 = (s + 1 <= t) ? a.w_spatial[i + 1] : 0.f;
        *(unsigned*)(wsb + i) = cvt_pk_bf16(v0, v1);
    }
}

constexpr int GM_WSL = 98304, GM_STAT = 90112;
__device__ __forceinline__ void gmlp_load_ws(const Frame& F, const Args& a, int g) {
    const bf16_t* wsb = (const bf16_t*)(a.ws + WS_WSB);
    for (int i = F.tid; i < 128 * 16; i += NTHREADS) { const int row = i >> 4, ch = i & 15; *(LAS u32x4*)(F.lds + GM_WSL + off_b(row, ch)) = *(const u32x4*)(wsb + ((size_t)g * 128 + row) * 128 + ch * 8); }
}
__device__ __forceinline__ void gmlp_chunk(const Frame& F, const Args& a, int row0, int g, const bool live) {
    asm volatile("" : "+s"(row0), "+s"(g));
    int tid_ = F.tid; asm volatile("" : "+v"(tid_));
    unsigned char* ws = a.ws;
    bf16_t* Ub = (bf16_t*)(ws + WS_U); const bf16_t* VG = (const bf16_t*)(ws + WS_VG);
    const f32x2* stats = (const f32x2*)(ws + WS_STAT);
    LAS unsigned char* VN = F.lds;
    LAS unsigned char* WSL = F.lds + GM_WSL;
    LAS float* MEAN = (LAS float*)(F.lds + GM_STAT); LAS float* RSTD = MEAN + 128;
    const int lane = tid_ & 63, wid = __builtin_amdgcn_readfirstlane(tid_ >> 6), r32 = lane & 31, hh = lane >> 5;
    const int mych = tid_ & 15;
    const f32x4 lg0 = *(const f32x4*)(a.ln_g + g * 128 + mych * 8), lg1 = *(const f32x4*)(a.ln_g + g * 128 + mych * 8 + 4);
    const f32x4 lb0 = *(const f32x4*)(a.ln_b + g * 128 + mych * 8), lb1 = *(const f32x4*)(a.ln_b + g * 128 + mych * 8 + 4);
    const int tt = wid >> 1, cp = wid & 1;
    const float bsp = a.b_spatial[g * 128 + tt * 32 + r32];
    __syncthreads();
    if (tid_ < 128) { const f32x2* sp = stats + (size_t)(row0 + tid_) * 16; float s1 = 0.f, s2 = 0.f;
#pragma unroll
        for (int j = 0; j < 16; ++j) { const f32x2 v = sp[j]; s1 += v.x; s2 += v.y; }
        const float mean = s1 * (1.f / 1024.f), var = s2 * (1.f / 1024.f) - mean * mean;
        MEAN[tid_] = mean; RSTD[tid_] = 1.0f / sqrtf(fmaxf(var, 0.f) + NORM_EPS); }
    __syncthreads();
#pragma unroll
    for (int it = 0; it < 4; ++it) { const int s = (tid_ >> 4) + 32 * it;
        const u32x4 raw = *(const u32x4*)(VG + (size_t)(row0 + s) * D + g * 128 + mych * 8);
        const float mu = MEAN[s], rs = RSTD[s];
        f32x4 x0 = (f32x4){bf_lo(raw.x), bf_hi(raw.x), bf_lo(raw.y), bf_hi(raw.y)}, x1 = (f32x4){bf_lo(raw.z), bf_hi(raw.z), bf_lo(raw.w), bf_hi(raw.w)};
        x0 = (x0 - mu) * rs * lg0 + lb0; x1 = (x1 - mu) * rs * lg1 + lb1;
        u32x4 w; w.x = cvt_pk_bf16(x0[0], x0[1]); w.y = cvt_pk_bf16(x0[2], x0[3]); w.z = cvt_pk_bf16(x1[0], x1[1]); w.w = cvt_pk_bf16(x1[2], x1[3]);
        *(LAS u32x4*)(VN + off_b(s, mych)) = w; }
    __syncthreads();
    f32x16 c0 = {}, c1 = {};
    const unsigned blk = (lane >> 4) & 1, q = (lane & 15) >> 2, p = lane & 3;
    for (int ks = 0; ks < 2 * (tt + 1); ++ks) {
        const bf16x8 bfrag = *(const LAS bf16x8*)(WSL + off_b(tt * 32 + r32, 2 * ks + hh));
        bf16x8 af[2];
#pragma unroll
        for (int ct = 0; ct < 2; ++ct) { const int cc = 2 * cp + ct;
            const s16x4 lo = lds_tr(VN + off_b(16 * ks + 8 * hh + q, 4 * cc + 2 * blk + (p >> 1)) + 8 * (p & 1));
            const s16x4 hi = lds_tr(VN + off_b(16 * ks + 8 * hh + 4 + q, 4 * cc + 2 * blk + (p >> 1)) + 8 * (p & 1));
            af[ct] = (bf16x8){lo[0], lo[1], lo[2], lo[3], hi[0], hi[1], hi[2], hi[3]}; }
        c0 = __builtin_amdgcn_mfma_f32_32x32x16_bf16(af[0], bfrag, c0, 0, 0, 0);
        c1 = __builtin_amdgcn_mfma_f32_32x32x16_bf16(af[1], bfrag, c1, 0, 0, 0);
    }
    const size_t rowoff = (size_t)(row0 + tt * 32 + r32) * D + g * 128;
#pragma unroll
    for (int ct = 0; ct < 2; ++ct)
#pragma unroll
        for (int gq = 0; gq < 4; ++gq) { const int c = 32 * (2 * cp + ct) + 8 * gq + 4 * hh;
            const u32x2 uu = *(const u32x2*)(Ub + rowoff + c);
            const f32x16& cc_ = ct ? c1 : c0;
            const float m0 = cc_[4 * gq + 0] + bsp, m1 = cc_[4 * gq + 1] + bsp, m2 = cc_[4 * gq + 2] + bsp, m3 = cc_[4 * gq + 3] + bsp;
            u32x2 o; o.x = cvt_pk_bf16(bf_lo(uu.x) * m0, bf_hi(uu.x) * m1); o.y = cvt_pk_bf16(bf_lo(uu.y) * m2, bf_hi(uu.y) * m3);
            if (live) *(u32x2*)(Ub + rowoff + c) = o; }
}

__constant__ unsigned char T5_BUCKET[128] = {0, 1, 2, 3, 4, 5, 6, 7, 8, 9, 10, 11, 12, 13, 14, 15, 16, 16, 16, 17, 17, 18, 18, 18, 19, 19, 19, 20, 20, 20, 20, 21, 21, 21, 21, 22, 22, 22, 22, 22, 23, 23, 23, 23, 23, 23, 24, 24, 24, 24, 24, 24, 25, 25, 25, 25, 25, 25, 25, 26, 26, 26, 26, 26, 26, 26, 26, 27, 27, 27, 27, 27, 27, 27, 27, 27, 27, 28, 28, 28, 28, 28, 28, 28, 28, 28, 28, 29, 29, 29, 29, 29, 29, 29, 29, 29, 29, 29, 29, 30, 30, 30, 30, 30, 30, 30, 30, 30, 30, 30, 30, 30, 30, 31, 31, 31, 31, 31, 31, 31, 31, 31, 31, 31, 31, 31, 31, 31};
constexpr int AT_KV = 0;
constexpr int AT_KMH = 65536, AT_KML = 73728, AT_TB = 81920;
__device__ __forceinline__ void attn_bh_tables(const Frame& F, const Args& a, int b, int h) {
    LAS unsigned char* lds = F.lds; const int tid = F.tid;
    const float* kpart = (const float*)(a.ws + WS_KPART);
    { const int n = tid >> 5, c4 = (tid & 31) * 4;
      const float* kp = kpart + ((size_t)(b * 16 + n) * 2) * D + h * HD + c4;
      const f32x4 s = (*(const f32x4*)kp + *(const f32x4*)(kp + D)) * (1.0f / 256.0f);
      u32x2 hi; hi.x = cvt_pk_bf16(s[0], s[1]); hi.y = cvt_pk_bf16(s[2], s[3]);
      const f32x4 rsd = (f32x4){s[0] - bf_lo(hi.x), s[1] - bf_hi(hi.x), s[2] - bf_lo(hi.y), s[3] - bf_hi(hi.y)};
      u32x2 lo; lo.x = cvt_pk_bf16(rsd[0], rsd[1]); lo.y = cvt_pk_bf16(rsd[2], rsd[3]);
      const unsigned o = off_b(n, c4 >> 3) + (c4 & 7) * 2, oz = off_b(n + 16, c4 >> 3) + (c4 & 7) * 2;
      *(LAS u32x2*)(lds + AT_KMH + o) = hi; *(LAS u32x2*)(lds + AT_KML + o) = lo;
      *(LAS u32x2*)(lds + AT_KMH + oz) = (u32x2){0u, 0u}; *(LAS u32x2*)(lds + AT_KML + oz) = (u32x2){0u, 0u};
#pragma unroll
      for (int i = 0; i < 3; ++i) { const int j = tid + 512 * i; const int d = 512 - j;
          if (j < 768) ((LAS float*)(lds + AT_TB))[j] = d < 0 ? -INFINITY : a.rel_bias[T5_BUCKET[d > 127 ? 127 : d] * NH + h] * LOG2E - 4.0f; else ((LAS float*)(lds + AT_TB))[j] = -INFINITY; } }
}
__device__ __forceinline__ void attn_unit(const Frame& F, const Args& a, int b, int h, int qb, const bool live) {
    unsigned char* ws = a.ws;
    const bf16_t* Qg = (const bf16_t*)(ws + WS_Q); const unsigned char* K8g = ws + WS_K; const unsigned char* VTg = ws + WS_VA;
    bf16_t* Zg = (bf16_t*)(ws + WS_U); const bf16_t* GBg = (const bf16_t*)(ws + WS_GB);
    const float* kpart = (const float*)(ws + WS_KPART);
    LAS unsigned char* lds = F.lds;
    int lane_ = F.lane, wid_ = F.wave; asm volatile("" : "+v"(lane_), "+s"(wid_));
    const int lane = lane_, wid = wid_, tid = wid * 64 + lane, r32 = lane & 31, hh = lane >> 5;
    const size_t tok_b = (size_t)b * SEQ;
    const int NT = 4 * (qb + 1);
#pragma unroll 1
    for (int cch = ((a.rep_mask >> 10) & 1) ? -2 : 0; cch < 2; ++cch) gmlp_chunk(F, a, (int)tok_b + qb * 256 + 128 * (cch & 1), h, live && cch >= 0);
    asm volatile("s_waitcnt vmcnt(0)" ::: "memory"); __builtin_amdgcn_fence(__ATOMIC_ACQ_REL, "workgroup");
    __syncthreads();
    const unsigned char* ksrc = K8g + (tok_b + 8 * wid + (lane >> 3)) * D + h * HD + 16 * ((lane & 7) ^ ((4 * wid + (lane >> 4)) & 7));
    const unsigned char* vsrc = VTg + (size_t)(b * 8 + h) * (64 * 8192) + (16 * wid + (lane >> 2)) * 64 + 16 * ((lane & 3) ^ ((lane >> 4) & 3));
#define AT_ISSUE(t) do { const int _bo = ((t) & 1) * 32768; \
        __builtin_amdgcn_global_load_lds((const unsigned*)(ksrc + (size_t)(t) * 64 * D), (LAS unsigned*)(lds + AT_KV + _bo + wid * 1024), 16, 0, 0); \
        __builtin_amdgcn_global_load_lds((const unsigned*)(vsrc + (size_t)(t) * 8192), (LAS unsigned*)(lds + AT_KV + _bo + 16384 + wid * 1024), 16, 0, 0); } while (0)
    AT_ISSUE(0);
    const int qi = wid * 32 + r32;
    const size_t qtok = tok_b + (size_t)qb * 256 + qi;
    pg8::i32x8_t q8[2];
    const float QS = 8.0f * 0.08838834764831845f * LOG2E;
    unsigned sel = 0u;
    { f32x16 gacc = {};
#pragma unroll
      for (int ks2 = 0; ks2 < 2; ++ks2) { bf16x8 qraw[4];
#pragma unroll
          for (int e = 0; e < 4; ++e) qraw[e] = *(const bf16x8*)(Qg + qtok * D + h * HD + 64 * ks2 + 32 * hh + 8 * e);
#pragma unroll
          for (int e = 0; e < 4; ++e) { const bf16x8 kh = *(const LAS bf16x8*)(lds + AT_KMH + off_b(r32, 8 * ks2 + 4 * hh + e)), kl = *(const LAS bf16x8*)(lds + AT_KML + off_b(r32, 8 * ks2 + 4 * hh + e));
              gacc = __builtin_amdgcn_mfma_f32_32x32x16_bf16(kh, qraw[e], gacc, 0, 0, 0); gacc = __builtin_amdgcn_mfma_f32_32x32x16_bf16(kl, qraw[e], gacc, 0, 0, 0); }
#pragma unroll
          for (int e = 0; e < 4; ++e) { const bf16x8 qq = qraw[e]; const u32x4 qw = __builtin_bit_cast(u32x4, qq);
              q8[ks2][2 * e] = (int)cvt_pk4_fp8(QS * bf_lo(qw.x), QS * bf_hi(qw.x), QS * bf_lo(qw.y), QS * bf_hi(qw.y)); q8[ks2][2 * e + 1] = (int)cvt_pk4_fp8(QS * bf_lo(qw.z), QS * bf_hi(qw.z), QS * bf_lo(qw.w), QS * bf_hi(qw.w)); } }
      float gv[16];
#pragma unroll
      for (int aa = 0; aa < 2; ++aa)
#pragma unroll
          for (int i = 0; i < 4; ++i) { const float own = gacc[4 * aa + i], oth = __shfl_xor(own, 32);
              gv[8 * aa + i] = hh ? oth : own; gv[8 * aa + 4 + i] = hh ? own : oth; }
#pragma unroll
      for (int n = 0; n < 16; ++n) if (n >= qb) gv[n] = -INFINITY;
#pragma unroll
      for (int k = 0; k < 3; ++k) { float best = -INFINITY; int bi = -1;
#pragma unroll
          for (int n = 0; n < 16; ++n) { const bool c = !((sel >> n) & 1u) && gv[n] > best; best = c ? gv[n] : best; bi = c ? n : bi; }
          if (bi >= 0) sel |= 1u << bi; } }
    const LAS float* TB = (const LAS float*)(lds + AT_TB);
    const float b31 = TB[512 - 127];
    const LAS float* tbl = TB + (512 - r32 + 4 * hh);
    f32x16 o[4]; o[0] = f32x16{}; o[1] = f32x16{}; o[2] = f32x16{}; o[3] = f32x16{};
    f32x16 o5 = f32x16{};
    const pg8::i32x8_t ones8 = {0x38383838, 0x38383838, 0x38383838, 0x38383838, 0x38383838, 0x38383838, 0x38383838, 0x38383838};
    pg8::i32x8_t p8 = {0, 0, 0, 0, 0, 0, 0, 0};
    f32x16 cbf = {};
    const unsigned kb0 = 128u * r32 + 16u * ((2u * hh) ^ ((r32 >> 1) & 7u));
    const unsigned vb0 = 64u * r32 + 16u * ((2u * hh) ^ ((r32 >> 2) & 3u));
    const int sc1 = 0x7f7f7f7f, scq = 0x7c7c7c7c;
#define AT_MMA_SEED(S, KF, QF) asm volatile("v_mfma_scale_f32_32x32x64_f8f6f4 %0, %1, %2, %5, %3, %4 op_sel_hi:[0,0,0]" : "=&v"(S) : "v"(KF), "v"(QF), "v"(sc1), "v"(scq), "v"(cbf))
#define AT_MMA_ACC(S, KF, QF) asm volatile("v_mfma_scale_f32_32x32x64_f8f6f4 %0, %1, %2, %0, %3, %4 op_sel_hi:[0,0,0]" : "+v"(S) : "v"(KF), "v"(QF), "v"(sc1), "v"(scq))
#define AT_SOFTMAX(S, HI) { float pr[16]; \
            _Pragma("unroll") for (int r = 0; r < 16; ++r) pr[r] = __builtin_amdgcn_exp2f(S[r]); \
            _Pragma("unroll") for (int w = 0; w < 8; ++w) p8[w] = HI ? __builtin_amdgcn_cvt_pk_fp8_f32(pr[w], pr[8 + w], p8[w], true) : __builtin_amdgcn_cvt_pk_fp8_f32(pr[w], pr[8 + w], p8[w], false); }
#define AT_TILE(FAST) { pg8::i32x8_t kf[4]; \
            _Pragma("unroll") for (int i = 0; i < 4; ++i) { const pg8::i32x4_t lo = *(const LAS pg8::i32x4_t*)(lds + (kb ^ (64u * (i & 1))) + (i >> 1) * 4096), hi = *(const LAS pg8::i32x4_t*)(lds + (kb ^ (64u * (i & 1)) ^ 16u) + (i >> 1) * 4096); \
                kf[i] = (pg8::i32x8_t){lo[0], lo[1], lo[2], lo[3], hi[0], hi[1], hi[2], hi[3]}; } \
            f32x16 s0, s1; \
            if (!(FAST)) { const LAS float* tp = tbl + (bfar == -INFINITY ? 768 : 0) + (kj0 - rel - wid * 32); \
                _Pragma("unroll") for (int r = 0; r < 16; ++r) s0[r] = tp[(r & 3) + 8 * (r >> 2)]; \
                _Pragma("unroll") for (int r = 0; r < 16; ++r) s1[r] = tp[32 + (r & 3) + 8 * (r >> 2)]; } \
            asm volatile("s_waitcnt lgkmcnt(0)\n\ts_nop 1" ::: "memory"); \
            if (FAST) { AT_MMA_SEED(s0, kf[0], q8[0]); } else { AT_MMA_ACC(s0, kf[0], q8[0]); } \
            AT_MMA_ACC(s0, kf[1], q8[1]); \
            if (FAST) { AT_MMA_SEED(s1, kf[2], q8[0]); } else { AT_MMA_ACC(s1, kf[2], q8[0]); } \
              \
            asm volatile("v_mfma_scale_f32_32x32x64_f8f6f4 %0, %2, %3, %0, %4, %5 op_sel_hi:[0,0,0]\n\ts_nop 7" : "+v"(s1), "+v"(s0) : "v"(kf[3]), "v"(q8[1]), "v"(sc1), "v"(scq)); \
              \
            pg8::i32x8_t vf[4]; \
            _Pragma("unroll") for (int dt = 0; dt < 4; ++dt) { const pg8::i32x4_t lo = *(const LAS pg8::i32x4_t*)(lds + vb + 2048 * dt), hi = *(const LAS pg8::i32x4_t*)(lds + (vb ^ 16u) + 2048 * dt); \
                vf[dt] = (pg8::i32x8_t){lo[0], lo[1], lo[2], lo[3], hi[0], hi[1], hi[2], hi[3]}; } \
            __builtin_amdgcn_sched_barrier(0); \
            AT_SOFTMAX(s0, false) \
            __builtin_amdgcn_sched_barrier(0); \
            AT_SOFTMAX(s1, true) \
            __builtin_amdgcn_sched_barrier(0); \
              \
            asm volatile("s_waitcnt lgkmcnt(0)\n\ts_nop 3" ::: "memory"); \
            _Pragma("unroll") for (int dt = 0; dt < 4; ++dt) \
                asm volatile("v_mfma_f32_32x32x64_f8f6f4 %0, %1, %2, %0" : "+v"(o[dt]) : "v"(p8), "v"(vf[dt])); \
            asm volatile("v_mfma_f32_32x32x64_f8f6f4 %0, %1, %2, %0" : "+v"(o5) : "v"(p8), "v"(ones8)); \
            __builtin_amdgcn_sched_barrier(0); }
#define AT_STEP(FAST) { \
        if (t + 1 < NT) { AT_ISSUE(t + 1); asm volatile("s_waitcnt vmcnt(2)" ::: "memory"); } else { asm volatile("s_waitcnt vmcnt(0)" ::: "memory"); } \
        __builtin_amdgcn_s_barrier(); asm volatile("" ::: "memory"); \
        const int n = t >> 2, kj0 = (t & 3) * 64; \
        unsigned kb = kb0 + AT_KV + (t & 1) * 32768, vb = vb0 + AT_KV + (t & 1) * 32768 + 16384; \
        asm volatile("" : "+v"(kb), "+v"(vb));                                    \
        const int rel = (n == qb) ? 0 : 256;                                      \
        const float bfar = (n == qb || ((sel >> n) & 1u)) ? b31 : -INFINITY;      \
        AT_TILE(FAST) \
        asm volatile("s_waitcnt lgkmcnt(0)" ::: "memory"); __builtin_amdgcn_s_barrier(); asm volatile("" ::: "memory"); }
    const int T1 = qb > 0 ? 4 * (qb - 1) : 0;
#pragma unroll 1
    for (int pass = (a.rep_mask >> 11) & 1; pass >= 0; --pass) {
    int t = 0;
#pragma unroll 1
    while (t < T1) {
        { const float bf = ((sel >> (t >> 2)) & 1u) ? b31 : -INFINITY;
#pragma unroll
          for (int r = 0; r < 16; ++r) cbf[r] = bf; }
#pragma unroll 1
        for (int j = 0; j < 4; ++j, ++t) AT_STEP(1)
    }
    asm volatile("s_nop 15\n\ts_nop 7" : "+v"(o[0]), "+v"(o[1]), "+v"(o[2]), "+v"(o[3]), "+v"(o5));
#pragma unroll 1
    for (; t < NT; ++t) AT_STEP(0)
    asm volatile("s_nop 15\n\ts_nop 7" : "+v"(o[0]), "+v"(o[1]), "+v"(o[2]), "+v"(o[3]), "+v"(o5));
    if (pass) { AT_ISSUE(0); }
    }
#undef AT_STEP
#undef AT_TILE
#undef AT_SOFTMAX
#undef AT_MMA_ACC
#undef AT_MMA_SEED
    asm volatile("s_nop 15\n\ts_nop 15" ::: "memory");
    { LAS unsigned char* stg = lds + AT_KV + wid * 8192;
#pragma unroll
      for (int r = 0; r < 16; ++r) { const int qrow = crow(r, hh); const float li = __builtin_amdgcn_rcpf(o5[r]);
#pragma unroll
          for (int dt = 0; dt < 4; ++dt) *(LAS bf16_t*)(stg + qrow * 256 + (32 * dt + r32) * 2) = (bf16_t)(cvt_pk_bf16(o[dt][r] * li, 0.f) & 0xffffu); }
      asm volatile("s_waitcnt lgkmcnt(0)" ::: "memory");
      const size_t rowbase = (tok_b + (size_t)qb * 256 + wid * 32) * D + h * HD;
#pragma unroll
      for (int i = 0; i < 8; ++i) { const int row = 4 * i + (lane >> 4), ch = lane & 15;
          const u32x4 yv = *(const LAS u32x4*)(stg + row * 256 + ch * 16);
          const size_t off = rowbase + (size_t)row * D + ch * 8;
          const u32x4 zv = *(const u32x4*)(Zg + off); const u32x2 g8 = *(const u32x2*)((const unsigned char*)GBg + off);
          u32x4 ov;
          { const f32x2 g0 = __builtin_amdgcn_cvt_pk_f32_fp8((int)g8.x, false), g1 = __builtin_amdgcn_cvt_pk_f32_fp8((int)g8.x, true), g2 = __builtin_amdgcn_cvt_pk_f32_fp8((int)g8.y, false), g3 = __builtin_amdgcn_cvt_pk_f32_fp8((int)g8.y, true);
            ov.x = cvt_pk_bf16(bf_lo(zv.x) + g0[0] * bf_lo(yv.x), bf_hi(zv.x) + g0[1] * bf_hi(yv.x)); ov.y = cvt_pk_bf16(bf_lo(zv.y) + g1[0] * bf_lo(yv.y), bf_hi(zv.y) + g1[1] * bf_hi(yv.y));
            ov.z = cvt_pk_bf16(bf_lo(zv.z) + g2[0] * bf_lo(yv.z), bf_hi(zv.z) + g2[1] * bf_hi(yv.z)); ov.w = cvt_pk_bf16(bf_lo(zv.w) + g3[0] * bf_lo(yv.w), bf_hi(zv.w) + g3[1] * bf_hi(yv.w)); }
          if (live) *(u32x4*)(Zg + off) = ov; }
      asm volatile("s_waitcnt lgkmcnt(0)" ::: "memory"); }
#undef AT_ISSUE
}
__device__ __forceinline__ void p3_attention(const Frame& F, const Args& a, const bool live) {
    for (int v = F.vcu; v < 256; v += F.G) {
        const int bh = v >> 3, s = v & 7;
        __syncthreads(); gmlp_load_ws(F, a, bh & 7); attn_bh_tables(F, a, bh >> 3, bh & 7);
#pragma unroll 1
        for (int uu = 0; uu < 2; ++uu) attn_unit(F, a, bh >> 3, bh & 7, uu ? s : 15 - s, live);
    }
}

constexpr int P5_CTR_OFF = MISC_OFF + 256;
__device__ __forceinline__ void p5_router(const Frame& F, const Args& a, const bool live) {
    unsigned char* ws = a.ws;
    const int lane = F.lane, wid = F.wave;
    const float* lpart = (const float*)(ws + WS_LPART); const float* ssqp = (const float*)(ws + WS_SSQ);
    unsigned* cnt = (unsigned*)(ws + WS_CTL) + CW_CNT; int* list = (int*)(ws + WS_LIST); int* inv = (int*)(ws + WS_INV); float* wtok = (float*)(ws + WS_WTOK); float* rsp = (float*)(ws + WS_RSP);
    LAS unsigned* ctr = (LAS unsigned*)(F.lds + P5_CTR_OFF);
    if (F.tid == 0) *ctr = 0u;
    __syncthreads();
    if (wid < 4) {
        LAS float* scr = (LAS float*)(F.lds + wid * 16384 + 8704);
        for (int tile = F.vcu * 4 + wid; tile < T / 16; tile += F.G * 4) {
        const int row0 = tile * 16, r = lane & 15, kq = lane >> 4;
        const float* lp = lpart + ((size_t)kq * T + row0 + r) * 48;
        f32x4 pv[12];
#pragma unroll
        for (int i = 0; i < 12; ++i) pv[i] = *(const f32x4*)(lp + 4 * i);
        float ssq = ssqp[(size_t)kq * T + row0 + r];
#pragma unroll
        for (int i = 0; i < 12; ++i)
#pragma unroll
            for (int j = 0; j < 4; ++j) { float v = pv[i][j]; v += __shfl_xor(v, 16); v += __shfl_xor(v, 32); pv[i][j] = v; }
        ssq += __shfl_xor(ssq, 16); ssq += __shfl_xor(ssq, 32);
        const float rs = 1.0f / sqrtf(ssq * (1.f / D) + NORM_EPS);
        if (kq == 0) {
#pragma unroll
            for (int i = 0; i < 12; ++i)
#pragma unroll
                for (int j = 0; j < 4; ++j) scr[r * 49 + 4 * i + j] = pv[i][j]; }
        LDS_WAIT(); asm volatile("" ::: "memory");
        if (lane < 16) {
            const LAS float* lr = scr + lane * 49;
            float gl[4];
#pragma unroll
            for (int g = 0; g < 4; ++g) gl[g] = lr[32 + g] * rs + a.b_gr[g];
            int gi = 0; float gm = gl[0];
#pragma unroll
            for (int g = 1; g < 4; ++g) if (gl[g] > gm) { gm = gl[g]; gi = g; }
            float den = 0.f;
#pragma unroll
            for (int g = 0; g < 4; ++g) den += __expf(gl[g] - gm);
            const float g_w = 1.0f / den;
            float el[8];
#pragma unroll
            for (int e = 0; e < 8; ++e) el[e] = lr[gi * 8 + e] * rs + a.b_er[gi * 8 + e];
            int e0 = 0; float v0 = el[0];
#pragma unroll
            for (int e = 1; e < 8; ++e) if (el[e] > v0) { v0 = el[e]; e0 = e; }
            int e1 = -1; float v1 = -INFINITY;
#pragma unroll
            for (int e = 0; e < 8; ++e) if (e != e0 && el[e] > v1) { v1 = el[e]; e1 = e; }
            const float x1 = __expf(v1 - v0), w0f = g_w / (1.0f + x1), w1f = g_w * x1 / (1.0f + x1);
            if (live) { const int m = row0 + lane;
                const int ex0 = gi * 8 + e0, ex1 = gi * 8 + e1;
                const unsigned p0 = __hip_atomic_fetch_add(cnt + 64 * ex0, 1u, __ATOMIC_RELAXED, __HIP_MEMORY_SCOPE_AGENT);
                const unsigned p1 = __hip_atomic_fetch_add(cnt + 64 * ex1, 1u, __ATOMIC_RELAXED, __HIP_MEMORY_SCOPE_AGENT);
                list[ex0 * LCAP + p0] = m * 2; list[ex1 * LCAP + p1] = m * 2 + 1;
                rsp[ex0 * LCAP + p0] = rs; rsp[ex1 * LCAP + p1] = rs;
                *(int2*)(inv + m * 2) = make_int2(ex0 * LCAP + (int)p0, ex1 * LCAP + (int)p1); *(float2*)(wtok + m * 2) = make_float2(w0f, w1f); }
        }
        LDS_WAIT(); asm volatile("" ::: "memory");
        }
    }
    { LAS float* tscr = (LAS float*)(F.lds + wid * 16384);
      const float* w1 = a.w1; const float* w3 = a.w3; const float* w2 = a.w2; unsigned char* w13 = ws + WS_W13; unsigned char* w2t = ws + WS_W2;
      constexpr int I13 = (D / 32) * (DEXP / 64), I2 = (DEXP / 32) * (D / 64), IPE = 2 * I13 + I2;
      auto gen = [=](int it) -> TDesc {
          TDesc d; const int e = it / IPE; int r = it % IPE;
          if (r < 2 * I13) { const int which = r / I13; r %= I13; const int kb = r / (DEXP / 64), nb = r % (DEXP / 64);
              d.src = (which ? w3 : w1) + (size_t)e * D * DEXP; d.N = DEXP; d.k0 = 32 * kb; d.n0 = 64 * nb; d.dst = w13 + (size_t)e * 512 * D; d.ldd = D; d.rmk = 3; d.which = which; d.scale = 32.0f; }
          else { r -= 2 * I13; const int kb = r / (D / 64), nb = r % (D / 64);
              d.src = w2 + (size_t)e * DEXP * D; d.N = D; d.k0 = 32 * kb; d.n0 = 64 * nb; d.dst = w2t + (size_t)e * D * DEXP; d.ldd = DEXP; d.rmk = 0; d.which = 0; d.scale = 16.0f; }
          return d; };
      const int per_wg = (NEXP * IPE + F.G - 1) / F.G;
      const int base = F.vcu * per_wg;
      const int q4 = per_wg / 8;
      const int restw = (per_wg - 4 * q4 + 3) / 4;
      const int lo_ = wid < 4 ? wid * q4 : 4 * q4 + (wid - 4) * restw;
      int hi_ = wid < 4 ? lo_ + q4 : lo_ + restw; if (hi_ > per_wg) hi_ = per_wg;
      int endi = base + hi_; if (endi > NEXP * IPE) endi = NEXP * IPE;
      titems_run(gen, base + lo_, 1, endi, tscr, lane); }
    __syncthreads();
}

__device__ __forceinline__ void p8_final(const Frame& F, const Args& a, const bool live) {
    const int gw = F.vcu * NWAVES + F.wave, NGW = F.G * NWAVES, lane = F.lane;
    const unsigned char* yp = a.ws + WS_YP;
    const LAS int* pref = (const LAS int*)(F.lds + PREF_OFF);
    f32x4 gv[4];
#pragma unroll
    for (int j = 0; j < 4; ++j) gv[j] = *((const f32x4*)a.norm_final_g + lane + 64 * j);
    for (int m = gw; m < T; m += NGW) {
        f32x4* xr = (f32x4*)(a.out + (size_t)m * D) + lane;
        const u32x2* hr = (const u32x2*)((const bf16_t*)(a.ws + WS_HB) + (size_t)m * D) + lane;
        const int2 iv = *(const int2*)((const int*)(a.ws + WS_INV) + m * 2); const float2 wv = *(const float2*)((const float*)(a.ws + WS_WTOK) + m * 2);
        const int pr0 = 256 * pref[iv.x >> 14] + (iv.x & (LCAP - 1)), pr1 = 256 * pref[iv.y >> 14] + (iv.y & (LCAP - 1));
        const unsigned* y0 = (const unsigned*)(yp + (size_t)pr0 * D) + lane; const unsigned* y1 = (const unsigned*)(yp + (size_t)pr1 * D) + lane;
        const float w0 = wv.x * (1.0f / 16.0f), w1 = wv.y * (1.0f / 16.0f);
        f32x4 v[4]; float s = 0.f;
#pragma unroll
        for (int j = 0; j < 4; ++j) { const unsigned p0 = y0[64 * j], p1 = y1[64 * j];
            const f32x2 a0 = __builtin_amdgcn_cvt_pk_f32_fp8((int)p0, false), a1 = __builtin_amdgcn_cvt_pk_f32_fp8((int)p0, true), b0 = __builtin_amdgcn_cvt_pk_f32_fp8((int)p1, false), b1 = __builtin_amdgcn_cvt_pk_f32_fp8((int)p1, true);
            const u32x2 hb = hr[64 * j];
            v[j] = (f32x4){bf_lo(hb.x), bf_hi(hb.x), bf_lo(hb.y), bf_hi(hb.y)} + (f32x4){w0 * a0[0] + w1 * b0[0], w0 * a0[1] + w1 * b0[1], w0 * a1[0] + w1 * b1[0], w0 * a1[1] + w1 * b1[1]};
            s += (v[j].x * v[j].x + v[j].y * v[j].y) + (v[j].z * v[j].z + v[j].w * v[j].w); }
        const float rs = 1.0f / sqrtf(wave_sum(s) * (1.f / D) + NORM_EPS);
#pragma unroll
        for (int j = 0; j < 4; ++j) if (live) xr[64 * j] = v[j] * rs * gv[j];
    }
}

constexpr int N_PHASES = 9;
__global__ void __launch_bounds__(NTHREADS, 2) mk_fwd(Args args) {
    extern __shared__ __attribute__((aligned(16))) unsigned char lds_raw[];
#define MKFRAME() Frame F; { unsigned l_ = __builtin_amdgcn_mbcnt_hi(~0u, __builtin_amdgcn_mbcnt_lo(~0u, 0u)); asm volatile("" : "+v"(l_)); F.lds = (LAS unsigned char*)lds_raw; F.lane = (int)l_; F.wave = wave0; F.tid = wave0 * 64 + F.lane; \
        F.G = gridDim.x; const int bx_ = blockIdx.x; F.vcu = (F.G % 8 == 0) ? (bx_ % 8) * (F.G / 8) + bx_ / 8 : bx_; }
    LAS unsigned char* const lds0 = (LAS unsigned char*)lds_raw;
    const int wave0 = __builtin_amdgcn_readfirstlane((int)(threadIdx.x >> 6));
    unsigned char* ws = args.ws;
    unsigned* ctl = (unsigned*)(ws + WS_CTL);
    if (threadIdx.x < 64) ((LAS unsigned*)(lds0 + MISC_OFF))[threadIdx.x] = 0u;
    __syncthreads();
    const int lo = args.ph_lo, hi = args.ph_hi, repm = args.rep_mask;
    XcdBarrier bar; bar.bar = ctl + CW_BAR; bar.x = 0; bar.st = nullptr;
    bar = xcd_barrier_post(ctl + CW_BAR, (volatile LAS unsigned*)(lds0 + MISC_OFF));
#ifndef PHASE_MASK
#define PHASE_MASK 0x1ff
#endif
#define IN(k) (((PHASE_MASK >> (k)) & 1) && lo <= (k) && (k) < hi)
#define SEAM(k) do { if (IN(k) && IN((k) + 1)) xcd_barrier(bar); } while (0)
#define REP(k) _Pragma("unroll 1") for (int rep_ = ((repm >> (k)) & 1); rep_ >= 0; --rep_)
#define LIVE (rep_ == 0)

    if (IN(0)) { REP(0) { MKFRAME(); const Args a = load_args(); p0_prologue(F, a); } SEAM(0); }
    if (IN(1)) { REP(1) {
        { MKFRAME(); const Args args = load_args();
          pg8::StaticOrder S; S.init((const bf16_t*)args.out, (const bf16_t*)(ws + WS_WIN), T, 2048, D, F.G, (int)blockIdx.x);
          EpiInProj E{(bf16_t*)(ws + WS_U), args.b_gates, (float*)(ws + WS_KPART), (f32x2*)(ws + WS_STAT), 0};
          pg8::gemm_phase<EpiInProj, pg8::StaticOrder, false, D>(F.lds, F.tid, S, E, nullptr); }
        { MKFRAME(); const Args args = load_args();
          pg8::StaticOrder S; S.init((const bf16_t*)(ws + WS_XN8), (const bf16_t*)(ws + WS_WIN8), T, 5120, D / 2, F.G, (int)blockIdx.x);
          EpiInProj E{(bf16_t*)(ws + WS_U), args.b_gates, (float*)(ws + WS_KPART), (f32x2*)(ws + WS_STAT), 8};
          pg8::gemm_phase<EpiInProj, pg8::StaticOrder, false, D / 2, 0x7a>(F.lds, F.tid, S, E, nullptr); } }
        SEAM(1);
    }
    if (IN(3)) { REP(3) { MKFRAME(); const Args a = load_args(); p3_attention(F, a, LIVE); } SEAM(3); }
    if (IN(4)) { REP(4) {
        MKFRAME(); const Args args = load_args();
        pg8::StaticOrder S; S.init((const bf16_t*)(ws + WS_U), (const bf16_t*)(ws + WS_WOUT), T, D, D, F.G, (int)blockIdx.x);
        EpiOutProj E{args.x, (bf16_t*)(ws + WS_HB), args.norm_ffn_g, ws + WS_XN2, (const bf16_t*)(ws + WS_RW), (float*)(ws + WS_LPART), (float*)(ws + WS_SSQ), F.lds + RED_OFF};
        pg8::gemm_phase<EpiOutProj, pg8::StaticOrder, false, D>(F.lds, F.tid, S, E, nullptr); }
        SEAM(4);
    }
    if (IN(5)) { REP(5) { MKFRAME(); const Args a = load_args(); p5_router(F, a, LIVE); } SEAM(5); }
    if (IN(6) || IN(7) || IN(8)) {
        if (threadIdx.x == 0) { LAS int* pref = (LAS int*)(lds0 + PREF_OFF); int acc = 0;
            for (int e = 0; e < NEXP; ++e) { pref[e] = acc; const int c = (int)__hip_atomic_load(ctl + CW_CNT + 64 * e, __ATOMIC_RELAXED, __HIP_MEMORY_SCOPE_AGENT); acc += (c + 255) >> 8; }
            pref[NEXP] = acc; }
        __syncthreads();
    }
    if (IN(6)) { REP(6) {
        typedef pg8::MoeOrder<2, 0, (size_t)512 * D, (size_t)256 * D, D> Ord1;
        typedef pg8::MoeOrder<4, (size_t)256 * DEXP, (size_t)D * DEXP, (size_t)256 * DEXP, 0> Ord2;
        const int G = gridDim.x, total = __builtin_amdgcn_readfirstlane(((const LAS int*)(lds0 + PREF_OFF))[NEXP]);
        const int n1 = 2 * total, r = n1 > G ? n1 - G : 0, early = (n1 > G ? G : n1) / 2;
#pragma unroll 1
        for (int stage = 0; stage < 2; ++stage) {
            MKFRAME();
            Ord1 S; S.pref = (const LAS int*)(F.lds + PREF_OFF); S.c = (int)blockIdx.x; S.A = (const char*)(ws + WS_XN2); S.Bt = (const char*)(ws + WS_W13); S.list = (const int*)(ws + WS_LIST);
            S.first = stage == 0 ? 0 : 2 * early; S.limit = stage == 0 ? 2 * early : n1; S.cbase = 0; S.nwg = stage == 0 ? G : (r > 0 ? r : 1);
            EpiMoe1 E{ws + WS_HID, (const float*)(ws + WS_RSP), ctl + CW_CNT};
            pg8::gemm_phase<EpiMoe1, Ord1, true, D / 2, 0x7a>(F.lds, F.tid, S, E, ctl + CW_CNT);
            if (stage == 0) xcd_barrier(bar);
        }
#pragma unroll 1
        for (int stage = 1; stage < 3; ++stage) {
            MKFRAME();
            Ord2 S; S.pref = (const LAS int*)(F.lds + PREF_OFF); S.c = (int)blockIdx.x; S.A = (const char*)(ws + WS_HID); S.Bt = (const char*)(ws + WS_W2); S.list = (const int*)(ws + WS_LIST);
            S.first = stage == 2 ? 4 * early : 0; S.limit = stage == 1 ? 4 * early : 4 * total; S.cbase = stage == 1 ? r : 0; S.nwg = stage == 1 ? G - r : G;
            EpiMoe2 E{ws + WS_YP};
            pg8::gemm_phase<EpiMoe2, Ord2, false, DEXP / 2, 0x7b>(F.lds, F.tid, S, E, nullptr);
            if (stage == 1) xcd_barrier(bar);
        } }
        SEAM(6);
    }
    if (IN(8)) { REP(8) { MKFRAME(); const Args a = load_args(); p8_final(F, a, LIVE); } }
#undef IN
#undef SEAM
#undef REP
#undef LIVE
}

#ifndef MK_REP_MASK
#define MK_REP_MASK 0x000
#endif
#ifndef MK_SPLIT
#define MK_SPLIT 0
#endif
extern "C" void kernel_launch(void* const* d_in, const int* in_sizes, int n_in, void* d_out, int out_size, void* d_ws, size_t ws_size, hipStream_t stream) {
    static int grid = 0;
    if (grid == 0) {
        if (n_in != 19 || out_size != T * D || ws_size < WS_END) { fprintf(stderr, "kernel_launch: unexpected problem (n_in %d, out %d, ws %zu)\n", n_in, out_size, ws_size); grid = -1; return; }
        int dev = 0, cus = 0, per_cu = 0;
        if (hipGetDevice(&dev) != hipSuccess || hipDeviceGetAttribute(&cus, hipDeviceAttributeMultiprocessorCount, dev) != hipSuccess) { grid = -1; return; }
        if (hipFuncSetAttribute((const void*)mk_fwd, hipFuncAttributeMaxDynamicSharedMemorySize, LDS_BYTES) != hipSuccess) { fprintf(stderr, "kernel_launch: hipFuncSetAttribute failed\n"); grid = -1; return; }
        if (hipOccupancyMaxActiveBlocksPerMultiprocessor(&per_cu, (const void*)mk_fwd, NTHREADS, LDS_BYTES) != hipSuccess || per_cu < 1) fprintf(stderr, "kernel_launch: occupancy query reports %d\n", per_cu);
        (void)hipGetLastError();
        grid = cus;
    }
    if (grid < 0) return;
    if (hipMemsetAsync((char*)d_ws + WS_CTL, 0, CTL_ZERO_BYTES, stream) != hipSuccess) return;
    Args a{};
    a.x = (const float*)d_in[0]; a.norm_mix_g = (const float*)d_in[1]; a.w_in = (const float*)d_in[2]; a.b_gates = (const float*)d_in[3]; a.ln_g = (const float*)d_in[4]; a.ln_b = (const float*)d_in[5];
    a.w_spatial = (const float*)d_in[6]; a.b_spatial = (const float*)d_in[7]; a.rel_bias = (const float*)d_in[8]; a.w_out = (const float*)d_in[9]; a.norm_ffn_g = (const float*)d_in[10];
    a.w_gr = (const float*)d_in[11]; a.b_gr = (const float*)d_in[12]; a.w_er = (const float*)d_in[13]; a.b_er = (const float*)d_in[14]; a.w1 = (const float*)d_in[15]; a.w3 = (const float*)d_in[16]; a.w2 = (const float*)d_in[17];
    a.norm_final_g = (const float*)d_in[18]; a.out = (float*)d_out; a.ws = (unsigned char*)d_ws; a.rep_mask = MK_REP_MASK; a.pad = 0;
#if MK_SPLIT
    for (int p = 0; p < N_PHASES; ++p) { a.ph_lo = p; a.ph_hi = p + 1; hipLaunchKernelGGL(mk_fwd, dim3(grid), dim3(NTHREADS), LDS_BYTES, stream, a); }
#else
    a.ph_lo = 0; a.ph_hi = N_PHASES; hipLaunchKernelGGL(mk_fwd, dim3(grid), dim3(NTHREADS), LDS_BYTES, stream, a);
#endif
}
```

```cpp
#include <hip/hip_runtime.h>
#include <cstdio>
#include <cstdint>

#define LAS __attribute__((address_space(3)))
#define GAS __attribute__((address_space(1)))
typedef unsigned short bf16_t;
typedef short bf16x8 __attribute__((ext_vector_type(8)));
typedef short s16x4 __attribute__((ext_vector_type(4)));
typedef float f32x4 __attribute__((ext_vector_type(4)));
typedef float f32x2 __attribute__((ext_vector_type(2)));
typedef float f32x16 __attribute__((ext_vector_type(16)));
typedef unsigned u32x4 __attribute__((ext_vector_type(4)));
typedef unsigned u32x2 __attribute__((ext_vector_type(2)));

constexpr int T = 16384, D = 1024, NCOL = 7168, SEQ = 4096, NBATCH = 4, NH = 8, HD = 128;
constexpr int NEXP = 32, DEXP = 256, LCAP = 16384;
constexpr float NORM_EPS = 1e-6f;
constexpr float LOG2E = 1.4426950408889634f;
constexpr int NWAVES = 8, NTHREADS = 512;

constexpr size_t MiB = 1u << 20;
constexpr size_t WS_CTL = 0, CTL_ZERO_BYTES = 1 * MiB;
constexpr size_t WS_WIN = 1 * MiB;
constexpr size_t WS_WIN8 = 5 * MiB;
constexpr size_t WS_XN8 = 212 * MiB;
constexpr size_t WS_WOUT = 15 * MiB;
constexpr size_t WS_WSB = 17 * MiB;
constexpr size_t WS_KPART = 17 * MiB + 256 * 1024;
constexpr size_t WS_RW = 17 * MiB + 768 * 1024;
constexpr size_t WS_LPART = 100 * MiB;
constexpr size_t WS_SSQ = 113 * MiB;
constexpr size_t WS_STAT = 18 * MiB;
constexpr size_t WS_U = 20 * MiB;
constexpr size_t SEG_BYTES = 32 * MiB;
constexpr size_t WS_VG = WS_U + SEG_BYTES, WS_Q = WS_U + 2 * SEG_BYTES, WS_K = WS_U + 3 * SEG_BYTES, WS_VA = WS_U + 4 * SEG_BYTES, WS_GB = WS_U + 5 * SEG_BYTES;
constexpr size_t WS_XN2 = 52 * MiB;
constexpr size_t WS_W13 = 84 * MiB;
constexpr size_t WS_W2 = 116 * MiB;
constexpr size_t WS_HID = 132 * MiB;
constexpr size_t WS_YP = 152 * MiB;
constexpr size_t WS_LIST = 232 * MiB;
constexpr size_t WS_INV = 234 * MiB;
constexpr size_t WS_WTOK = 235 * MiB;
constexpr size_t WS_RSP = 236 * MiB;
constexpr size_t WS_HB = 192 * MiB;
constexpr size_t WS_END = 238 * MiB;
constexpr int CW_BAR = 4096;
constexpr int CW_CNT = 8192;

constexpr int RING_BYTES = 131072;
constexpr int MISC_OFF = RING_BYTES;
constexpr int PREF_OFF = MISC_OFF + 64;
constexpr int LDS_BYTES = 163840;
constexpr int RED_OFF = MISC_OFF + 4096, RED_BYTES = 64 * 52 * 4;

typedef __bf16 bf16x2_t __attribute__((ext_vector_type(2)));
__device__ __forceinline__ unsigned cvt_pk_bf16(float lo, float hi) { const f32x2 v = {lo, hi}; const bf16x2_t b = __builtin_convertvector(v, bf16x2_t); return __builtin_bit_cast(unsigned, b); }
__device__ __forceinline__ unsigned cvt_pk4_fp8(float a, float b, float c, float d) { unsigned w = 0u; w = (unsigned)__builtin_amdgcn_cvt_pk_fp8_f32(a, b, (int)w, false); w = (unsigned)__builtin_amdgcn_cvt_pk_fp8_f32(c, d, (int)w, true); return w; }
__device__ __forceinline__ float bf_lo(unsigned w) { return __uint_as_float(w << 16); }
__device__ __forceinline__ float bf_hi(unsigned w) { return __uint_as_float(w & 0xffff0000u); }
__device__ __forceinline__ float wave_sum(float v) {
#pragma unroll
    for (int o = 1; o < 64; o <<= 1) v += __shfl_xor(v, o);
    return v;
}
#define LDS_WAIT() asm volatile("s_waitcnt lgkmcnt(0)" ::: "memory")
#define VM_WAIT() asm volatile("s_waitcnt vmcnt(0)" ::: "memory")

#define XB_TMO      128
#define XB_XCNT(j)  (256  + 64 * (j))
#define XB_XSUB(j)  (1280 + 64 * (j))
#define XB_XGEN(j)  (2304 + 64 * (j))
#define XB_TOP      3328
#define XB_TOPGEN   3392
#define XCD_BAR_WORDS 3456
#define XB_SPIN_CAP (1u << 18)
__device__ __forceinline__ unsigned xb_ld(unsigned* p)              { return __hip_atomic_load(p, __ATOMIC_RELAXED, __HIP_MEMORY_SCOPE_AGENT); }
__device__ __forceinline__ unsigned xb_add(unsigned* p, unsigned v) { return __hip_atomic_fetch_add(p, v, __ATOMIC_RELAXED, __HIP_MEMORY_SCOPE_AGENT); }
__device__ __forceinline__ unsigned xb_xcc_id() { return (unsigned)__builtin_amdgcn_s_getreg((3 << 11) | 20) & 0xFu; }
#define XB_SPIN(cond, bar) do { unsigned _sp = 0; while (cond) { __builtin_amdgcn_s_sleep(1); \
    if ((++_sp & 255u) == 0u) { if (xb_ld(&(bar)[XB_TMO])) break; if (_sp > XB_SPIN_CAP) { atomicAdd(&(bar)[XB_TMO], 1u); break; } } } } while (0)
struct XcdBarrier { unsigned* bar; unsigned x; volatile LAS unsigned* st; };
__device__ __forceinline__ XcdBarrier xcd_barrier_post(unsigned* bar, volatile LAS unsigned* st) {
    XcdBarrier b; b.bar = bar; b.x = xb_xcc_id(); b.st = st;
    if (threadIdx.x == 0) (void)xb_add(&bar[XB_XCNT(b.x)], 1u);
    return b;
}
__device__ __forceinline__ void xcd_barrier_complete(unsigned* bar, unsigned x, unsigned& nloc, unsigned& nx) {
    const unsigned G = gridDim.x * gridDim.y * gridDim.z;
    unsigned sum, cnt, mine, sp = 0u;
    for (;;) {
        sum = 0u; cnt = 0u; mine = 0u;
#pragma unroll
        for (unsigned j = 0; j < 16; ++j) { const unsigned c = xb_ld(&bar[XB_XCNT(j)]); sum += c; cnt += (c > 0u) ? 1u : 0u; mine = (j == x) ? c : mine; }
        if (sum == G) break;
        __builtin_amdgcn_s_sleep(1);
        if ((++sp & 255u) == 0u) { if (xb_ld(&bar[XB_TMO])) break; if (sp > XB_SPIN_CAP) { atomicAdd(&bar[XB_TMO], 1u); break; } }
    }
    nloc = mine > 0u ? mine : 1u; nx = cnt > 0u ? cnt : 1u;
}
__device__ __forceinline__ void xcd_barrier(const XcdBarrier& b) {
    asm volatile("s_waitcnt vmcnt(0)" ::: "memory");
    __syncthreads();
    if (threadIdx.x == 0) {
        unsigned* bar = b.bar;
        __builtin_amdgcn_s_waitcnt(0);
        unsigned nloc = b.st[0], nx = b.st[1];
        if (nloc == 0u) { xcd_barrier_complete(bar, b.x, nloc, nx); b.st[0] = nloc; b.st[1] = nx; }
        const unsigned old = xb_add(&bar[XB_XSUB(b.x)], 1u);
        const unsigned gen = old / nloc;
        if (old + 1u == (gen + 1u) * nloc) {
            __builtin_amdgcn_fence(__ATOMIC_RELEASE, "agent");
            asm volatile("s_waitcnt vmcnt(0)" ::: "memory");
            const unsigned og = xb_add(&bar[XB_TOP], 1u);
            const unsigned tg = og / nx;
            if (og + 1u == (tg + 1u) * nx) xb_add(&bar[XB_TOPGEN], 1u);
            else XB_SPIN(xb_ld(&bar[XB_TOPGEN]) == tg, bar);
            __builtin_amdgcn_fence(__ATOMIC_ACQUIRE, "agent");
            xb_add(&bar[XB_XGEN(b.x)], 1u);
            asm volatile("s_waitcnt vmcnt(0)" ::: "memory");
        } else {
            XB_SPIN(xb_ld(&bar[XB_XGEN(b.x)]) == gen, bar);
            __builtin_amdgcn_fence(__ATOMIC_ACQUIRE, "agent");
            asm volatile("s_waitcnt vmcnt(0)" ::: "memory");
        }
    }
    __syncthreads();
}

namespace pg8 {
constexpr int BM = 256, BK = 64, HALF = 128, HTB = HALF * BK * 2, STAGE_BYTES = 8 * HTB, NXCD = 8, WGM = 8;
__host__ __device__ __forceinline__ int lds_byte(int r, int c) { const int st = (r >> 4) * 2 + (c >> 5), rr = r & 15, cc = c & 31, ob = rr * 64 + cc * 2; return st * 1024 + (ob ^ (((ob >> 9) & 1) << 5)); }
__host__ __device__ __forceinline__ void stage_rc(int b, int& R, int& C) { const int st = b / 1024, sb = b % 1024, swz = sb ^ (((sb >> 9) & 1) << 5); R = (st >> 1) * 16 + swz / 64; C = (st & 1) * 32 + (swz % 64) / 2; }
__host__ __device__ __forceinline__ int perm32(int rho) { const int n = rho >> 4, i = rho & 15; return 8 * (i >> 2) + 4 * n + (i & 3); }

struct Unit { int pm, pn, ex, rt; };

struct StaticOrder {
    int nM, nN, nwg, G, c; const char* A; const char* Bt; size_t tstep;
    __device__ void init(const bf16_t* A_, const bf16_t* Bt_, int M, int N, int K, int G_, int c_) { nM = M / BM; nN = N / BM; nwg = nM * nN; G = G_; c = c_; A = (const char*)A_; Bt = (const char*)Bt_; tstep = (size_t)BM * K * 2; }
    __device__ bool next(int i, Unit& u) const {
        const long L = (long)i * G + c; if (L >= nwg) return false;
        int wgid = (int)L; { const int q = nwg / NXCD, r = nwg % NXCD, xcd = wgid % NXCD, off = wgid / NXCD; wgid = (xcd < r ? xcd * (q + 1) : r * (q + 1) + (xcd - r) * q) + off; }
        const int nig = WGM * nN, gid = wgid / nig, fm = gid * WGM, gsz = (nM - fm) < WGM ? (nM - fm) : WGM;
        u.pm = fm + ((wgid % nig) % gsz); u.pn = (wgid % nig) / gsz; u.ex = 0; u.rt = 0; return true;
    }
    __device__ __forceinline__ const char* abase(const Unit& u) const { return A + (size_t)u.pm * tstep; }
    __device__ __forceinline__ const char* bbase(const Unit& u) const { return Bt + (size_t)u.pn * tstep; }
    __device__ __forceinline__ unsigned arow_off(const Unit&, int) const { return 0u; }
};
template <int npn, size_t a_tstep, size_t b_estep, size_t b_tstep, unsigned rowbytes>
struct MoeOrder {
    const LAS int* pref; int c; const char* A; const char* Bt; const int* list;
    int first, limit, cbase, nwg;
    __device__ bool next(int i, Unit& u) const {
        if (c < cbase || c >= cbase + nwg) return false;
        const long L = (long)first + (long)i * nwg + (c - cbase);
        if (L >= (long)limit) return false;
        const int tl = (int)(L / npn); u.pn = (int)(L % npn); u.pm = tl;
        const int ln = (int)__builtin_amdgcn_mbcnt_hi(~0u, __builtin_amdgcn_mbcnt_lo(~0u, 0u));
        const int mine = pref[ln & 31];
        const unsigned long long m = __ballot(ln >= 1 && ln < NEXP && mine <= tl);
        const int e = __builtin_popcountll(m);
        u.ex = e; u.rt = tl - __builtin_amdgcn_readlane(mine, e); return true;
    }
    __device__ __forceinline__ const char* abase(const Unit& u) const { return A + (size_t)u.pm * a_tstep; }
    __device__ __forceinline__ const char* bbase(const Unit& u) const { return Bt + (size_t)u.ex * b_estep + (size_t)u.pn * b_tstep; }
    __device__ __forceinline__ unsigned arow_off(const Unit& u, int r, int cnt_e) const {
        int p = u.rt * 256 + r; p = p < cnt_e ? p : 0;
        const int ent = list[u.ex * LCAP + p];
        return (unsigned)(ent >> 1) * rowbytes;
    }
};

typedef float f32x2v __attribute__((ext_vector_type(2)));
typedef int i32x4_t __attribute__((ext_vector_type(4)));
typedef int i32x8_t __attribute__((ext_vector_type(8)));
__device__ __forceinline__ f32x2v gelu_pk(f32x2v v) {
    const f32x2v av = __builtin_elementwise_abs(v), d = av * 0.2316418882f + 1.0f;
    f32x2v t; t.x = __builtin_amdgcn_rcpf(d.x); t.y = __builtin_amdgcn_rcpf(d.y);
    f32x2v q = t * 0.5307027145f + (-0.7265760135f); q = q * t + 0.7107068705f; q = q * t + (-0.142248368f); q = q * t + 0.127414796f; q = q * t;
    const f32x2v s = (v * v) * (-0.72134752044f);
    f32x2v e; e.x = __builtin_amdgcn_exp2f(s.x); e.y = __builtin_amdgcn_exp2f(s.y);
    const f32x2v m = v * (q * e), r = v - m;
    f32x2v o; o.x = v.x < 0.f ? m.x : r.x; o.y = v.y < 0.f ? m.y : r.y; return o;
}

template <class Epi, class Sched, bool GATHER, int K, int WSCALE = 0>
__device__ __forceinline__ void gemm_phase(LAS unsigned char* lds, const int tid, const Sched& S, const Epi& E, const unsigned* cnts) {
    const int wid = __builtin_amdgcn_readfirstlane(tid >> 6), lane = tid & 63, wr = wid >> 2, wc = wid & 3, fr = lane & 15, fq = lane >> 4;
    const int nt = K / BK;
    unsigned voffA[2], voffB[2]; int stR[2];
#pragma unroll
    for (int i = 0; i < 2; ++i) { int R, C; stage_rc(tid * 16 + i * 8192, R, C); const int Rb = Epi::PERM ? ((R & ~31) + perm32(R & 31)) : R;
        voffA[i] = GATHER ? (unsigned)(C * 2) : (unsigned)(R * K + C) * 2u; voffB[i] = (unsigned)(Rb * K + C) * 2u; stR[i] = R; }
    const size_t kstep = (size_t)(BK * 2);
    const size_t hstep = (size_t)HALF * K * 2;
    const unsigned ldsw = (unsigned)wid * 1024u;
    const int aoff = lds_byte(wr * 64 + fr, fq * 8), boff = lds_byte(wc * 32 + fr, fq * 8);
#define PG8_SA(b, h) (((b) * 2 + (h)) * HTB)
#define PG8_SB(b, h) ((4 + (b) * 2 + (h)) * HTB)
#define PG8_GLDS(gp, bufoff, i) __builtin_amdgcn_global_load_lds((const unsigned*)(gp), (LAS unsigned*)(lds + (bufoff) + ldsw + (i) * 8192), 16, 0, 0)
#define PG8_STAGE(bufoff, gbase, voff) do { _Pragma("unroll") for (int _i = 0; _i < 2; ++_i) PG8_GLDS((const char*)(gbase) + (voff)[_i], bufoff, _i); } while (0)
#define PG8_STAGE_A(bufoff, H, NX, KO) do { _Pragma("unroll") for (int _i = 0; _i < 2; ++_i) { \
        if constexpr (GATHER) { const unsigned _o = (NX) ? offN[H][_i] : offC[H][_i]; PG8_GLDS(gA + _o + voffA[_i] + (KO), bufoff, _i); } \
        else { PG8_GLDS(((NX) ? nA : cA) + (H) * hstep + voffA[_i] + (KO), bufoff, _i); } } } while (0)
#define PG8_LDA(dst, b, h) do { _Pragma("unroll") for (int m = 0; m < 4; ++m) { dst[m].lo = *(const LAS i32x4_t*)(lds + PG8_SA(b, h) + aoff + m * 2048); dst[m].hi = *(const LAS i32x4_t*)(lds + PG8_SA(b, h) + aoff + m * 2048 + 1024); } } while (0)
#define PG8_LDB(dst, b, h) do { _Pragma("unroll") for (int n = 0; n < 2; ++n) { dst[n].lo = *(const LAS i32x4_t*)(lds + PG8_SB(b, h) + boff + n * 2048); dst[n].hi = *(const LAS i32x4_t*)(lds + PG8_SB(b, h) + boff + n * 2048 + 1024); } } while (0)
#define PG8_MMA(ai, bj, At, Bt) do { __builtin_amdgcn_s_setprio(1); if constexpr (WSCALE != 0) asm volatile("s_nop 3" ::: "memory");     \
        _Pragma("unroll") for (int m = 0; m < 4; ++m) _Pragma("unroll") for (int n = 0; n < 2; ++n) { \
        if constexpr (WSCALE != 0) { asm volatile("v_mfma_scale_f32_16x16x128_f8f6f4 %0, %1, %2, %0, %3, %4 op_sel_hi:[0,0,0]" : "+v"(acc[ai][bj][m][n]) : "v"(Bt[n]), "v"(At[m]), "v"(wscale_v), "v"(ascale_v)); } \
        else { const i32x4_t bl_ = Bt[n].lo, bh_ = Bt[n].hi, al_ = At[m].lo, ah_ = At[m].hi;     \
               acc[ai][bj][m][n] = __builtin_amdgcn_mfma_f32_16x16x32_bf16(__builtin_bit_cast(bf16x8, bl_), __builtin_bit_cast(bf16x8, al_), acc[ai][bj][m][n], 0, 0, 0); \
               acc[ai][bj][m][n] = __builtin_amdgcn_mfma_f32_16x16x32_bf16(__builtin_bit_cast(bf16x8, bh_), __builtin_bit_cast(bf16x8, ah_), acc[ai][bj][m][n], 0, 0, 0); } } \
        __builtin_amdgcn_s_setprio(0); } while (0)
#define PG8_WAIT_V(n) asm volatile("s_waitcnt vmcnt(" #n ")" ::: "memory")
#define PG8_WAIT_L(n) asm volatile("s_waitcnt lgkmcnt(" #n ")" ::: "memory")
#define PG8_BAR __builtin_amdgcn_s_barrier()
#define PG8_SCHED __builtin_amdgcn_sched_barrier(0)
    Unit cur, nxt; int ui = 0;
    if (!S.next(0, cur)) return;
    f32x4 acc[2][2][4][2];
#pragma unroll
    for (int a = 0; a < 2; ++a)
#pragma unroll
        for (int b = 0; b < 2; ++b)
#pragma unroll
            for (int m = 0; m < 4; ++m)
#pragma unroll
                for (int n = 0; n < 2; ++n) acc[a][b][m][n] = (f32x4){0.f, 0.f, 0.f, 0.f};
    i32x8_t At[4], B0[2], B1[2];
    const int wscale_v = WSCALE * 0x01010101, ascale_v = 0x7f7f7f7f;
    const char* gA = S.A;
    const char* cA = S.abase(cur); const char* cB = S.bbase(cur);
    const char* nA = cA;
    unsigned offC[2][2], offN[2][2];
    if constexpr (GATHER) {
        const int ce = __builtin_amdgcn_readfirstlane((int)cnts[64 * cur.ex]);
#pragma unroll
        for (int h = 0; h < 2; ++h)
#pragma unroll
            for (int i = 0; i < 2; ++i) { offC[h][i] = S.arow_off(cur, stR[i] + h * HALF, ce); offN[h][i] = offC[h][i]; }
    } else {
#pragma unroll
        for (int h = 0; h < 2; ++h)
#pragma unroll
            for (int i = 0; i < 2; ++i) { offC[h][i] = 0u; offN[h][i] = 0u; }
    }
    PG8_STAGE(PG8_SB(0, 0), cB, voffB); PG8_STAGE(PG8_SB(0, 1), cB + hstep, voffB); PG8_STAGE_A(PG8_SA(0, 0), 0, false, 0); PG8_STAGE_A(PG8_SA(0, 1), 1, false, 0);
    if (wr == 1) PG8_BAR;
    PG8_WAIT_V(2); PG8_BAR;
    PG8_STAGE(PG8_SB(1, 0), cB + kstep, voffB); PG8_STAGE_A(PG8_SA(1, 0), 0, false, kstep); PG8_STAGE(PG8_SB(1, 1), cB + hstep + kstep, voffB);
    PG8_WAIT_V(6); PG8_BAR;
    for (;;) {
        const bool has_next = S.next(ui + 1, nxt);
        nA = has_next ? S.abase(nxt) : cA; const char* nB = has_next ? S.bbase(nxt) : cB;
        if constexpr (GATHER) {
            if (has_next) { const int ce = __builtin_amdgcn_readfirstlane((int)cnts[64 * nxt.ex]);
#pragma unroll
                for (int h = 0; h < 2; ++h)
#pragma unroll
                    for (int i = 0; i < 2; ++i) offN[h][i] = S.arow_off(nxt, stR[i] + h * HALF, ce);
            } else {
#pragma unroll
                for (int h = 0; h < 2; ++h)
#pragma unroll
                    for (int i = 0; i < 2; ++i) offN[h][i] = offC[h][i];
            }
        }
#pragma unroll 1
        for (int t = 0; t < nt; t += 2) {
            const bool last = (t == nt - 2);
            const size_t k1 = (size_t)(t + 1) * kstep;
            const size_t k2 = last ? 0 : (size_t)(t + 2) * kstep, k3 = k2 + kstep;
            const char* b2 = last ? nB : cB + (size_t)(t + 2) * kstep; const char* b3 = b2 + kstep;
            PG8_LDB(B0, 0, 0); PG8_LDB(B1, 0, 1); PG8_SCHED; PG8_LDA(At, 0, 0); PG8_STAGE_A(PG8_SA(1, 1), 1, false, k1);
            PG8_WAIT_V(8); PG8_WAIT_L(0); PG8_BAR; PG8_MMA(0, 0, At, B0); PG8_MMA(0, 1, At, B1); PG8_BAR; PG8_SCHED;
            PG8_LDA(At, 0, 1); PG8_STAGE(PG8_SB(0, 0), b2, voffB); PG8_STAGE(PG8_SB(0, 1), b2 + hstep, voffB); PG8_STAGE_A(PG8_SA(0, 0), 0, last, k2);
            PG8_WAIT_V(8); PG8_WAIT_L(0); PG8_BAR; PG8_MMA(1, 0, At, B0); PG8_MMA(1, 1, At, B1); PG8_BAR; PG8_SCHED;
            PG8_LDB(B0, 1, 0); PG8_LDB(B1, 1, 1); PG8_SCHED; PG8_LDA(At, 1, 0); PG8_STAGE_A(PG8_SA(0, 1), 1, last, k2);
            PG8_WAIT_V(8); PG8_WAIT_L(0); PG8_BAR; PG8_MMA(0, 0, At, B0); PG8_MMA(0, 1, At, B1); PG8_BAR; PG8_SCHED;
            PG8_LDA(At, 1, 1); PG8_STAGE(PG8_SB(1, 0), b3, voffB); PG8_STAGE(PG8_SB(1, 1), b3 + hstep, voffB); PG8_STAGE_A(PG8_SA(1, 0), 0, last, k3);
            PG8_WAIT_V(8); PG8_WAIT_L(0); PG8_BAR; PG8_MMA(1, 0, At, B0); PG8_MMA(1, 1, At, B1); PG8_BAR; PG8_SCHED;
        }
        if (wr == 0) PG8_BAR;
        if constexpr (WSCALE != 0) asm volatile("s_nop 15\n\ts_nop 7" ::: "memory");
        E(acc, cur, wr, wc, fr, fq);
        if (!has_next) break;
#pragma unroll
        for (int a = 0; a < 2; ++a)
#pragma unroll
            for (int b = 0; b < 2; ++b)
#pragma unroll
                for (int m = 0; m < 4; ++m)
#pragma unroll
                    for (int n = 0; n < 2; ++n) acc[a][b][m][n] = (f32x4){0.f, 0.f, 0.f, 0.f};
        cur = nxt; cA = nA; cB = nB; ++ui;
#pragma unroll
        for (int h = 0; h < 2; ++h)
#pragma unroll
            for (int i = 0; i < 2; ++i) offC[h][i] = offN[h][i];
        if (wr == 1) PG8_BAR;
    }
    PG8_WAIT_V(0);
    PG8_BAR;
#undef PG8_SA
#undef PG8_SB
#undef PG8_GLDS
#undef PG8_STAGE
#undef PG8_STAGE_A
#undef PG8_LDA
#undef PG8_LDB
#undef PG8_MMA
#undef PG8_WAIT_V
#undef PG8_WAIT_L
#undef PG8_BAR
#undef PG8_SCHED
}
}

struct EpiInProj {
    static constexpr bool PERM = true;
    bf16_t* seg0; const float* b_gates; float* kpart; f32x2* stats; int pn_off;
    __device__ __forceinline__ void operator()(const f32x4 (&acc)[2][2][4][2], const pg8::Unit& u_, int wr, int wc, int fr, int fq) const {
        pg8::Unit u = u_; u.pn += pn_off;
        const int row0 = u.pm * 256 + wr * 64 + fr;
        if (u.pn < 8) {
            const int ch0 = 128 * u.pn + 16 * wc + 4 * fq;
            f32x4 bv[2];
#pragma unroll
            for (int bj = 0; bj < 2; ++bj) bv[bj] = *(const f32x4*)(b_gates + ch0 + 64 * bj);
#pragma unroll
            for (int ai = 0; ai < 2; ++ai)
#pragma unroll
                for (int m = 0; m < 4; ++m) { bf16_t* rowp = seg0 + (size_t)(row0 + ai * 128 + m * 16) * D + ch0;
#pragma unroll
                    for (int bj = 0; bj < 2; ++bj) { const f32x4 uu = acc[ai][bj][m][0], gg = acc[ai][bj][m][1] + bv[bj];
                        const pg8::f32x2v a = pg8::gelu_pk((pg8::f32x2v){uu[0], uu[1]}), b = pg8::gelu_pk((pg8::f32x2v){uu[2], uu[3]});
                        float sg[4];
#pragma unroll
                        for (int j = 0; j < 4; ++j) sg[j] = __builtin_amdgcn_rcpf(1.0f + __builtin_amdgcn_exp2f(-LOG2E * gg[j]));
                        u32x2 w; w.x = cvt_pk_bf16(a.x * sg[0], a.y * sg[1]); w.y = cvt_pk_bf16(b.x * sg[2], b.y * sg[3]);
                        *(u32x2*)(rowp + 64 * bj) = w; } }
            return;
        }
        const int seg = (u.pn >> 2) - 1;
        const int colt = (u.pn & 3) * 256, col0 = colt + wc * 32 + 8 * fq;
        bf16_t* base = seg0 + (size_t)seg * (SEG_BYTES / 2);
        if (seg == 1) {
#pragma unroll
            for (int ai = 0; ai < 2; ++ai)
#pragma unroll
                for (int m = 0; m < 4; ++m) { bf16_t* rowp = base + (size_t)(row0 + ai * 128 + m * 16) * D + col0; float s1 = 0.f, s2 = 0.f;
#pragma unroll
                    for (int bj = 0; bj < 2; ++bj) { const f32x4 v0 = acc[ai][bj][m][0], v1 = acc[ai][bj][m][1];
                        const pg8::f32x2v a = pg8::gelu_pk((pg8::f32x2v){v0[0], v0[1]}), b = pg8::gelu_pk((pg8::f32x2v){v0[2], v0[3]}), c = pg8::gelu_pk((pg8::f32x2v){v1[0], v1[1]}), d = pg8::gelu_pk((pg8::f32x2v){v1[2], v1[3]});
                        s1 += ((a.x + a.y) + (b.x + b.y)) + ((c.x + c.y) + (d.x + d.y));
                        s2 += ((a.x * a.x + a.y * a.y) + (b.x * b.x + b.y * b.y)) + ((c.x * c.x + c.y * c.y) + (d.x * d.x + d.y * d.y));
                        u32x4 w; w.x = cvt_pk_bf16(a.x, a.y); w.y = cvt_pk_bf16(b.x, b.y); w.z = cvt_pk_bf16(c.x, c.y); w.w = cvt_pk_bf16(d.x, d.y);
                        *(u32x4*)(rowp + bj * 128) = w; }
                    s1 += __shfl_xor(s1, 16); s1 += __shfl_xor(s1, 32); s2 += __shfl_xor(s2, 16); s2 += __shfl_xor(s2, 32);
                    if (fq == 0) stats[(size_t)(row0 + ai * 128 + m * 16) * 16 + (u.pn & 3) * 4 + wc] = (f32x2){s1, s2}; }
        } else if (seg == 5) {
            const float* bp = b_gates + D + col0;
            f32x4 bv[2][2];
#pragma unroll
            for (int bj = 0; bj < 2; ++bj)
#pragma unroll
                for (int n = 0; n < 2; ++n) bv[bj][n] = *(const f32x4*)(bp + bj * 128 + 4 * n);
#pragma unroll
            for (int ai = 0; ai < 2; ++ai)
#pragma unroll
                for (int m = 0; m < 4; ++m) { bf16_t* rowp = base + (size_t)(row0 + ai * 128 + m * 16) * D + col0;
#pragma unroll
                    for (int bj = 0; bj < 2; ++bj) { f32x4 v0 = acc[ai][bj][m][0] + bv[bj][0], v1 = acc[ai][bj][m][1] + bv[bj][1];
#pragma unroll
                        for (int j = 0; j < 4; ++j) { v0[j] = __builtin_amdgcn_rcpf(1.0f + __builtin_amdgcn_exp2f(-LOG2E * v0[j])); v1[j] = __builtin_amdgcn_rcpf(1.0f + __builtin_amdgcn_exp2f(-LOG2E * v1[j])); }
                        u32x2 w; w.x = cvt_pk4_fp8(v0[0], v0[1], v0[2], v0[3]); w.y = cvt_pk4_fp8(v1[0], v1[1], v1[2], v1[3]);
                        *(u32x2*)((unsigned char*)base + (size_t)(row0 + ai * 128 + m * 16) * D + col0 + bj * 128) = w; } }
        } else if (seg == 4) {
            unsigned char* vt = (unsigned char*)base;
            const int pw = 4 * (8 * ((fr >> 2) & 1) + 4 * (fr >> 3) + (fr & 3));
#pragma unroll
            for (int ai = 0; ai < 2; ++ai)
#pragma unroll
                for (int bj = 0; bj < 2; ++bj) {
                    unsigned char* tb = vt + ((size_t)(((u.pm >> 4) * 8 + 2 * (u.pn & 3) + bj) * 64 + 4 * (u.pm & 15) + 2 * ai + wr) * 128 + 32 * wc + 8 * fq) * 64 + pw;
#pragma unroll
                    for (int n = 0; n < 2; ++n)
#pragma unroll
                        for (int i = 0; i < 4; ++i) *(unsigned*)(tb + (4 * n + i) * 64) = cvt_pk4_fp8(acc[ai][bj][0][n][i], acc[ai][bj][1][n][i], acc[ai][bj][2][n][i], acc[ai][bj][3][n][i]); }
        } else {
            if (seg == 3) {
#pragma unroll
                for (int ai = 0; ai < 2; ++ai)
#pragma unroll
                    for (int m = 0; m < 4; ++m)
#pragma unroll
                        for (int bj = 0; bj < 2; ++bj) { const f32x4 v0 = acc[ai][bj][m][0], v1 = acc[ai][bj][m][1];
                            u32x2 w; w.x = cvt_pk4_fp8(v0[0], v0[1], v0[2], v0[3]); w.y = cvt_pk4_fp8(v1[0], v1[1], v1[2], v1[3]);
                            *(u32x2*)((unsigned char*)base + (size_t)(row0 + ai * 128 + m * 16) * D + col0 + bj * 128) = w; }
            } else {
#pragma unroll
            for (int ai = 0; ai < 2; ++ai)
#pragma unroll
                for (int m = 0; m < 4; ++m) { bf16_t* rowp = base + (size_t)(row0 + ai * 128 + m * 16) * D + col0;
#pragma unroll
                    for (int bj = 0; bj < 2; ++bj) { const f32x4 v0 = acc[ai][bj][m][0], v1 = acc[ai][bj][m][1];
                        u32x4 w; w.x = cvt_pk_bf16(v0[0], v0[1]); w.y = cvt_pk_bf16(v0[2], v0[3]); w.z = cvt_pk_bf16(v1[0], v1[1]); w.w = cvt_pk_bf16(v1[2], v1[3]);
                        *(u32x4*)(rowp + bj * 128) = w; } }
            }
            if (seg == 3) {
#pragma unroll
                for (int bj = 0; bj < 2; ++bj)
#pragma unroll
                    for (int n = 0; n < 2; ++n) { f32x4 s = (f32x4){0.f, 0.f, 0.f, 0.f};
#pragma unroll
                        for (int ai = 0; ai < 2; ++ai)
#pragma unroll
                            for (int m = 0; m < 4; ++m) s += acc[ai][bj][m][n];
#pragma unroll
                        for (int o = 1; o < 16; o <<= 1) { s[0] += __shfl_xor(s[0], o); s[1] += __shfl_xor(s[1], o); s[2] += __shfl_xor(s[2], o); s[3] += __shfl_xor(s[3], o); }
                        if (fr == 0) *(f32x4*)(kpart + ((size_t)u.pm * 2 + wr) * D + col0 + bj * 128 + 4 * n) = s; }
            }
        }
    }
};
struct EpiOutProj {
    static constexpr bool PERM = true;
    const float* x; bf16_t* hb; const float* gffn; unsigned char* xn2; const bf16_t* rwh; float* lpart; float* ssqp; LAS unsigned char* red;
    __device__ __forceinline__ void operator()(const f32x4 (&acc)[2][2][4][2], const pg8::Unit& u, int wr, int wc, int fr, int fq) const {
        asm volatile("" : "+v"(fr), "+v"(fq));
        const int row0 = u.pm * 256 + wr * 64 + fr, col0 = u.pn * 256 + wc * 32 + 8 * fq, lane = fq * 16 + fr;
        const bf16_t* rwl = rwh + 48 * D;
        LAS float* R = (LAS float*)(red + wr * RED_BYTES);
#pragma unroll
        for (int ai = 0; ai < 2; ++ai)
#pragma unroll
            for (int m = 0; m < 4; ++m) { const size_t off = (size_t)(row0 + ai * 128 + m * 16) * D + col0;
#pragma unroll
                for (int bj = 0; bj < 2; ++bj) { const f32x4 h0 = *(const f32x4*)(x + off + bj * 128) + acc[ai][bj][m][0], h1 = *(const f32x4*)(x + off + bj * 128 + 4) + acc[ai][bj][m][1];
                    u32x4 w; w.x = cvt_pk_bf16(h0[0], h0[1]); w.y = cvt_pk_bf16(h0[2], h0[3]); w.z = cvt_pk_bf16(h1[0], h1[1]); w.w = cvt_pk_bf16(h1[2], h1[3]);
                    *(u32x4*)(hb + off + bj * 128) = w; } }
        asm volatile("s_waitcnt vmcnt(0)" ::: "memory");
        bf16x8 bh[2][3], bl[2][3]; f32x4 gv[2][2];
#pragma unroll
        for (int bj = 0; bj < 2; ++bj) { gv[bj][0] = *(const f32x4*)(gffn + col0 + 128 * bj); gv[bj][1] = *(const f32x4*)(gffn + col0 + 128 * bj + 4); }
#pragma unroll
        for (int bj = 0; bj < 2; ++bj)
#pragma unroll
            for (int nt = 0; nt < 3; ++nt) { bh[bj][nt] = *(const bf16x8*)(rwh + (size_t)(16 * nt + fr) * D + col0 + 128 * bj); bl[bj][nt] = *(const bf16x8*)(rwl + (size_t)(16 * nt + fr) * D + col0 + 128 * bj); }
        LAS int* Ri = (LAS int*)R;
#pragma unroll
        for (int i = 0; i < 13; ++i) Ri[(16 * wc) * 52 + i * 64 + lane] = 0;
        __syncthreads();
#pragma unroll
        for (int ai = 0; ai < 2; ++ai) {
            f32x4 lacc[4][3]; float ssq[4];
#pragma unroll
            for (int m = 0; m < 4; ++m) { ssq[m] = 0.f;
#pragma unroll
                for (int nt = 0; nt < 3; ++nt) lacc[m][nt] = (f32x4){0.f, 0.f, 0.f, 0.f}; }
#pragma unroll
            for (int bj = 0; bj < 2; ++bj)
#pragma unroll
                for (int m = 0; m < 4; ++m) { const size_t off = (size_t)(row0 + ai * 128 + m * 16) * D + col0 + bj * 128;
                    const u32x4 w = *(const u32x4*)(hb + off); const bf16x8 af = __builtin_bit_cast(bf16x8, w);
                    const f32x4 r0 = (f32x4){bf_lo(w.x), bf_hi(w.x), bf_lo(w.y), bf_hi(w.y)}, r1 = (f32x4){bf_lo(w.z), bf_hi(w.z), bf_lo(w.w), bf_hi(w.w)};
                    ssq[m] += ((r0[0] * r0[0] + r0[1] * r0[1]) + (r0[2] * r0[2] + r0[3] * r0[3])) + ((r1[0] * r1[0] + r1[1] * r1[1]) + (r1[2] * r1[2] + r1[3] * r1[3]));
                    { const f32x4 y0 = r0 * gv[bj][0], y1 = r1 * gv[bj][1];
                      u32x2 w8; w8.x = cvt_pk4_fp8(y0[0], y0[1], y0[2], y0[3]); w8.y = cvt_pk4_fp8(y1[0], y1[1], y1[2], y1[3]);
                      *(u32x2*)(xn2 + off) = w8; }
#pragma unroll
                    for (int nt = 0; nt < 3; ++nt) { lacc[m][nt] = __builtin_amdgcn_mfma_f32_16x16x32_bf16(af, bh[bj][nt], lacc[m][nt], 0, 0, 0); lacc[m][nt] = __builtin_amdgcn_mfma_f32_16x16x32_bf16(af, bl[bj][nt], lacc[m][nt], 0, 0, 0); } }
#pragma unroll
            for (int m = 0; m < 4; ++m) {
#pragma unroll
                for (int nt = 0; nt < 3; ++nt)
#pragma unroll
                    for (int j = 0; j < 4; ++j) __hip_atomic_fetch_add(Ri + (16 * m + 4 * fq + j) * 52 + 16 * nt + fr, __float2int_rn(lacc[m][nt][j] * 4194304.0f), __ATOMIC_RELAXED, __HIP_MEMORY_SCOPE_WORKGROUP);
                float sq = ssq[m]; sq += __shfl_xor(sq, 16); sq += __shfl_xor(sq, 32);
                if (fq == 0) __hip_atomic_fetch_add(Ri + (16 * m + fr) * 52 + 48, __float2int_rn(sq * 65536.0f), __ATOMIC_RELAXED, __HIP_MEMORY_SCOPE_WORKGROUP); }
            __syncthreads();
            const int grow0 = u.pm * 256 + ai * 128 + wr * 64;
#pragma unroll
            for (int i = 0; i < 3; ++i) { const int q = i * 64 + lane, r = 16 * wc + q / 12, c4 = q % 12;
                const pg8::i32x4_t iv = *(const LAS pg8::i32x4_t*)(Ri + r * 52 + 4 * c4);
                *(f32x4*)(lpart + ((size_t)u.pn * T + grow0 + r) * 48 + 4 * c4) = (f32x4){(float)iv[0], (float)iv[1], (float)iv[2], (float)iv[3]} * (1.0f / 4194304.0f); }
            if (lane < 16) ssqp[(size_t)u.pn * T + grow0 + 16 * wc + lane] = (float)Ri[(16 * wc + lane) * 52 + 48] * (1.0f / 65536.0f);
            if (ai == 0) {
                asm volatile("s_waitcnt lgkmcnt(0)" ::: "memory");
#pragma unroll
                for (int i = 0; i < 13; ++i) Ri[(16 * wc) * 52 + i * 64 + lane] = 0;
                __syncthreads(); }
        }
    }
};
struct EpiMoe1 {
    static constexpr bool PERM = true;
    unsigned char* hid;
    const float* rsp; const unsigned* cnt;
    __device__ __forceinline__ void operator()(const f32x4 (&acc)[2][2][4][2], const pg8::Unit& u, int wr, int wc, int fr, int fq) const {
        const int hc0 = 128 * u.pn + 16 * wc + 4 * fq;
        const int ce = __builtin_amdgcn_readfirstlane((int)cnt[64 * u.ex]);
        float rsv[2][4];
#pragma unroll
        for (int ai = 0; ai < 2; ++ai)
#pragma unroll
            for (int m = 0; m < 4; ++m) { const int p = u.rt * 256 + ai * 128 + wr * 64 + m * 16 + fr; rsv[ai][m] = p < ce ? rsp[u.ex * LCAP + p] : 0.f; }
#pragma unroll
        for (int ai = 0; ai < 2; ++ai)
#pragma unroll
            for (int m = 0; m < 4; ++m) { const int r = ai * 128 + wr * 64 + m * 16 + fr; const float rs = rsv[ai][m];
                unsigned char* rowp = hid + (size_t)(u.pm * 256 + r) * DEXP + hc0;
#pragma unroll
                for (int bj = 0; bj < 2; ++bj) { const f32x4 a = acc[ai][bj][m][0] * rs, b = acc[ai][bj][m][1] * rs; f32x4 o;
#pragma unroll
                    for (int j = 0; j < 4; ++j) { const float sg = __builtin_amdgcn_rcpf(1.0f + __builtin_amdgcn_exp2f(-LOG2E * a[j])); o[j] = a[j] * sg * b[j]; }
                    *(unsigned*)(rowp + bj * 64) = cvt_pk4_fp8(o[0], o[1], o[2], o[3]); } }
    }
};
struct EpiMoe2 {
    static constexpr bool PERM = true;
    unsigned char* yp;
    __device__ __forceinline__ void operator()(const f32x4 (&acc)[2][2][4][2], const pg8::Unit& u, int wr, int wc, int fr, int fq) const {
        const int row0 = u.pm * 256 + wr * 64 + fr, col0 = u.pn * 256 + wc * 32 + 8 * fq;
#pragma unroll
        for (int ai = 0; ai < 2; ++ai)
#pragma unroll
            for (int m = 0; m < 4; ++m) { unsigned char* rowp = yp + (size_t)(row0 + ai * 128 + m * 16) * D + col0;
#pragma unroll
                for (int bj = 0; bj < 2; ++bj) { const f32x4 v0 = acc[ai][bj][m][0] * 16.0f, v1 = acc[ai][bj][m][1] * 16.0f;
                    u32x2 w; w.x = cvt_pk4_fp8(v0[0], v0[1], v0[2], v0[3]); w.y = cvt_pk4_fp8(v1[0], v1[1], v1[2], v1[3]);
                    *(u32x2*)(rowp + bj * 128) = w; } }
    }
};

struct Args {
    const float* x; const float* norm_mix_g; const float* w_in; const float* b_gates; const float* ln_g; const float* ln_b; const float* w_spatial; const float* b_spatial;
    const float* rel_bias; const float* w_out; const float* norm_ffn_g; const float* w_gr; const float* b_gr; const float* w_er; const float* b_er;
    const float* w1; const float* w3; const float* w2; const float* norm_final_g;
    float* out; unsigned char* ws; int ph_lo, ph_hi; int rep_mask, pad;
};
struct Frame { LAS unsigned char* lds; int tid, lane, wave, vcu, G; };
__device__ __forceinline__ Args load_args() {
#if defined(__HIP_DEVICE_COMPILE__)
    const __attribute__((address_space(4))) Args* p = (const __attribute__((address_space(4))) Args*)__builtin_amdgcn_kernarg_segment_ptr(); asm volatile("" : "+s"(p));
    Args r; __builtin_memcpy(&r, (const Args*)p, sizeof(Args)); return r;
#else
    return Args{};
#endif
}

__device__ __forceinline__ unsigned off_b(unsigned row, unsigned ch) { return 256u * row + 16u * (ch ^ (((row & 3) << 2) | ((row >> 2) & 3))); }
__device__ __forceinline__ int crow(int r, int hi) { return (r & 3) + 8 * (r >> 2) + 4 * hi; }
__device__ __forceinline__ s16x4 lds_tr(LAS const unsigned char* p) { typedef short v4i16_t __attribute__((ext_vector_type(4))); return __builtin_bit_cast(s16x4, __builtin_amdgcn_ds_read_tr16_b64_v4i16((LAS v4i16_t*)p)); }

struct TDesc { const float* src; int N, k0, n0; unsigned char* dst; int ldd  ; int rmk  , which; float scale  ; };
__device__ __forceinline__ int tdesc_row(const TDesc& d, int n) {
    if (d.rmk == 0) return n;
    if (d.rmk == 3) return 8 * (n >> 2) + 4 * d.which + (n & 3);
    const int sg = n >> 10, j = n & 1023; const int r = sg == 0 ? 8 * (j >> 2) + (j & 3) : sg == 5 ? 8 * (j >> 2) + 4 + (j & 3) : sg == 6 ? 6144 + j : 1024 + n;
    return d.rmk == 1 ? r : r - 2048;
}
__device__ __forceinline__ void titem_load(const TDesc& d, f32x4 (&v)[8], int lane) {
    const float* p = d.src + (size_t)(d.k0 + (lane >> 4)) * d.N + d.n0 + 4 * (lane & 15);
#pragma unroll
    for (int i = 0; i < 8; ++i) v[i] = __builtin_nontemporal_load((const f32x4*)(p + (size_t)(4 * i) * d.N));
}
__device__ __forceinline__ void titem_store(const TDesc& d, const f32x4 (&v)[8], LAS float* scr  , int lane) {
#pragma unroll
    for (int i = 0; i < 8; ++i) *(LAS f32x4*)(scr + (4 * i + (lane >> 4)) * 68 + 4 * (lane & 15)) = v[i];
    LDS_WAIT(); asm volatile("" ::: "memory");
    if (d.scale != 0.f) {
#pragma unroll
        for (int q = 0; q < 2; ++q) { const int n = (lane >> 1) + 32 * q, kh = lane & 1; const LAS float* sp = scr + (16 * kh) * 68 + n; float f[16];
#pragma unroll
            for (int j = 0; j < 16; ++j) f[j] = sp[j * 68] * d.scale;
            u32x4 o; o.x = cvt_pk4_fp8(f[0], f[1], f[2], f[3]); o.y = cvt_pk4_fp8(f[4], f[5], f[6], f[7]); o.z = cvt_pk4_fp8(f[8], f[9], f[10], f[11]); o.w = cvt_pk4_fp8(f[12], f[13], f[14], f[15]);
            *(u32x4*)(d.dst + (size_t)tdesc_row(d, d.n0 + n) * d.ldd + d.k0 + 16 * kh) = o; }
    } else {
#pragma unroll
        for (int q = 0; q < 4; ++q) { const int n = (lane >> 2) + 16 * q, kq = lane & 3; const LAS float* sp = scr + (8 * kq) * 68 + n; float f[8];
#pragma unroll
            for (int j = 0; j < 8; ++j) f[j] = sp[j * 68];
            u32x4 o; o.x = cvt_pk_bf16(f[0], f[1]); o.y = cvt_pk_bf16(f[2], f[3]); o.z = cvt_pk_bf16(f[4], f[5]); o.w = cvt_pk_bf16(f[6], f[7]);
            *(u32x4*)(d.dst + (size_t)tdesc_row(d, d.n0 + n) * d.ldd + (size_t)(d.k0 + 8 * kq) * 2) = o; }
    }
    LDS_WAIT(); asm volatile("" ::: "memory");
}
template <class Gen>
__device__ __forceinline__ void titems_run(const Gen& gen, int first, int stride, int end, LAS float* scr, int lane) {
    for (int it = first; it < end; it += 4 * stride) {
        const bool h1 = it + stride < end, h2 = it + 2 * stride < end, h3 = it + 3 * stride < end;
        const TDesc d0 = gen(it), d1 = gen(h1 ? it + stride : it), d2 = gen(h2 ? it + 2 * stride : it), d3 = gen(h3 ? it + 3 * stride : it);
        f32x4 v0[8], v1[8], v2[8], v3[8];
        titem_load(d0, v0, lane); if (h1) titem_load(d1, v1, lane); if (h2) titem_load(d2, v2, lane); if (h3) titem_load(d3, v3, lane);
        titem_store(d0, v0, scr, lane); if (h1) titem_store(d1, v1, scr, lane); if (h2) titem_store(d2, v2, scr, lane); if (h3) titem_store(d3, v3, scr, lane);
    }
}
template <class RowMap>
__device__ __forceinline__ void transpose_item_fp8(const float* W, int N, int k0, int n0, unsigned char* dst, int ldd, LAS float* scr, int lane, RowMap rm, float scale) {
#pragma unroll 8
    for (int i = 0; i < 32; ++i) { const int kk = 2 * i + (lane >> 5); scr[kk * 33 + (lane & 31)] = W[(size_t)(k0 + kk) * N + n0 + (lane & 31)]; }
    LDS_WAIT(); asm volatile("" ::: "memory");
    const int c = lane & 7;
#pragma unroll
    for (int j = 0; j < 4; ++j) { const int n = (lane >> 3) + 8 * j; const LAS float* s = scr + (8 * c) * 33 + n;
        u32x2 o; o.x = cvt_pk4_fp8(s[0 * 33] * scale, s[1 * 33] * scale, s[2 * 33] * scale, s[3 * 33] * scale); o.y = cvt_pk4_fp8(s[4 * 33] * scale, s[5 * 33] * scale, s[6 * 33] * scale, s[7 * 33] * scale);
        *(u32x2*)(dst + (size_t)rm(n0 + n) * ldd + k0 + 8 * c) = o; }
    LDS_WAIT(); asm volatile("" ::: "memory");
}
template <class RowMap>
__device__ __forceinline__ void transpose_item(const float* W, int N, int k0, int n0, bf16_t* dst, int ldd, LAS float* scr, int lane, RowMap rm) {
#pragma unroll 8
    for (int i = 0; i < 32; ++i) { const int kk = 2 * i + (lane >> 5); scr[kk * 33 + (lane & 31)] = W[(size_t)(k0 + kk) * N + n0 + (lane & 31)]; }
    LDS_WAIT(); asm volatile("" ::: "memory");
    const int c = lane & 7;
#pragma unroll
    for (int j = 0; j < 4; ++j) { const int n = (lane >> 3) + 8 * j; const LAS float* s = scr + (8 * c) * 33 + n;
        u32x4 o; o.x = cvt_pk_bf16(s[0 * 33], s[1 * 33]); o.y = cvt_pk_bf16(s[2 * 33], s[3 * 33]); o.z = cvt_pk_bf16(s[4 * 33], s[5 * 33]); o.w = cvt_pk_bf16(s[6 * 33], s[7 * 33]);
        *(u32x4*)(dst + (size_t)rm(n0 + n) * ldd + k0 + 8 * c) = o; }
    LDS_WAIT(); asm volatile("" ::: "memory");
}
struct RmId { __device__ __forceinline__ int operator()(int n) const { return n; } };
struct RmWin { __device__ __forceinline__ int operator()(int n) const { const int sg = n >> 10, j = n & 1023;
    return sg == 0 ? 8 * (j >> 2) + (j & 3) : sg == 5 ? 8 * (j >> 2) + 4 + (j & 3) : sg == 6 ? 6144 + j : 1024 + n; } };
struct RmWin8 { __device__ __forceinline__ int operator()(int n) const { return RmWin{}(n) - 2048; } };
struct RmW13 { int which; __device__ __forceinline__ int operator()(int j) const { return 8 * (j >> 2) + 4 * which + (j & 3); } };

__device__ __forceinline__ void p0_prologue(const Frame& F, const Args& a) {
    unsigned char* ws = a.ws;
    LAS float* scr = (LAS float*)(F.lds + F.wave * 16384);
    const int gw = F.vcu * NWAVES + F.wave, NGW = F.G * NWAVES;
    bf16_t* win_t = (bf16_t*)(ws + WS_WIN); bf16_t* wout_t = (bf16_t*)(ws + WS_WOUT);
    constexpr int I_IN = (D / 32) * (NCOL / 64), I_OUT = (D / 32) * (D / 64);
    { const float* w_in = a.w_in; unsigned char* wsb_ = ws;
      auto gen = [=](int it) -> TDesc {
          TDesc d; const int nblk = NCOL / 64, kb = it / nblk, nb = it % nblk; const int sg = (64 * nb) >> 10; const bool bf = (sg == 0 || sg == 5);
          d.src = w_in; d.N = NCOL; d.k0 = 32 * kb; d.n0 = 64 * nb; d.dst = wsb_ + (bf ? WS_WIN : WS_WIN8); d.ldd = bf ? D * 2 : D; d.rmk = bf ? 1 : 2; d.which = 0; d.scale = bf ? 0.f : 32.0f;
          return d; };
      titems_run(gen, gw, NGW, I_IN, scr, F.lane); }
    { const float* w_out = a.w_out; unsigned char* wsb_ = ws;
      auto gen = [=](int it) -> TDesc {
          TDesc d; const int nblk = D / 64, kb = it / nblk, nb = it % nblk;
          d.src = w_out; d.N = D; d.k0 = 32 * kb; d.n0 = 64 * nb; d.dst = wsb_ + WS_WOUT; d.ldd = D * 2; d.rmk = 0; d.which = 0; d.scale = 0.f;
          return d; };
      titems_run(gen, gw, NGW, I_OUT, scr, F.lane); }
    bf16_t* xn = (bf16_t*)a.out;
    f32x4 gv[4];
#pragma unroll
    for (int j = 0; j < 4; ++j) gv[j] = *((const f32x4*)a.norm_mix_g + F.lane + 64 * j);
    for (int m = gw; m < T; m += NGW) {
        const f32x4* xr = (const f32x4*)(a.x + (size_t)m * D) + F.lane;
        f32x4 v[4]; float s = 0.f;
#pragma unroll
        for (int j = 0; j < 4; ++j) { v[j] = __builtin_nontemporal_load(xr + 64 * j); s += (v[j].x * v[j].x + v[j].y * v[j].y) + (v[j].z * v[j].z + v[j].w * v[j].w); }
        const float rs = 1.0f / sqrtf(wave_sum(s) * (1.f / D) + NORM_EPS);
        u32x2* o8 = (u32x2*)(xn + (size_t)m * D) + F.lane;
#pragma unroll
        for (int j = 0; j < 4; ++j) { const f32x4 y = v[j] * rs * gv[j]; u32x2 w; w.x = cvt_pk_bf16(y.x, y.y); w.y = cvt_pk_bf16(y.z, y.w); o8[64 * j] = w;
            ((unsigned*)(ws + WS_XN8 + (size_t)m * D))[F.lane + 64 * j] = cvt_pk4_fp8(y.x, y.y, y.z, y.w); }
    }
    { bf16_t* rwh = (bf16_t*)(ws + WS_RW); bf16_t* rwl = rwh + 48 * D;
      for (int i = (blockIdx.x * NTHREADS + F.tid) * 2; i < 48 * D; i += F.G * NTHREADS * 2) {
          const int c = i >> 10, k = i & 1023; float v0 = 0.f, v1 = 0.f;
          if (c < 32) { v0 = a.norm_ffn_g[k] * a.w_er[((size_t)(c >> 3) * D + k) * 8 + (c & 7)]; v1 = a.norm_ffn_g[k + 1] * a.w_er[((size_t)(c >> 3) * D + k + 1) * 8 + (c & 7)]; }
          else if (c < 36) { v0 = a.norm_ffn_g[k] * a.w_gr[k * 4 + (c - 32)]; v1 = a.norm_ffn_g[k + 1] * a.w_gr[(k + 1) * 4 + (c - 32)]; }
          const unsigned hi = cvt_pk_bf16(v0, v1);
          *(unsigned*)(rwh + i) = hi; *(unsigned*)(rwl + i) = cvt_pk_bf16(v0 - bf_lo(hi), v1 - bf_hi(hi)); } }
    bf16_t* wsb = (bf16_t*)(ws + WS_WSB);
    for (int i = (blockIdx.x * NTHREADS + F.tid) * 2; i < 8 * 128 * 128; i += F.G * NTHREADS * 2) {
        const int s = i & 127, t = (i >> 7) & 127;
        const float v0 = (s <= t) ? a.w_spatial[i] : 0.f, v1 = (s + 1 <= t) ? a.w_spatial[i + 1] : 0.f;
        *(unsigned*)(wsb + i) = cvt_pk_bf16(v0, v1);
    }
}

constexpr int GM_WSL = 98304, GM_STAT = 90112;
__device__ __forceinline__ void gmlp_load_ws(const Frame& F, const Args& a, int g) {
    const bf16_t* wsb = (const bf16_t*)(a.ws + WS_WSB);
    for (int i = F.tid; i < 128 * 16; i += NTHREADS) { const int row = i >> 4, ch = i & 15; *(LAS u32x4*)(F.lds + GM_WSL + off_b(row, ch)) = *(const u32x4*)(wsb + ((size_t)g * 128 + row) * 128 + ch * 8); }
}
__device__ __forceinline__ void gmlp_chunk(const Frame& F, const Args& a, int row0, int g, const bool live) {
    asm volatile("" : "+s"(row0), "+s"(g));
    int tid_ = F.tid; asm volatile("" : "+v"(tid_));
    unsigned char* ws = a.ws;
    bf16_t* Ub = (bf16_t*)(ws + WS_U); const bf16_t* VG = (const bf16_t*)(ws + WS_VG);
    const f32x2* stats = (const f32x2*)(ws + WS_STAT);
    LAS unsigned char* VN = F.lds;
    LAS unsigned char* WSL = F.lds + GM_WSL;
    LAS float* MEAN = (LAS float*)(F.lds + GM_STAT); LAS float* RSTD = MEAN + 128;
    const int lane = tid_ & 63, wid = __builtin_amdgcn_readfirstlane(tid_ >> 6), r32 = lane & 31, hh = lane >> 5;
    const int mych = tid_ & 15;
    const f32x4 lg0 = *(const f32x4*)(a.ln_g + g * 128 + mych * 8), lg1 = *(const f32x4*)(a.ln_g + g * 128 + mych * 8 + 4);
    const f32x4 lb0 = *(const f32x4*)(a.ln_b + g * 128 + mych * 8), lb1 = *(const f32x4*)(a.ln_b + g * 128 + mych * 8 + 4);
    const int tt = wid >> 1, cp = wid & 1;
    const float bsp = a.b_spatial[g * 128 + tt * 32 + r32];
    __syncthreads();
    if (tid_ < 128) { const f32x2* sp = stats + (size_t)(row0 + tid_) * 16; float s1 = 0.f, s2 = 0.f;
#pragma unroll
        for (int j = 0; j < 16; ++j) { const f32x2 v = sp[j]; s1 += v.x; s2 += v.y; }
        const float mean = s1 * (1.f / 1024.f), var = s2 * (1.f / 1024.f) - mean * mean;
        MEAN[tid_] = mean; RSTD[tid_] = 1.0f / sqrtf(fmaxf(var, 0.f) + NORM_EPS); }
    __syncthreads();
#pragma unroll
    for (int it = 0; it < 4; ++it) { const int s = (tid_ >> 4) + 32 * it;
        const u32x4 raw = *(const u32x4*)(VG + (size_t)(row0 + s) * D + g * 128 + mych * 8);
        const float mu = MEAN[s], rs = RSTD[s];
        f32x4 x0 = (f32x4){bf_lo(raw.x), bf_hi(raw.x), bf_lo(raw.y), bf_hi(raw.y)}, x1 = (f32x4){bf_lo(raw.z), bf_hi(raw.z), bf_lo(raw.w), bf_hi(raw.w)};
        x0 = (x0 - mu) * rs * lg0 + lb0; x1 = (x1 - mu) * rs * lg1 + lb1;
        u32x4 w; w.x = cvt_pk_bf16(x0[0], x0[1]); w.y = cvt_pk_bf16(x0[2], x0[3]); w.z = cvt_pk_bf16(x1[0], x1[1]); w.w = cvt_pk_bf16(x1[2], x1[3]);
        *(LAS u32x4*)(VN + off_b(s, mych)) = w; }
    __syncthreads();
    f32x16 c0 = {}, c1 = {};
    const unsigned blk = (lane >> 4) & 1, q = (lane & 15) >> 2, p = lane & 3;
    for (int ks = 0; ks < 2 * (tt + 1); ++ks) {
        const bf16x8 bfrag = *(const LAS bf16x8*)(WSL + off_b(tt * 32 + r32, 2 * ks + hh));
        bf16x8 af[2];
#pragma unroll
        for (int ct = 0; ct < 2; ++ct) { const int cc = 2 * cp + ct;
            const s16x4 lo = lds_tr(VN + off_b(16 * ks + 8 * hh + q, 4 * cc + 2 * blk + (p >> 1)) + 8 * (p & 1));
            const s16x4 hi = lds_tr(VN + off_b(16 * ks + 8 * hh + 4 + q, 4 * cc + 2 * blk + (p >> 1)) + 8 * (p & 1));
            af[ct] = (bf16x8){lo[0], lo[1], lo[2], lo[3], hi[0], hi[1], hi[2], hi[3]}; }
        c0 = __builtin_amdgcn_mfma_f32_32x32x16_bf16(af[0], bfrag, c0, 0, 0, 0);
        c1 = __builtin_amdgcn_mfma_f32_32x32x16_bf16(af[1], bfrag, c1, 0, 0, 0);
    }
    const size_t rowoff = (size_t)(row0 + tt * 32 + r32) * D + g * 128;
#pragma unroll
    for (int ct = 0; ct < 2; ++ct)
#pragma unroll
        for (int gq = 0; gq < 4; ++gq) { const int c = 32 * (2 * cp + ct) + 8 * gq + 4 * hh;
            const u32x2 uu = *(const u32x2*)(Ub + rowoff + c);
            const f32x16& cc_ = ct ? c1 : c0;
            const float m0 = cc_[4 * gq + 0] + bsp, m1 = cc_[4 * gq + 1] + bsp, m2 = cc_[4 * gq + 2] + bsp, m3 = cc_[4 * gq + 3] + bsp;
            u32x2 o; o.x = cvt_pk_bf16(bf_lo(uu.x) * m0, bf_hi(uu.x) * m1); o.y = cvt_pk_bf16(bf_lo(uu.y) * m2, bf_hi(uu.y) * m3);
            if (live) *(u32x2*)(Ub + rowoff + c) = o; }
}

__constant__ unsigned char T5_BUCKET[128] = {0, 1, 2, 3, 4, 5, 6, 7, 8, 9, 10, 11, 12, 13, 14, 15, 16, 16, 16, 17, 17, 18, 18, 18, 19, 19, 19, 20, 20, 20, 20, 21, 21, 21, 21, 22, 22, 22, 22, 22, 23, 23, 23, 23, 23, 23, 24, 24, 24, 24, 24, 24, 25, 25, 25, 25, 25, 25, 25, 26, 26, 26, 26, 26, 26, 26, 26, 27, 27, 27, 27, 27, 27, 27, 27, 27, 27, 28, 28, 28, 28, 28, 28, 28, 28, 28, 28, 29, 29, 29, 29, 29, 29, 29, 29, 29, 29, 29, 29, 30, 30, 30, 30, 30, 30, 30, 30, 30, 30, 30, 30, 30, 30, 31, 31, 31, 31, 31, 31, 31, 31, 31, 31, 31, 31, 31, 31, 31};
constexpr int AT_KV = 0;
constexpr int AT_KMH = 65536, AT_KML = 73728, AT_TB = 81920;
__device__ __forceinline__ void attn_bh_tables(const Frame& F, const Args& a, int b, int h) {
    LAS unsigned char* lds = F.lds; const int tid = F.tid;
    const float* kpart = (const float*)(a.ws + WS_KPART);
    { const int n = tid >> 5, c4 = (tid & 31) * 4;
      const float* kp = kpart + ((size_t)(b * 16 + n) * 2) * D + h * HD + c4;
      const f32x4 s = (*(const f32x4*)kp + *(const f32x4*)(kp + D)) * (1.0f / 256.0f);
      u32x2 hi; hi.x = cvt_pk_bf16(s[0], s[1]); hi.y = cvt_pk_bf16(s[2], s[3]);
      const f32x4 rsd = (f32x4){s[0] - bf_lo(hi.x), s[1] - bf_hi(hi.x), s[2] - bf_lo(hi.y), s[3] - bf_hi(hi.y)};
      u32x2 lo; lo.x = cvt_pk_bf16(rsd[0], rsd[1]); lo.y = cvt_pk_bf16(rsd[2], rsd[3]);
      const unsigned o = off_b(n, c4 >> 3) + (c4 & 7) * 2, oz = off_b(n + 16, c4 >> 3) + (c4 & 7) * 2;
      *(LAS u32x2*)(lds + AT_KMH + o) = hi; *(LAS u32x2*)(lds + AT_KML + o) = lo;
      *(LAS u32x2*)(lds + AT_KMH + oz) = (u32x2){0u, 0u}; *(LAS u32x2*)(lds + AT_KML + oz) = (u32x2){0u, 0u};
#pragma unroll
      for (int i = 0; i < 3; ++i) { const int j = tid + 512 * i; const int d = 512 - j;
          if (j < 768) ((LAS float*)(lds + AT_TB))[j] = d < 0 ? -INFINITY : a.rel_bias[T5_BUCKET[d > 127 ? 127 : d] * NH + h] * LOG2E - 4.0f; else ((LAS float*)(lds + AT_TB))[j] = -INFINITY; } }
}
__device__ __forceinline__ void attn_unit(const Frame& F, const Args& a, int b, int h, int qb, const bool live) {
    unsigned char* ws = a.ws;
    const bf16_t* Qg = (const bf16_t*)(ws + WS_Q); const unsigned char* K8g = ws + WS_K; const unsigned char* VTg = ws + WS_VA;
    bf16_t* Zg = (bf16_t*)(ws + WS_U); const bf16_t* GBg = (const bf16_t*)(ws + WS_GB);
    const float* kpart = (const float*)(ws + WS_KPART);
    LAS unsigned char* lds = F.lds;
    int lane_ = F.lane, wid_ = F.wave; asm volatile("" : "+v"(lane_), "+s"(wid_));
    const int lane = lane_, wid = wid_, tid = wid * 64 + lane, r32 = lane & 31, hh = lane >> 5;
    const size_t tok_b = (size_t)b * SEQ;
    const int NT = 4 * (qb + 1);
#pragma unroll 1
    for (int cch = ((a.rep_mask >> 10) & 1) ? -2 : 0; cch < 2; ++cch) gmlp_chunk(F, a, (int)tok_b + qb * 256 + 128 * (cch & 1), h, live && cch >= 0);
    asm volatile("s_waitcnt vmcnt(0)" ::: "memory"); __builtin_amdgcn_fence(__ATOMIC_ACQ_REL, "workgroup");
    __syncthreads();
    const unsigned char* ksrc = K8g + (tok_b + 8 * wid + (lane >> 3)) * D + h * HD + 16 * ((lane & 7) ^ ((4 * wid + (lane >> 4)) & 7));
    const unsigned char* vsrc = VTg + (size_t)(b * 8 + h) * (64 * 8192) + (16 * wid + (lane >> 2)) * 64 + 16 * ((lane & 3) ^ ((lane >> 4) & 3));
#define AT_ISSUE(t) do { const int _bo = ((t) & 1) * 32768; \
        __builtin_amdgcn_global_load_lds((const unsigned*)(ksrc + (size_t)(t) * 64 * D), (LAS unsigned*)(lds + AT_KV + _bo + wid * 1024), 16, 0, 0); \
        __builtin_amdgcn_global_load_lds((const unsigned*)(vsrc + (size_t)(t) * 8192), (LAS unsigned*)(lds + AT_KV + _bo + 16384 + wid * 1024), 16, 0, 0); } while (0)
    AT_ISSUE(0);
    const int qi = wid * 32 + r32;
    const size_t qtok = tok_b + (size_t)qb * 256 + qi;
    pg8::i32x8_t q8[2];
    const float QS = 8.0f * 0.08838834764831845f * LOG2E;
    unsigned sel = 0u;
    { f32x16 gacc = {};
#pragma unroll
      for (int ks2 = 0; ks2 < 2; ++ks2) { bf16x8 qraw[4];
#pragma unroll
          for (int e = 0; e < 4; ++e) qraw[e] = *(const bf16x8*)(Qg + qtok * D + h * HD + 64 * ks2 + 32 * hh + 8 * e);
#pragma unroll
          for (int e = 0; e < 4; ++e) { const bf16x8 kh = *(const LAS bf16x8*)(lds + AT_KMH + off_b(r32, 8 * ks2 + 4 * hh + e)), kl = *(const LAS bf16x8*)(lds + AT_KML + off_b(r32, 8 * ks2 + 4 * hh + e));
              gacc = __builtin_amdgcn_mfma_f32_32x32x16_bf16(kh, qraw[e], gacc, 0, 0, 0); gacc = __builtin_amdgcn_mfma_f32_32x32x16_bf16(kl, qraw[e], gacc, 0, 0, 0); }
#pragma unroll
          for (int e = 0; e < 4; ++e) { const bf16x8 qq = qraw[e]; const u32x4 qw = __builtin_bit_cast(u32x4, qq);
              q8[ks2][2 * e] = (int)cvt_pk4_fp8(QS * bf_lo(qw.x), QS * bf_hi(qw.x), QS * bf_lo(qw.y), QS * bf_hi(qw.y)); q8[ks2][2 * e + 1] = (int)cvt_pk4_fp8(QS * bf_lo(qw.z), QS * bf_hi(qw.z), QS * bf_lo(qw.w), QS * bf_hi(qw.w)); } }
      float gv[16];
#pragma unroll
      for (int aa = 0; aa < 2; ++aa)
#pragma unroll
          for (int i = 0; i < 4; ++i) { const float own = gacc[4 * aa + i], oth = __shfl_xor(own, 32);
              gv[8 * aa + i] = hh ? oth : own; gv[8 * aa + 4 + i] = hh ? own : oth; }
#pragma unroll
      for (int n = 0; n < 16; ++n) if (n >= qb) gv[n] = -INFINITY;
#pragma unroll
      for (int k = 0; k < 3; ++k) { float best = -INFINITY; int bi = -1;
#pragma unroll
          for (int n = 0; n < 16; ++n) { const bool c = !((sel >> n) & 1u) && gv[n] > best; best = c ? gv[n] : best; bi = c ? n : bi; }
          if (bi >= 0) sel |= 1u << bi; } }
    const LAS float* TB = (const LAS float*)(lds + AT_TB);
    const float b31 = TB[512 - 127];
    const LAS float* tbl = TB + (512 - r32 + 4 * hh);
    f32x16 o[4]; o[0] = f32x16{}; o[1] = f32x16{}; o[2] = f32x16{}; o[3] = f32x16{};
    f32x16 o5 = f32x16{};
    const pg8::i32x8_t ones8 = {0x38383838, 0x38383838, 0x38383838, 0x38383838, 0x38383838, 0x38383838, 0x38383838, 0x38383838};
    pg8::i32x8_t p8 = {0, 0, 0, 0, 0, 0, 0, 0};
    f32x16 cbf = {};
    const unsigned kb0 = 128u * r32 + 16u * ((2u * hh) ^ ((r32 >> 1) & 7u));
    const unsigned vb0 = 64u * r32 + 16u * ((2u * hh) ^ ((r32 >> 2) & 3u));
    const int sc1 = 0x7f7f7f7f, scq = 0x7c7c7c7c;
#define AT_MMA_SEED(S, KF, QF) asm volatile("v_mfma_scale_f32_32x32x64_f8f6f4 %0, %1, %2, %5, %3, %4 op_sel_hi:[0,0,0]" : "=&v"(S) : "v"(KF), "v"(QF), "v"(sc1), "v"(scq), "v"(cbf))
#define AT_MMA_ACC(S, KF, QF) asm volatile("v_mfma_scale_f32_32x32x64_f8f6f4 %0, %1, %2, %0, %3, %4 op_sel_hi:[0,0,0]" : "+v"(S) : "v"(KF), "v"(QF), "v"(sc1), "v"(scq))
#define AT_SOFTMAX(S, HI) { float pr[16]; \
            _Pragma("unroll") for (int r = 0; r < 16; ++r) pr[r] = __builtin_amdgcn_exp2f(S[r]); \
            _Pragma("unroll") for (int w = 0; w < 8; ++w) p8[w] = HI ? __builtin_amdgcn_cvt_pk_fp8_f32(pr[w], pr[8 + w], p8[w], true) : __builtin_amdgcn_cvt_pk_fp8_f32(pr[w], pr[8 + w], p8[w], false); }
#define AT_TILE(FAST) { pg8::i32x8_t kf[4]; \
            _Pragma("unroll") for (int i = 0; i < 4; ++i) { const pg8::i32x4_t lo = *(const LAS pg8::i32x4_t*)(lds + (kb ^ (64u * (i & 1))) + (i >> 1) * 4096), hi = *(const LAS pg8::i32x4_t*)(lds + (kb ^ (64u * (i & 1)) ^ 16u) + (i >> 1) * 4096); \
                kf[i] = (pg8::i32x8_t){lo[0], lo[1], lo[2], lo[3], hi[0], hi[1], hi[2], hi[3]}; } \
            f32x16 s0, s1; \
            if (!(FAST)) { const LAS float* tp = tbl + (bfar == -INFINITY ? 768 : 0) + (kj0 - rel - wid * 32); \
                _Pragma("unroll") for (int r = 0; r < 16; ++r) s0[r] = tp[(r & 3) + 8 * (r >> 2)]; \
                _Pragma("unroll") for (int r = 0; r < 16; ++r) s1[r] = tp[32 + (r & 3) + 8 * (r >> 2)]; } \
            asm volatile("s_waitcnt lgkmcnt(0)\n\ts_nop 1" ::: "memory"); \
            if (FAST) { AT_MMA_SEED(s0, kf[0], q8[0]); } else { AT_MMA_ACC(s0, kf[0], q8[0]); } \
            AT_MMA_ACC(s0, kf[1], q8[1]); \
            if (FAST) { AT_MMA_SEED(s1, kf[2], q8[0]); } else { AT_MMA_ACC(s1, kf[2], q8[0]); } \
              \
            asm volatile("v_mfma_scale_f32_32x32x64_f8f6f4 %0, %2, %3, %0, %4, %5 op_sel_hi:[0,0,0]\n\ts_nop 7" : "+v"(s1), "+v"(s0) : "v"(kf[3]), "v"(q8[1]), "v"(sc1), "v"(scq)); \
              \
            pg8::i32x8_t vf[4]; \
            _Pragma("unroll") for (int dt = 0; dt < 4; ++dt) { const pg8::i32x4_t lo = *(const LAS pg8::i32x4_t*)(lds + vb + 2048 * dt), hi = *(const LAS pg8::i32x4_t*)(lds + (vb ^ 16u) + 2048 * dt); \
                vf[dt] = (pg8::i32x8_t){lo[0], lo[1], lo[2], lo[3], hi[0], hi[1], hi[2], hi[3]}; } \
            __builtin_amdgcn_sched_barrier(0); \
            AT_SOFTMAX(s0, false) \
            __builtin_amdgcn_sched_barrier(0); \
            AT_SOFTMAX(s1, true) \
            __builtin_amdgcn_sched_barrier(0); \
              \
            asm volatile("s_waitcnt lgkmcnt(0)\n\ts_nop 3" ::: "memory"); \
            _Pragma("unroll") for (int dt = 0; dt < 4; ++dt) \
                asm volatile("v_mfma_f32_32x32x64_f8f6f4 %0, %1, %2, %0" : "+v"(o[dt]) : "v"(p8), "v"(vf[dt])); \
            asm volatile("v_mfma_f32_32x32x64_f8f6f4 %0, %1, %2, %0" : "+v"(o5) : "v"(p8), "v"(ones8)); \
            __builtin_amdgcn_sched_barrier(0); }
#define AT_STEP(FAST) { \
        if (t + 1 < NT) { AT_ISSUE(t + 1); asm volatile("s_waitcnt vmcnt(2)" ::: "memory"); } else { asm volatile("s_waitcnt vmcnt(0)" ::: "memory"); } \
        __builtin_amdgcn_s_barrier(); asm volatile("" ::: "memory"); \
        const int n = t >> 2, kj0 = (t & 3) * 64; \
        unsigned kb = kb0 + AT_KV + (t & 1) * 32768, vb = vb0 + AT_KV + (t & 1) * 32768 + 16384; \
        asm volatile("" : "+v"(kb), "+v"(vb));                                    \
        const int rel = (n == qb) ? 0 : 256;                                      \
        const float bfar = (n == qb || ((sel >> n) & 1u)) ? b31 : -INFINITY;      \
        AT_TILE(FAST) \
        asm volatile("s_waitcnt lgkmcnt(0)" ::: "memory"); __builtin_amdgcn_s_barrier(); asm volatile("" ::: "memory"); }
    const int T1 = qb > 0 ? 4 * (qb - 1) : 0;
#pragma unroll 1
    for (int pass = (a.rep_mask >> 11) & 1; pass >= 0; --pass) {
    int t = 0;
#pragma unroll 1
    while (t < T1) {
        { const float bf = ((sel >> (t >> 2)) & 1u) ? b31 : -INFINITY;
#pragma unroll
          for (int r = 0; r < 16; ++r) cbf[r] = bf; }
#pragma unroll 1
        for (int j = 0; j < 4; ++j, ++t) AT_STEP(1)
    }
    asm volatile("s_nop 15\n\ts_nop 7" : "+v"(o[0]), "+v"(o[1]), "+v"(o[2]), "+v"(o[3]), "+v"(o5));
#pragma unroll 1
    for (; t < NT; ++t) AT_STEP(0)
    asm volatile("s_nop 15\n\ts_nop 7" : "+v"(o[0]), "+v"(o[1]), "+v"(o[2]), "+v"(o[3]), "+v"(o5));
    if (pass) { AT_ISSUE(0); }
    }
#undef AT_STEP
#undef AT_TILE
#undef AT_SOFTMAX
#undef AT_MMA_ACC
#undef AT_MMA_SEED
    asm volatile("s_nop 15\n\ts_nop 15" ::: "memory");
    { LAS unsigned char* stg = lds + AT_KV + wid * 8192;
#pragma unroll
      for (int r = 0; r < 16; ++r) { const int qrow = crow(r, hh); const float li = __builtin_amdgcn_rcpf(o5[r]);
#pragma unroll
          for (int dt = 0; dt < 4; ++dt) *(LAS bf16_t*)(stg + qrow * 256 + (32 * dt + r32) * 2) = (bf16_t)(cvt_pk_bf16(o[dt][r] * li, 0.f) & 0xffffu); }
      asm volatile("s_waitcnt lgkmcnt(0)" ::: "memory");
      const size_t rowbase = (tok_b + (size_t)qb * 256 + wid * 32) * D + h * HD;
#pragma unroll
      for (int i = 0; i < 8; ++i) { const int row = 4 * i + (lane >> 4), ch = lane & 15;
          const u32x4 yv = *(const LAS u32x4*)(stg + row * 256 + ch * 16);
          const size_t off = rowbase + (size_t)row * D + ch * 8;
          const u32x4 zv = *(const u32x4*)(Zg + off); const u32x2 g8 = *(const u32x2*)((const unsigned char*)GBg + off);
          u32x4 ov;
          { const f32x2 g0 = __builtin_amdgcn_cvt_pk_f32_fp8((int)g8.x, false), g1 = __builtin_amdgcn_cvt_pk_f32_fp8((int)g8.x, true), g2 = __builtin_amdgcn_cvt_pk_f32_fp8((int)g8.y, false), g3 = __builtin_amdgcn_cvt_pk_f32_fp8((int)g8.y, true);
            ov.x = cvt_pk_bf16(bf_lo(zv.x) + g0[0] * bf_lo(yv.x), bf_hi(zv.x) + g0[1] * bf_hi(yv.x)); ov.y = cvt_pk_bf16(bf_lo(zv.y) + g1[0] * bf_lo(yv.y), bf_hi(zv.y) + g1[1] * bf_hi(yv.y));
            ov.z = cvt_pk_bf16(bf_lo(zv.z) + g2[0] * bf_lo(yv.z), bf_hi(zv.z) + g2[1] * bf_hi(yv.z)); ov.w = cvt_pk_bf16(bf_lo(zv.w) + g3[0] * bf_lo(yv.w), bf_hi(zv.w) + g3[1] * bf_hi(yv.w)); }
          if (live) *(u32x4*)(Zg + off) = ov; }
      asm volatile("s_waitcnt lgkmcnt(0)" ::: "memory"); }
#undef AT_ISSUE
}
__device__ __forceinline__ void p3_attention(const Frame& F, const Args& a, const bool live) {
    for (int v = F.vcu; v < 256; v += F.G) {
        const int bh = v >> 3, s = v & 7;
        __syncthreads(); gmlp_load_ws(F, a, bh & 7); attn_bh_tables(F, a, bh >> 3, bh & 7);
#pragma unroll 1
        for (int uu = 0; uu < 2; ++uu) attn_unit(F, a, bh >> 3, bh & 7, uu ? s : 15 - s, live);
    }
}

constexpr int P5_CTR_OFF = MISC_OFF + 256;
__device__ __forceinline__ void p5_router(const Frame& F, const Args& a, const bool live) {
    unsigned char* ws = a.ws;
    const int lane = F.lane, wid = F.wave;
    const float* lpart = (const float*)(ws + WS_LPART); const float* ssqp = (const float*)(ws + WS_SSQ);
    unsigned* cnt = (unsigned*)(ws + WS_CTL) + CW_CNT; int* list = (int*)(ws + WS_LIST); int* inv = (int*)(ws + WS_INV); float* wtok = (float*)(ws + WS_WTOK); float* rsp = (float*)(ws + WS_RSP);
    LAS unsigned* ctr = (LAS unsigned*)(F.lds + P5_CTR_OFF);
    if (F.tid == 0) *ctr = 0u;
    __syncthreads();
    if (wid < 4) {
        LAS float* scr = (LAS float*)(F.lds + wid * 16384 + 8704);
        for (int tile = F.vcu * 4 + wid; tile < T / 16; tile += F.G * 4) {
        const int row0 = tile * 16, r = lane & 15, kq = lane >> 4;
        const float* lp = lpart + ((size_t)kq * T + row0 + r) * 48;
        f32x4 pv[12];
#pragma unroll
        for (int i = 0; i < 12; ++i) pv[i] = *(const f32x4*)(lp + 4 * i);
        float ssq = ssqp[(size_t)kq * T + row0 + r];
#pragma unroll
        for (int i = 0; i < 12; ++i)
#pragma unroll
            for (int j = 0; j < 4; ++j) { float v = pv[i][j]; v += __shfl_xor(v, 16); v += __shfl_xor(v, 32); pv[i][j] = v; }
        ssq += __shfl_xor(ssq, 16); ssq += __shfl_xor(ssq, 32);
        const float rs = 1.0f / sqrtf(ssq * (1.f / D) + NORM_EPS);
        if (kq == 0) {
#pragma unroll
            for (int i = 0; i < 12; ++i)
#pragma unroll
                for (int j = 0; j < 4; ++j) scr[r * 49 + 4 * i + j] = pv[i][j]; }
        LDS_WAIT(); asm volatile("" ::: "memory");
        if (lane < 16) {
            const LAS float* lr = scr + lane * 49;
            float gl[4];
#pragma unroll
            for (int g = 0; g < 4; ++g) gl[g] = lr[32 + g] * rs + a.b_gr[g];
            int gi = 0; float gm = gl[0];
#pragma unroll
            for (int g = 1; g < 4; ++g) if (gl[g] > gm) { gm = gl[g]; gi = g; }
            float den = 0.f;
#pragma unroll
            for (int g = 0; g < 4; ++g) den += __expf(gl[g] - gm);
            const float g_w = 1.0f / den;
            float el[8];
#pragma unroll
            for (int e = 0; e < 8; ++e) el[e] = lr[gi * 8 + e] * rs + a.b_er[gi * 8 + e];
            int e0 = 0; float v0 = el[0];
#pragma unroll
            for (int e = 1; e < 8; ++e) if (el[e] > v0) { v0 = el[e]; e0 = e; }
            int e1 = -1; float v1 = -INFINITY;
#pragma unroll
            for (int e = 0; e < 8; ++e) if (e != e0 && el[e] > v1) { v1 = el[e]; e1 = e; }
            const float x1 = __expf(v1 - v0), w0f = g_w / (1.0f + x1), w1f = g_w * x1 / (1.0f + x1);
            if (live) { const int m = row0 + lane;
                const int ex0 = gi * 8 + e0, ex1 = gi * 8 + e1;
                const unsigned p0 = __hip_atomic_fetch_add(cnt + 64 * ex0, 1u, __ATOMIC_RELAXED, __HIP_MEMORY_SCOPE_AGENT);
                const unsigned p1 = __hip_atomic_fetch_add(cnt + 64 * ex1, 1u, __ATOMIC_RELAXED, __HIP_MEMORY_SCOPE_AGENT);
                list[ex0 * LCAP + p0] = m * 2; list[ex1 * LCAP + p1] = m * 2 + 1;
                rsp[ex0 * LCAP + p0] = rs; rsp[ex1 * LCAP + p1] = rs;
                *(int2*)(inv + m * 2) = make_int2(ex0 * LCAP + (int)p0, ex1 * LCAP + (int)p1); *(float2*)(wtok + m * 2) = make_float2(w0f, w1f); }
        }
        LDS_WAIT(); asm volatile("" ::: "memory");
        }
    }
    { LAS float* tscr = (LAS float*)(F.lds + wid * 16384);
      const float* w1 = a.w1; const float* w3 = a.w3; const float* w2 = a.w2; unsigned char* w13 = ws + WS_W13; unsigned char* w2t = ws + WS_W2;
      constexpr int I13 = (D / 32) * (DEXP / 64), I2 = (DEXP / 32) * (D / 64), IPE = 2 * I13 + I2;
      auto gen = [=](int it) -> TDesc {
          TDesc d; const int e = it / IPE; int r = it % IPE;
          if (r < 2 * I13) { const int which = r / I13; r %= I13; const int kb = r / (DEXP / 64), nb = r % (DEXP / 64);
              d.src = (which ? w3 : w1) + (size_t)e * D * DEXP; d.N = DEXP; d.k0 = 32 * kb; d.n0 = 64 * nb; d.dst = w13 + (size_t)e * 512 * D; d.ldd = D; d.rmk = 3; d.which = which; d.scale = 32.0f; }
          else { r -= 2 * I13; const int kb = r / (D / 64), nb = r % (D / 64);
              d.src = w2 + (size_t)e * DEXP * D; d.N = D; d.k0 = 32 * kb; d.n0 = 64 * nb; d.dst = w2t + (size_t)e * D * DEXP; d.ldd = DEXP; d.rmk = 0; d.which = 0; d.scale = 16.0f; }
          return d; };
      const int per_wg = (NEXP * IPE + F.G - 1) / F.G;
      const int base = F.vcu * per_wg;
      const int q4 = per_wg / 8;
      const int restw = (per_wg - 4 * q4 + 3) / 4;
      const int lo_ = wid < 4 ? wid * q4 : 4 * q4 + (wid - 4) * restw;
      int hi_ = wid < 4 ? lo_ + q4 : lo_ + restw; if (hi_ > per_wg) hi_ = per_wg;
      int endi = base + hi_; if (endi > NEXP * IPE) endi = NEXP * IPE;
      titems_run(gen, base + lo_, 1, endi, tscr, lane); }
    __syncthreads();
}

__device__ __forceinline__ void p8_final(const Frame& F, const Args& a, const bool live) {
    const int gw = F.vcu * NWAVES + F.wave, NGW = F.G * NWAVES, lane = F.lane;
    const unsigned char* yp = a.ws + WS_YP;
    const LAS int* pref = (const LAS int*)(F.lds + PREF_OFF);
    f32x4 gv[4];
#pragma unroll
    for (int j = 0; j < 4; ++j) gv[j] = *((const f32x4*)a.norm_final_g + lane + 64 * j);
    for (int m = gw; m < T; m += NGW) {
        f32x4* xr = (f32x4*)(a.out + (size_t)m * D) + lane;
        const u32x2* hr = (const u32x2*)((const bf16_t*)(a.ws + WS_HB) + (size_t)m * D) + lane;
        const int2 iv = *(const int2*)((const int*)(a.ws + WS_INV) + m * 2); const float2 wv = *(const float2*)((const float*)(a.ws + WS_WTOK) + m * 2);
        const int pr0 = 256 * pref[iv.x >> 14] + (iv.x & (LCAP - 1)), pr1 = 256 * pref[iv.y >> 14] + (iv.y & (LCAP - 1));
        const unsigned* y0 = (const unsigned*)(yp + (size_t)pr0 * D) + lane; const unsigned* y1 = (const unsigned*)(yp + (size_t)pr1 * D) + lane;
        const float w0 = wv.x * (1.0f / 16.0f), w1 = wv.y * (1.0f / 16.0f);
        f32x4 v[4]; float s = 0.f;
#pragma unroll
        for (int j = 0; j < 4; ++j) { const unsigned p0 = y0[64 * j], p1 = y1[64 * j];
            const f32x2 a0 = __builtin_amdgcn_cvt_pk_f32_fp8((int)p0, false), a1 = __builtin_amdgcn_cvt_pk_f32_fp8((int)p0, true), b0 = __builtin_amdgcn_cvt_pk_f32_fp8((int)p1, false), b1 = __builtin_amdgcn_cvt_pk_f32_fp8((int)p1, true);
            const u32x2 hb = hr[64 * j];
            v[j] = (f32x4){bf_lo(hb.x), bf_hi(hb.x), bf_lo(hb.y), bf_hi(hb.y)} + (f32x4){w0 * a0[0] + w1 * b0[0], w0 * a0[1] + w1 * b0[1], w0 * a1[0] + w1 * b1[0], w0 * a1[1] + w1 * b1[1]};
            s += (v[j].x * v[j].x + v[j].y * v[j].y) + (v[j].z * v[j].z + v[j].w * v[j].w); }
        const float rs = 1.0f / sqrtf(wave_sum(s) * (1.f / D) + NORM_EPS);
#pragma unroll
        for (int j = 0; j < 4; ++j) if (live) xr[64 * j] = v[j] * rs * gv[j];
    }
}

constexpr int N_PHASES = 9;
__global__ void __launch_bounds__(NTHREADS, 2) mk_fwd(Args args) {
    extern __shared__ __attribute__((aligned(16))) unsigned char lds_raw[];
#define MKFRAME() Frame F; { unsigned l_ = __builtin_amdgcn_mbcnt_hi(~0u, __builtin_amdgcn_mbcnt_lo(~0u, 0u)); asm volatile("" : "+v"(l_)); F.lds = (LAS unsigned char*)lds_raw; F.lane = (int)l_; F.wave = wave0; F.tid = wave0 * 64 + F.lane; \
        F.G = gridDim.x; const int bx_ = blockIdx.x; F.vcu = (F.G % 8 == 0) ? (bx_ % 8) * (F.G / 8) + bx_ / 8 : bx_; }
    LAS unsigned char* const lds0 = (LAS unsigned char*)lds_raw;
    const int wave0 = __builtin_amdgcn_readfirstlane((int)(threadIdx.x >> 6));
    unsigned char* ws = args.ws;
    unsigned* ctl = (unsigned*)(ws + WS_CTL);
    if (threadIdx.x < 64) ((LAS unsigned*)(lds0 + MISC_OFF))[threadIdx.x] = 0u;
    __syncthreads();
    const int lo = args.ph_lo, hi = args.ph_hi, repm = args.rep_mask;
    XcdBarrier bar; bar.bar = ctl + CW_BAR; bar.x = 0; bar.st = nullptr;
    bar = xcd_barrier_post(ctl + CW_BAR, (volatile LAS unsigned*)(lds0 + MISC_OFF));
#ifndef PHASE_MASK
#define PHASE_MASK 0x1ff
#endif
#define IN(k) (((PHASE_MASK >> (k)) & 1) && lo <= (k) && (k) < hi)
#define SEAM(k) do { if (IN(k) && IN((k) + 1)) xcd_barrier(bar); } while (0)
#define REP(k) _Pragma("unroll 1") for (int rep_ = ((repm >> (k)) & 1); rep_ >= 0; --rep_)
#define LIVE (rep_ == 0)

    if (IN(0)) { REP(0) { MKFRAME(); const Args a = load_args(); p0_prologue(F, a); } SEAM(0); }
    if (IN(1)) { REP(1) {
        { MKFRAME(); const Args args = load_args();
          pg8::StaticOrder S; S.init((const bf16_t*)args.out, (const bf16_t*)(ws + WS_WIN), T, 2048, D, F.G, (int)blockIdx.x);
          EpiInProj E{(bf16_t*)(ws + WS_U), args.b_gates, (float*)(ws + WS_KPART), (f32x2*)(ws + WS_STAT), 0};
          pg8::gemm_phase<EpiInProj, pg8::StaticOrder, false, D>(F.lds, F.tid, S, E, nullptr); }
        { MKFRAME(); const Args args = load_args();
          pg8::StaticOrder S; S.init((const bf16_t*)(ws + WS_XN8), (const bf16_t*)(ws + WS_WIN8), T, 5120, D / 2, F.G, (int)blockIdx.x);
          EpiInProj E{(bf16_t*)(ws + WS_U), args.b_gates, (float*)(ws + WS_KPART), (f32x2*)(ws + WS_STAT), 8};
          pg8::gemm_phase<EpiInProj, pg8::StaticOrder, false, D / 2, 0x7a>(F.lds, F.tid, S, E, nullptr); } }
        SEAM(1);
    }
    if (IN(3)) { REP(3) { MKFRAME(); const Args a = load_args(); p3_attention(F, a, LIVE); } SEAM(3); }
    if (IN(4)) { REP(4) {
        MKFRAME(); const Args args = load_args();
        pg8::StaticOrder S; S.init((const bf16_t*)(ws + WS_U), (const bf16_t*)(ws + WS_WOUT), T, D, D, F.G, (int)blockIdx.x);
        EpiOutProj E{args.x, (bf16_t*)(ws + WS_HB), args.norm_ffn_g, ws + WS_XN2, (const bf16_t*)(ws + WS_RW), (float*)(ws + WS_LPART), (float*)(ws + WS_SSQ), F.lds + RED_OFF};
        pg8::gemm_phase<EpiOutProj, pg8::StaticOrder, false, D>(F.lds, F.tid, S, E, nullptr); }
        SEAM(4);
    }
    if (IN(5)) { REP(5) { MKFRAME(); const Args a = load_args(); p5_router(F, a, LIVE); } SEAM(5); }
    if (IN(6) || IN(7) || IN(8)) {
        if (threadIdx.x == 0) { LAS int* pref = (LAS int*)(lds0 + PREF_OFF); int acc = 0;
            for (int e = 0; e < NEXP; ++e) { pref[e] = acc; const int c = (int)__hip_atomic_load(ctl + CW_CNT + 64 * e, __ATOMIC_RELAXED, __HIP_MEMORY_SCOPE_AGENT); acc += (c + 255) >> 8; }
            pref[NEXP] = acc; }
        __syncthreads();
    }
    if (IN(6)) { REP(6) {
        typedef pg8::MoeOrder<2, 0, (size_t)512 * D, (size_t)256 * D, D> Ord1;
        typedef pg8::MoeOrder<4, (size_t)256 * DEXP, (size_t)D * DEXP, (size_t)256 * DEXP, 0> Ord2;
        const int G = gridDim.x, total = __builtin_amdgcn_readfirstlane(((const LAS int*)(lds0 + PREF_OFF))[NEXP]);
        const int n1 = 2 * total, r = n1 > G ? n1 - G : 0, early = (n1 > G ? G : n1) / 2;
#pragma unroll 1
        for (int stage = 0; stage < 2; ++stage) {
            MKFRAME();
            Ord1 S; S.pref = (const LAS int*)(F.lds + PREF_OFF); S.c = (int)blockIdx.x; S.A = (const char*)(ws + WS_XN2); S.Bt = (const char*)(ws + WS_W13); S.list = (const int*)(ws + WS_LIST);
            S.first = stage == 0 ? 0 : 2 * early; S.limit = stage == 0 ? 2 * early : n1; S.cbase = 0; S.nwg = stage == 0 ? G : (r > 0 ? r : 1);
            EpiMoe1 E{ws + WS_HID, (const float*)(ws + WS_RSP), ctl + CW_CNT};
            pg8::gemm_phase<EpiMoe1, Ord1, true, D / 2, 0x7a>(F.lds, F.tid, S, E, ctl + CW_CNT);
            if (stage == 0) xcd_barrier(bar);
        }
#pragma unroll 1
        for (int stage = 1; stage < 3; ++stage) {
            MKFRAME();
            Ord2 S; S.pref = (const LAS int*)(F.lds + PREF_OFF); S.c = (int)blockIdx.x; S.A = (const char*)(ws + WS_HID); S.Bt = (const char*)(ws + WS_W2); S.list = (const int*)(ws + WS_LIST);
            S.first = stage == 2 ? 4 * early : 0; S.limit = stage == 1 ? 4 * early : 4 * total; S.cbase = stage == 1 ? r : 0; S.nwg = stage == 1 ? G - r : G;
            EpiMoe2 E{ws + WS_YP};
            pg8::gemm_phase<EpiMoe2, Ord2, false, DEXP / 2, 0x7b>(F.lds, F.tid, S, E, nullptr);
            if (stage == 1) xcd_barrier(bar);
        } }
        SEAM(6);
    }
    if (IN(8)) { REP(8) { MKFRAME(); const Args a = load_args(); p8_final(F, a, LIVE); } }
#undef IN
#undef SEAM
#undef REP
#undef LIVE
}

#ifndef MK_REP_MASK
#define MK_REP_MASK 0x000
#endif
#ifndef MK_SPLIT
#define MK_SPLIT 0
#endif
extern "C" void kernel_launch(void* const* d_in, const int* in_sizes, int n_in, void* d_out, int out_size, void* d_ws, size_t ws_size, hipStream_t stream) {
    static int grid = 0;
    if (grid == 0) {
        if (n_in != 19 || out_size != T * D || ws_size < WS_END) { fprintf(stderr, "kernel_launch: unexpected problem (n_in %d, out %d, ws %zu)\n", n_in, out_size, ws_size); grid = -1; return; }
        int dev = 0, cus = 0, per_cu = 0;
        if (hipGetDevice(&dev) != hipSuccess || hipDeviceGetAttribute(&cus, hipDeviceAttributeMultiprocessorCount, dev) != hipSuccess) { grid = -1; return; }
        if (hipFuncSetAttribute((const void*)mk_fwd, hipFuncAttributeMaxDynamicSharedMemorySize, LDS_BYTES) != hipSuccess) { fprintf(stderr, "kernel_launch: hipFuncSetAttribute failed\n"); grid = -1; return; }
        if (hipOccupancyMaxActiveBlocksPerMultiprocessor(&per_cu, (const void*)mk_fwd, NTHREADS, LDS_BYTES) != hipSuccess || per_cu < 1) fprintf(stderr, "kernel_launch: occupancy query reports %d\n", per_cu);
        (void)hipGetLastError();
        grid = cus;
    }
    if (grid < 0) return;
    if (hipMemsetAsync((char*)d_ws + WS_CTL, 0, CTL_ZERO_BYTES, stream) != hipSuccess) return;
    Args a{};
    a.x = (const float*)d_in[0]; a.norm_mix_g = (const float*)d_in[1]; a.w_in = (const float*)d_in[2]; a.b_gates = (const float*)d_in[3]; a.ln_g = (const float*)d_in[4]; a.ln_b = (const float*)d_in[5];
    a.w_spatial = (const float*)d_in[6]; a.b_spatial = (const float*)d_in[7]; a.rel_bias = (const float*)d_in[8]; a.w_out = (const float*)d_in[9]; a.norm_ffn_g = (const float*)d_in[10];
    a.w_gr = (const float*)d_in[11]; a.b_gr = (const float*)d_in[12]; a.w_er = (const float*)d_in[13]; a.b_er = (const float*)d_in[14]; a.w1 = (const float*)d_in[15]; a.w3 = (const float*)d_in[16]; a.w2 = (const float*)d_in[17];
    a.norm_final_g = (const float*)d_in[18]; a.out = (float*)d_out; a.ws = (unsigned char*)d_ws; a.rep_mask = MK_REP_MASK; a.pad = 0;
#if MK_SPLIT
    for (int p = 0; p < N_PHASES; ++p) { a.ph_lo = p; a.ph_hi = p + 1; hipLaunchKernelGGL(mk_fwd, dim3(grid), dim3(NTHREADS), LDS_BYTES, stream, a); }
#else
    a.ph_lo = 0; a.ph_hi = N_PHASES; hipLaunchKernelGGL(mk_fwd, dim3(grid), dim3(NTHREADS), LDS_BYTES, stream, a);
#endif
}
```

```cpp
#include <hip/hip_runtime.h>
#include <cstdio>
#include <cstdint>

#define LAS __attribute__((address_space(3)))
#define GAS __attribute__((address_space(1)))
typedef unsigned short bf16_t;
typedef short bf16x8 __attribute__((ext_vector_type(8)));
typedef short s16x4 __attribute__((ext_vector_type(4)));
typedef float f32x4 __attribute__((ext_vector_type(4)));
typedef float f32x2 __attribute__((ext_vector_type(2)));
typedef float f32x16 __attribute__((ext_vector_type(16)));
typedef unsigned u32x4 __attribute__((ext_vector_type(4)));
typedef unsigned u32x2 __attribute__((ext_vector_type(2)));

constexpr int T = 16384, D = 1024, NCOL = 7168, SEQ = 4096, NBATCH = 4, NH = 8, HD = 128;
constexpr int NEXP = 32, DEXP = 256, LCAP = 16384;
constexpr float NORM_EPS = 1e-6f;
constexpr float LOG2E = 1.4426950408889634f;
constexpr int NWAVES = 8, NTHREADS = 512;

constexpr size_t MiB = 1u << 20;
constexpr size_t WS_CTL = 0, CTL_ZERO_BYTES = 1 * MiB;
constexpr size_t WS_WIN = 1 * MiB;
constexpr size_t WS_WIN8 = 5 * MiB;
constexpr size_t WS_XN8 = 212 * MiB;
constexpr size_t WS_WOUT = 15 * MiB;
constexpr size_t WS_WSB = 17 * MiB;
constexpr size_t WS_KPART = 17 * MiB + 256 * 1024;
constexpr size_t WS_RW = 17 * MiB + 768 * 1024;
constexpr size_t WS_LPART = 100 * MiB;
constexpr size_t WS_SSQ = 113 * MiB;
constexpr size_t WS_STAT = 18 * MiB;
constexpr size_t WS_U = 20 * MiB;
constexpr size_t SEG_BYTES = 32 * MiB;
constexpr size_t WS_VG = WS_U + SEG_BYTES, WS_Q = WS_U + 2 * SEG_BYTES, WS_K = WS_U + 3 * SEG_BYTES, WS_VA = WS_U + 4 * SEG_BYTES, WS_GB = WS_U + 5 * SEG_BYTES;
constexpr size_t WS_XN2 = 52 * MiB;
constexpr size_t WS_W13 = 84 * MiB;
constexpr size_t WS_W2 = 116 * MiB;
constexpr size_t WS_HID = 132 * MiB;
constexpr size_t WS_YP = 152 * MiB;
constexpr size_t WS_LIST = 232 * MiB;
constexpr size_t WS_INV = 234 * MiB;
constexpr size_t WS_WTOK = 235 * MiB;
constexpr size_t WS_RSP = 236 * MiB;
constexpr size_t WS_XRS = 228 * MiB;
constexpr size_t WS_HB = 192 * MiB;
constexpr size_t WS_END = 238 * MiB;
constexpr int CW_BAR = 4096;
constexpr int CW_CNT = 8192;

constexpr int RING_BYTES = 131072;
constexpr int MISC_OFF = RING_BYTES;
constexpr int PREF_OFF = MISC_OFF + 64;
constexpr int LDS_BYTES = 163840;
constexpr int RED_OFF = MISC_OFF + 4096, RED_BYTES = 64 * 52 * 4;

typedef __bf16 bf16x2_t __attribute__((ext_vector_type(2)));
__device__ __forceinline__ unsigned cvt_pk_bf16(float lo, float hi) { const f32x2 v = {lo, hi}; const bf16x2_t b = __builtin_convertvector(v, bf16x2_t); return __builtin_bit_cast(unsigned, b); }
__device__ __forceinline__ unsigned cvt_pk4_fp8(float a, float b, float c, float d) { unsigned w = 0u; w = (unsigned)__builtin_amdgcn_cvt_pk_fp8_f32(a, b, (int)w, false); w = (unsigned)__builtin_amdgcn_cvt_pk_fp8_f32(c, d, (int)w, true); return w; }
__device__ __forceinline__ float bf_lo(unsigned w) { return __uint_as_float(w << 16); }
__device__ __forceinline__ float bf_hi(unsigned w) { return __uint_as_float(w & 0xffff0000u); }
__device__ __forceinline__ float wave_sum(float v) {
#pragma unroll
    for (int o = 1; o < 64; o <<= 1) v += __shfl_xor(v, o);
    return v;
}
#define LDS_WAIT() asm volatile("s_waitcnt lgkmcnt(0)" ::: "memory")
#define VM_WAIT() asm volatile("s_waitcnt vmcnt(0)" ::: "memory")

#define XB_TMO      128
#define XB_XCNT(j)  (256  + 64 * (j))
#define XB_XSUB(j)  (1280 + 64 * (j))
#define XB_XGEN(j)  (2304 + 64 * (j))
#define XB_TOP      3328
#define XB_TOPGEN   3392
#define XCD_BAR_WORDS 3456
#define XB_SPIN_CAP (1u << 18)
__device__ __forceinline__ unsigned xb_ld(unsigned* p)              { return __hip_atomic_load(p, __ATOMIC_RELAXED, __HIP_MEMORY_SCOPE_AGENT); }
__device__ __forceinline__ unsigned xb_add(unsigned* p, unsigned v) { return __hip_atomic_fetch_add(p, v, __ATOMIC_RELAXED, __HIP_MEMORY_SCOPE_AGENT); }
__device__ __forceinline__ unsigned xb_xcc_id() { return (unsigned)__builtin_amdgcn_s_getreg((3 << 11) | 20) & 0xFu; }
#define XB_SPIN(cond, bar) do { unsigned _sp = 0; while (cond) { __builtin_amdgcn_s_sleep(1); \
    if ((++_sp & 255u) == 0u) { if (xb_ld(&(bar)[XB_TMO])) break; if (_sp > XB_SPIN_CAP) { atomicAdd(&(bar)[XB_TMO], 1u); break; } } } } while (0)
struct XcdBarrier { unsigned* bar; unsigned x; volatile LAS unsigned* st; };
__device__ __forceinline__ XcdBarrier xcd_barrier_post(unsigned* bar, volatile LAS unsigned* st) {
    XcdBarrier b; b.bar = bar; b.x = xb_xcc_id(); b.st = st;
    if (threadIdx.x == 0) (void)xb_add(&bar[XB_XCNT(b.x)], 1u);
    return b;
}
__device__ __forceinline__ void xcd_barrier_complete(unsigned* bar, unsigned x, unsigned& nloc, unsigned& nx) {
    const unsigned G = gridDim.x * gridDim.y * gridDim.z;
    unsigned sum, cnt, mine, sp = 0u;
    for (;;) {
        sum = 0u; cnt = 0u; mine = 0u;
#pragma unroll
        for (unsigned j = 0; j < 16; ++j) { const unsigned c = xb_ld(&bar[XB_XCNT(j)]); sum += c; cnt += (c > 0u) ? 1u : 0u; mine = (j == x) ? c : mine; }
        if (sum == G) break;
        __builtin_amdgcn_s_sleep(1);
        if ((++sp & 255u) == 0u) { if (xb_ld(&bar[XB_TMO])) break; if (sp > XB_SPIN_CAP) { atomicAdd(&bar[XB_TMO], 1u); break; } }
    }
    nloc = mine > 0u ? mine : 1u; nx = cnt > 0u ? cnt : 1u;
}
__device__ __forceinline__ void xcd_barrier(const XcdBarrier& b) {
    asm volatile("s_waitcnt vmcnt(0)" ::: "memory");
    __syncthreads();
    if (threadIdx.x == 0) {
        unsigned* bar = b.bar;
        __builtin_amdgcn_s_waitcnt(0);
        unsigned nloc = b.st[0], nx = b.st[1];
        if (nloc == 0u) { xcd_barrier_complete(bar, b.x, nloc, nx); b.st[0] = nloc; b.st[1] = nx; }
        const unsigned old = xb_add(&bar[XB_XSUB(b.x)], 1u);
        const unsigned gen = old / nloc;
        if (old + 1u == (gen + 1u) * nloc) {
            __builtin_amdgcn_fence(__ATOMIC_RELEASE, "agent");
            asm volatile("s_waitcnt vmcnt(0)" ::: "memory");
            const unsigned og = xb_add(&bar[XB_TOP], 1u);
            const unsigned tg = og / nx;
            if (og + 1u == (tg + 1u) * nx) xb_add(&bar[XB_TOPGEN], 1u);
            else XB_SPIN(xb_ld(&bar[XB_TOPGEN]) == tg, bar);
            __builtin_amdgcn_fence(__ATOMIC_ACQUIRE, "agent");
            xb_add(&bar[XB_XGEN(b.x)], 1u);
            asm volatile("s_waitcnt vmcnt(0)" ::: "memory");
        } else {
            XB_SPIN(xb_ld(&bar[XB_XGEN(b.x)]) == gen, bar);
            __builtin_amdgcn_fence(__ATOMIC_ACQUIRE, "agent");
            asm volatile("s_waitcnt vmcnt(0)" ::: "memory");
        }
    }
    __syncthreads();
}

namespace pg8 {
constexpr int BM = 256, BK = 64, HALF = 128, HTB = HALF * BK * 2, STAGE_BYTES = 8 * HTB, NXCD = 8, WGM = 8;
__host__ __device__ __forceinline__ int lds_byte(int r, int c) { const int st = (r >> 4) * 2 + (c >> 5), rr = r & 15, cc = c & 31, ob = rr * 64 + cc * 2; return st * 1024 + (ob ^ (((ob >> 9) & 1) << 5)); }
__host__ __device__ __forceinline__ void stage_rc(int b, int& R, int& C) { const int st = b / 1024, sb = b % 1024, swz = sb ^ (((sb >> 9) & 1) << 5); R = (st >> 1) * 16 + swz / 64; C = (st & 1) * 32 + (swz % 64) / 2; }
__host__ __device__ __forceinline__ int perm32(int rho) { const int n = rho >> 4, i = rho & 15; return 8 * (i >> 2) + 4 * n + (i & 3); }

struct Unit { int pm, pn, ex, rt; };

struct StaticOrder {
    int nM, nN, nwg, G, c; const char* A; const char* Bt; size_t tstep;
    __device__ void init(const bf16_t* A_, const bf16_t* Bt_, int M, int N, int K, int G_, int c_) { nM = M / BM; nN = N / BM; nwg = nM * nN; G = G_; c = c_; A = (const char*)A_; Bt = (const char*)Bt_; tstep = (size_t)BM * K * 2; }
    __device__ bool next(int i, Unit& u) const {
        const long L = (long)i * G + c; if (L >= nwg) return false;
        int wgid = (int)L; { const int q = nwg / NXCD, r = nwg % NXCD, xcd = wgid % NXCD, off = wgid / NXCD; wgid = (xcd < r ? xcd * (q + 1) : r * (q + 1) + (xcd - r) * q) + off; }
        const int nig = WGM * nN, gid = wgid / nig, fm = gid * WGM, gsz = (nM - fm) < WGM ? (nM - fm) : WGM;
        u.pm = fm + ((wgid % nig) % gsz); u.pn = (wgid % nig) / gsz; u.ex = 0; u.rt = 0; return true;
    }
    __device__ __forceinline__ const char* abase(const Unit& u) const { return A + (size_t)u.pm * tstep; }
    __device__ __forceinline__ const char* bbase(const Unit& u) const { return Bt + (size_t)u.pn * tstep; }
    __device__ __forceinline__ unsigned arow_off(const Unit&, int) const { return 0u; }
};
template <int npn, size_t a_tstep, size_t b_estep, size_t b_tstep, unsigned rowbytes>
struct MoeOrder {
    const LAS int* pref; int c; const char* A; const char* Bt; const int* list;
    int first, limit, cbase, nwg;
    __device__ bool next(int i, Unit& u) const {
        if (c < cbase || c >= cbase + nwg) return false;
        const long L = (long)first + (long)i * nwg + (c - cbase);
        if (L >= (long)limit) return false;
        const int tl = (int)(L / npn); u.pn = (int)(L % npn); u.pm = tl;
        const int ln = (int)__builtin_amdgcn_mbcnt_hi(~0u, __builtin_amdgcn_mbcnt_lo(~0u, 0u));
        const int mine = pref[ln & 31];
        const unsigned long long m = __ballot(ln >= 1 && ln < NEXP && mine <= tl);
        const int e = __builtin_popcountll(m);
        u.ex = e; u.rt = tl - __builtin_amdgcn_readlane(mine, e); return true;
    }
    __device__ __forceinline__ const char* abase(const Unit& u) const { return A + (size_t)u.pm * a_tstep; }
    __device__ __forceinline__ const char* bbase(const Unit& u) const { return Bt + (size_t)u.ex * b_estep + (size_t)u.pn * b_tstep; }
    __device__ __forceinline__ unsigned arow_off(const Unit& u, int r, int cnt_e) const {
        int p = u.rt * 256 + r; p = p < cnt_e ? p : 0;
        const int ent = list[u.ex * LCAP + p];
        return (unsigned)(ent >> 1) * rowbytes;
    }
};

typedef float f32x2v __attribute__((ext_vector_type(2)));
typedef int i32x4_t __attribute__((ext_vector_type(4)));
typedef int i32x8_t __attribute__((ext_vector_type(8)));
__device__ __forceinline__ f32x2v gelu_pk(f32x2v v) {
    const f32x2v av = __builtin_elementwise_abs(v), d = av * 0.2316418882f + 1.0f;
    f32x2v t; t.x = __builtin_amdgcn_rcpf(d.x); t.y = __builtin_amdgcn_rcpf(d.y);
    f32x2v q = t * 0.5307027145f + (-0.7265760135f); q = q * t + 0.7107068705f; q = q * t + (-0.142248368f); q = q * t + 0.127414796f; q = q * t;
    const f32x2v s = (v * v) * (-0.72134752044f);
    f32x2v e; e.x = __builtin_amdgcn_exp2f(s.x); e.y = __builtin_amdgcn_exp2f(s.y);
    const f32x2v m = v * (q * e), r = v - m;
    f32x2v o; o.x = v.x < 0.f ? m.x : r.x; o.y = v.y < 0.f ? m.y : r.y; return o;
}

template <class Epi, class Sched, bool GATHER, int K, int WSCALE = 0>
__device__ __forceinline__ void gemm_phase(LAS unsigned char* lds, const int tid, const Sched& S, const Epi& E, const unsigned* cnts) {
    const int wid = __builtin_amdgcn_readfirstlane(tid >> 6), lane = tid & 63, wr = wid >> 2, wc = wid & 3, fr = lane & 15, fq = lane >> 4;
    const int nt = K / BK;
    unsigned voffA[2], voffB[2]; int stR[2];
#pragma unroll
    for (int i = 0; i < 2; ++i) { int R, C; stage_rc(tid * 16 + i * 8192, R, C); const int Rb = Epi::PERM ? ((R & ~31) + perm32(R & 31)) : R;
        voffA[i] = GATHER ? (unsigned)(C * 2) : (unsigned)(R * K + C) * 2u; voffB[i] = (unsigned)(Rb * K + C) * 2u; stR[i] = R; }
    const size_t kstep = (size_t)(BK * 2);
    const size_t hstep = (size_t)HALF * K * 2;
    const unsigned ldsw = (unsigned)wid * 1024u;
    const int aoff = lds_byte(wr * 64 + fr, fq * 8), boff = lds_byte(wc * 32 + fr, fq * 8);
#define PG8_SA(b, h) (((b) * 2 + (h)) * HTB)
#define PG8_SB(b, h) ((4 + (b) * 2 + (h)) * HTB)
#define PG8_GLDS(gp, bufoff, i) __builtin_amdgcn_global_load_lds((const unsigned*)(gp), (LAS unsigned*)(lds + (bufoff) + ldsw + (i) * 8192), 16, 0, 0)
#define PG8_STAGE(bufoff, gbase, voff) do { _Pragma("unroll") for (int _i = 0; _i < 2; ++_i) PG8_GLDS((const char*)(gbase) + (voff)[_i], bufoff, _i); } while (0)
#define PG8_STAGE_A(bufoff, H, NX, KO) do { _Pragma("unroll") for (int _i = 0; _i < 2; ++_i) { \
        if constexpr (GATHER) { const unsigned _o = (NX) ? offN[H][_i] : offC[H][_i]; PG8_GLDS(gA + _o + voffA[_i] + (KO), bufoff, _i); } \
        else { PG8_GLDS(((NX) ? nA : cA) + (H) * hstep + voffA[_i] + (KO), bufoff, _i); } } } while (0)
#define PG8_LDA(dst, b, h) do { _Pragma("unroll") for (int m = 0; m < 4; ++m) { dst[m].lo = *(const LAS i32x4_t*)(lds + PG8_SA(b, h) + aoff + m * 2048); dst[m].hi = *(const LAS i32x4_t*)(lds + PG8_SA(b, h) + aoff + m * 2048 + 1024); } } while (0)
#define PG8_LDB(dst, b, h) do { _Pragma("unroll") for (int n = 0; n < 2; ++n) { dst[n].lo = *(const LAS i32x4_t*)(lds + PG8_SB(b, h) + boff + n * 2048); dst[n].hi = *(const LAS i32x4_t*)(lds + PG8_SB(b, h) + boff + n * 2048 + 1024); } } while (0)
#define PG8_MMA(ai, bj, At, Bt) do { __builtin_amdgcn_s_setprio(1); if constexpr (WSCALE != 0) asm volatile("s_nop 3" ::: "memory");     \
        _Pragma("unroll") for (int m = 0; m < 4; ++m) _Pragma("unroll") for (int n = 0; n < 2; ++n) { \
        if constexpr (WSCALE != 0) { asm volatile("v_mfma_scale_f32_16x16x128_f8f6f4 %0, %1, %2, %0, %3, %4 op_sel_hi:[0,0,0]" : "+v"(acc[ai][bj][m][n]) : "v"(Bt[n]), "v"(At[m]), "v"(wscale_v), "v"(ascale_v)); } \
        else { const i32x4_t bl_ = Bt[n].lo, bh_ = Bt[n].hi, al_ = At[m].lo, ah_ = At[m].hi;     \
               acc[ai][bj][m][n] = __builtin_amdgcn_mfma_f32_16x16x32_bf16(__builtin_bit_cast(bf16x8, bl_), __builtin_bit_cast(bf16x8, al_), acc[ai][bj][m][n], 0, 0, 0); \
               acc[ai][bj][m][n] = __builtin_amdgcn_mfma_f32_16x16x32_bf16(__builtin_bit_cast(bf16x8, bh_), __builtin_bit_cast(bf16x8, ah_), acc[ai][bj][m][n], 0, 0, 0); } } \
        __builtin_amdgcn_s_setprio(0); } while (0)
#define PG8_WAIT_V(n) asm volatile("s_waitcnt vmcnt(" #n ")" ::: "memory")
#define PG8_WAIT_L(n) asm volatile("s_waitcnt lgkmcnt(" #n ")" ::: "memory")
#define PG8_BAR __builtin_amdgcn_s_barrier()
#define PG8_SCHED __builtin_amdgcn_sched_barrier(0)
    Unit cur, nxt; int ui = 0;
    if (!S.next(0, cur)) return;
    f32x4 acc[2][2][4][2];
#pragma unroll
    for (int a = 0; a < 2; ++a)
#pragma unroll
        for (int b = 0; b < 2; ++b)
#pragma unroll
            for (int m = 0; m < 4; ++m)
#pragma unroll
                for (int n = 0; n < 2; ++n) acc[a][b][m][n] = (f32x4){0.f, 0.f, 0.f, 0.f};
    i32x8_t At[4], B0[2], B1[2];
    const int wscale_v = WSCALE * 0x01010101, ascale_v = 0x7f7f7f7f;
    const char* gA = S.A;
    const char* cA = S.abase(cur); const char* cB = S.bbase(cur);
    const char* nA = cA;
    unsigned offC[2][2], offN[2][2];
    if constexpr (GATHER) {
        const int ce = __builtin_amdgcn_readfirstlane((int)cnts[64 * cur.ex]);
#pragma unroll
        for (int h = 0; h < 2; ++h)
#pragma unroll
            for (int i = 0; i < 2; ++i) { offC[h][i] = S.arow_off(cur, stR[i] + h * HALF, ce); offN[h][i] = offC[h][i]; }
    } else {
#pragma unroll
        for (int h = 0; h < 2; ++h)
#pragma unroll
            for (int i = 0; i < 2; ++i) { offC[h][i] = 0u; offN[h][i] = 0u; }
    }
    PG8_STAGE(PG8_SB(0, 0), cB, voffB); PG8_STAGE(PG8_SB(0, 1), cB + hstep, voffB); PG8_STAGE_A(PG8_SA(0, 0), 0, false, 0); PG8_STAGE_A(PG8_SA(0, 1), 1, false, 0);
    if (wr == 1) PG8_BAR;
    PG8_WAIT_V(2); PG8_BAR;
    PG8_STAGE(PG8_SB(1, 0), cB + kstep, voffB); PG8_STAGE_A(PG8_SA(1, 0), 0, false, kstep); PG8_STAGE(PG8_SB(1, 1), cB + hstep + kstep, voffB);
    PG8_WAIT_V(6); PG8_BAR;
    for (;;) {
        const bool has_next = S.next(ui + 1, nxt);
        nA = has_next ? S.abase(nxt) : cA; const char* nB = has_next ? S.bbase(nxt) : cB;
        if constexpr (GATHER) {
            if (has_next) { const int ce = __builtin_amdgcn_readfirstlane((int)cnts[64 * nxt.ex]);
#pragma unroll
                for (int h = 0; h < 2; ++h)
#pragma unroll
                    for (int i = 0; i < 2; ++i) offN[h][i] = S.arow_off(nxt, stR[i] + h * HALF, ce);
            } else {
#pragma unroll
                for (int h = 0; h < 2; ++h)
#pragma unroll
                    for (int i = 0; i < 2; ++i) offN[h][i] = offC[h][i];
            }
        }
#pragma unroll 1
        for (int t = 0; t < nt; t += 2) {
            const bool last = (t == nt - 2);
            const size_t k1 = (size_t)(t + 1) * kstep;
            const size_t k2 = last ? 0 : (size_t)(t + 2) * kstep, k3 = k2 + kstep;
            const char* b2 = last ? nB : cB + (size_t)(t + 2) * kstep; const char* b3 = b2 + kstep;
            PG8_LDB(B0, 0, 0); PG8_LDB(B1, 0, 1); PG8_SCHED; PG8_LDA(At, 0, 0); PG8_STAGE_A(PG8_SA(1, 1), 1, false, k1);
            PG8_WAIT_V(8); PG8_WAIT_L(0); PG8_BAR; PG8_MMA(0, 0, At, B0); PG8_MMA(0, 1, At, B1); PG8_BAR; PG8_SCHED;
            PG8_LDA(At, 0, 1); PG8_STAGE(PG8_SB(0, 0), b2, voffB); PG8_STAGE(PG8_SB(0, 1), b2 + hstep, voffB); PG8_STAGE_A(PG8_SA(0, 0), 0, last, k2);
            PG8_WAIT_V(8); PG8_WAIT_L(0); PG8_BAR; PG8_MMA(1, 0, At, B0); PG8_MMA(1, 1, At, B1); PG8_BAR; PG8_SCHED;
            PG8_LDB(B0, 1, 0); PG8_LDB(B1, 1, 1); PG8_SCHED; PG8_LDA(At, 1, 0); PG8_STAGE_A(PG8_SA(0, 1), 1, last, k2);
            PG8_WAIT_V(8); PG8_WAIT_L(0); PG8_BAR; PG8_MMA(0, 0, At, B0); PG8_MMA(0, 1, At, B1); PG8_BAR; PG8_SCHED;
            PG8_LDA(At, 1, 1); PG8_STAGE(PG8_SB(1, 0), b3, voffB); PG8_STAGE(PG8_SB(1, 1), b3 + hstep, voffB); PG8_STAGE_A(PG8_SA(1, 0), 0, last, k3);
            PG8_WAIT_V(8); PG8_WAIT_L(0); PG8_BAR; PG8_MMA(1, 0, At, B0); PG8_MMA(1, 1, At, B1); PG8_BAR; PG8_SCHED;
        }
        if (wr == 0) PG8_BAR;
        if constexpr (WSCALE != 0) asm volatile("s_nop 15\n\ts_nop 7" ::: "memory");
        E(acc, cur, wr, wc, fr, fq);
        if (!has_next) break;
#pragma unroll
        for (int a = 0; a < 2; ++a)
#pragma unroll
            for (int b = 0; b < 2; ++b)
#pragma unroll
                for (int m = 0; m < 4; ++m)
#pragma unroll
                    for (int n = 0; n < 2; ++n) acc[a][b][m][n] = (f32x4){0.f, 0.f, 0.f, 0.f};
        cur = nxt; cA = nA; cB = nB; ++ui;
#pragma unroll
        for (int h = 0; h < 2; ++h)
#pragma unroll
            for (int i = 0; i < 2; ++i) offC[h][i] = offN[h][i];
        if (wr == 1) PG8_BAR;
    }
    PG8_WAIT_V(0);
    PG8_BAR;
#undef PG8_SA
#undef PG8_SB
#undef PG8_GLDS
#undef PG8_STAGE
#undef PG8_STAGE_A
#undef PG8_LDA
#undef PG8_LDB
#undef PG8_MMA
#undef PG8_WAIT_V
#undef PG8_WAIT_L
#undef PG8_BAR
#undef PG8_SCHED
}
}

struct EpiInProj {
    static constexpr bool PERM = true;
    bf16_t* seg0; const float* b_gates; float* kpart; f32x2* stats; int pn_off;
    __device__ __forceinline__ void operator()(const f32x4 (&acc)[2][2][4][2], const pg8::Unit& u_, int wr, int wc, int fr, int fq) const {
        pg8::Unit u = u_; u.pn += pn_off;
        const int row0 = u.pm * 256 + wr * 64 + fr;
        if (u.pn < 8) {
            const int ch0 = 128 * u.pn + 16 * wc + 4 * fq;
            f32x4 bv[2];
#pragma unroll
            for (int bj = 0; bj < 2; ++bj) bv[bj] = *(const f32x4*)(b_gates + ch0 + 64 * bj);
#pragma unroll
            for (int ai = 0; ai < 2; ++ai)
#pragma unroll
                for (int m = 0; m < 4; ++m) { bf16_t* rowp = seg0 + (size_t)(row0 + ai * 128 + m * 16) * D + ch0;
#pragma unroll
                    for (int bj = 0; bj < 2; ++bj) { const f32x4 uu = acc[ai][bj][m][0], gg = acc[ai][bj][m][1] + bv[bj];
                        const pg8::f32x2v a = pg8::gelu_pk((pg8::f32x2v){uu[0], uu[1]}), b = pg8::gelu_pk((pg8::f32x2v){uu[2], uu[3]});
                        float sg[4];
#pragma unroll
                        for (int j = 0; j < 4; ++j) sg[j] = __builtin_amdgcn_rcpf(1.0f + __builtin_amdgcn_exp2f(-LOG2E * gg[j]));
                        u32x2 w; w.x = cvt_pk_bf16(a.x * sg[0], a.y * sg[1]); w.y = cvt_pk_bf16(b.x * sg[2], b.y * sg[3]);
                        *(u32x2*)(rowp + 64 * bj) = w; } }
            return;
        }
        const int seg = (u.pn >> 2) - 1;
        const int colt = (u.pn & 3) * 256, col0 = colt + wc * 32 + 8 * fq;
        bf16_t* base = seg0 + (size_t)seg * (SEG_BYTES / 2);
        if (seg == 1) {
#pragma unroll
            for (int ai = 0; ai < 2; ++ai)
#pragma unroll
                for (int m = 0; m < 4; ++m) { bf16_t* rowp = base + (size_t)(row0 + ai * 128 + m * 16) * D + col0; float s1 = 0.f, s2 = 0.f;
#pragma unroll
                    for (int bj = 0; bj < 2; ++bj) { const f32x4 v0 = acc[ai][bj][m][0], v1 = acc[ai][bj][m][1];
                        const pg8::f32x2v a = pg8::gelu_pk((pg8::f32x2v){v0[0], v0[1]}), b = pg8::gelu_pk((pg8::f32x2v){v0[2], v0[3]}), c = pg8::gelu_pk((pg8::f32x2v){v1[0], v1[1]}), d = pg8::gelu_pk((pg8::f32x2v){v1[2], v1[3]});
                        s1 += ((a.x + a.y) + (b.x + b.y)) + ((c.x + c.y) + (d.x + d.y));
                        s2 += ((a.x * a.x + a.y * a.y) + (b.x * b.x + b.y * b.y)) + ((c.x * c.x + c.y * c.y) + (d.x * d.x + d.y * d.y));
                        u32x4 w; w.x = cvt_pk_bf16(a.x, a.y); w.y = cvt_pk_bf16(b.x, b.y); w.z = cvt_pk_bf16(c.x, c.y); w.w = cvt_pk_bf16(d.x, d.y);
                        *(u32x4*)(rowp + bj * 128) = w; }
                    s1 += __shfl_xor(s1, 16); s1 += __shfl_xor(s1, 32); s2 += __shfl_xor(s2, 16); s2 += __shfl_xor(s2, 32);
                    if (fq == 0) stats[(size_t)(row0 + ai * 128 + m * 16) * 16 + (u.pn & 3) * 4 + wc] = (f32x2){s1, s2}; }
        } else if (seg == 5) {
            const float* bp = b_gates + D + col0;
            f32x4 bv[2][2];
#pragma unroll
            for (int bj = 0; bj < 2; ++bj)
#pragma unroll
                for (int n = 0; n < 2; ++n) bv[bj][n] = *(const f32x4*)(bp + bj * 128 + 4 * n);
#pragma unroll
            for (int ai = 0; ai < 2; ++ai)
#pragma unroll
                for (int m = 0; m < 4; ++m) { bf16_t* rowp = base + (size_t)(row0 + ai * 128 + m * 16) * D + col0;
#pragma unroll
                    for (int bj = 0; bj < 2; ++bj) { f32x4 v0 = acc[ai][bj][m][0] + bv[bj][0], v1 = acc[ai][bj][m][1] + bv[bj][1];
#pragma unroll
                        for (int j = 0; j < 4; ++j) { v0[j] = __builtin_amdgcn_rcpf(1.0f + __builtin_amdgcn_exp2f(-LOG2E * v0[j])); v1[j] = __builtin_amdgcn_rcpf(1.0f + __builtin_amdgcn_exp2f(-LOG2E * v1[j])); }
                        u32x2 w; w.x = cvt_pk4_fp8(v0[0], v0[1], v0[2], v0[3]); w.y = cvt_pk4_fp8(v1[0], v1[1], v1[2], v1[3]);
                        *(u32x2*)((unsigned char*)base + (size_t)(row0 + ai * 128 + m * 16) * D + col0 + bj * 128) = w; } }
        } else if (seg == 4) {
            unsigned char* vt = (unsigned char*)base;
            const int pw = 4 * (8 * ((fr >> 2) & 1) + 4 * (fr >> 3) + (fr & 3));
#pragma unroll
            for (int ai = 0; ai < 2; ++ai)
#pragma unroll
                for (int bj = 0; bj < 2; ++bj) {
                    unsigned char* tb = vt + ((size_t)(((u.pm >> 4) * 8 + 2 * (u.pn & 3) + bj) * 64 + 4 * (u.pm & 15) + 2 * ai + wr) * 128 + 32 * wc + 8 * fq) * 64 + pw;
#pragma unroll
                    for (int n = 0; n < 2; ++n)
#pragma unroll
                        for (int i = 0; i < 4; ++i) *(unsigned*)(tb + (4 * n + i) * 64) = cvt_pk4_fp8(acc[ai][bj][0][n][i], acc[ai][bj][1][n][i], acc[ai][bj][2][n][i], acc[ai][bj][3][n][i]); }
        } else {
            if (seg == 3) {
#pragma unroll
                for (int ai = 0; ai < 2; ++ai)
#pragma unroll
                    for (int m = 0; m < 4; ++m)
#pragma unroll
                        for (int bj = 0; bj < 2; ++bj) { const f32x4 v0 = acc[ai][bj][m][0], v1 = acc[ai][bj][m][1];
                            u32x2 w; w.x = cvt_pk4_fp8(v0[0], v0[1], v0[2], v0[3]); w.y = cvt_pk4_fp8(v1[0], v1[1], v1[2], v1[3]);
                            *(u32x2*)((unsigned char*)base + (size_t)(row0 + ai * 128 + m * 16) * D + col0 + bj * 128) = w; }
            } else {
#pragma unroll
            for (int ai = 0; ai < 2; ++ai)
#pragma unroll
                for (int m = 0; m < 4; ++m) { bf16_t* rowp = base + (size_t)(row0 + ai * 128 + m * 16) * D + col0;
#pragma unroll
                    for (int bj = 0; bj < 2; ++bj) { const f32x4 v0 = acc[ai][bj][m][0], v1 = acc[ai][bj][m][1];
                        u32x4 w; w.x = cvt_pk_bf16(v0[0], v0[1]); w.y = cvt_pk_bf16(v0[2], v0[3]); w.z = cvt_pk_bf16(v1[0], v1[1]); w.w = cvt_pk_bf16(v1[2], v1[3]);
                        *(u32x4*)(rowp + bj * 128) = w; } }
            }
            if (seg == 3) {
#pragma unroll
                for (int bj = 0; bj < 2; ++bj)
#pragma unroll
                    for (int n = 0; n < 2; ++n) { f32x4 s = (f32x4){0.f, 0.f, 0.f, 0.f};
#pragma unroll
                        for (int ai = 0; ai < 2; ++ai)
#pragma unroll
                            for (int m = 0; m < 4; ++m) s += acc[ai][bj][m][n];
#pragma unroll
                        for (int o = 1; o < 16; o <<= 1) { s[0] += __shfl_xor(s[0], o); s[1] += __shfl_xor(s[1], o); s[2] += __shfl_xor(s[2], o); s[3] += __shfl_xor(s[3], o); }
                        if (fr == 0) *(f32x4*)(kpart + ((size_t)u.pm * 2 + wr) * D + col0 + bj * 128 + 4 * n) = s; }
            }
        }
    }
};
struct EpiOutProj {
    static constexpr bool PERM = true;
    const bf16_t* xnb; const float* xrs; const float* gmix; bf16_t* hb; const float* gffn; unsigned char* xn2; const bf16_t* rwh; float* lpart; float* ssqp; LAS unsigned char* red;
    __device__ __forceinline__ void operator()(const f32x4 (&acc)[2][2][4][2], const pg8::Unit& u, int wr, int wc, int fr, int fq) const {
        asm volatile("" : "+v"(fr), "+v"(fq));
        const int row0 = u.pm * 256 + wr * 64 + fr, col0 = u.pn * 256 + wc * 32 + 8 * fq, lane = fq * 16 + fr;
        const bf16_t* rwl = rwh + 48 * D;
        LAS float* R = (LAS float*)(red + wr * RED_BYTES);
        f32x4 ig[2][2];
#pragma unroll
        for (int bj = 0; bj < 2; ++bj)
#pragma unroll
            for (int n = 0; n < 2; ++n) { const f32x4 gm = *(const f32x4*)(gmix + col0 + 128 * bj + 4 * n); ig[bj][n] = (f32x4){__builtin_amdgcn_rcpf(gm[0]), __builtin_amdgcn_rcpf(gm[1]), __builtin_amdgcn_rcpf(gm[2]), __builtin_amdgcn_rcpf(gm[3])}; }
#pragma unroll
        for (int ai = 0; ai < 2; ++ai)
#pragma unroll
            for (int m = 0; m < 4; ++m) { const size_t off = (size_t)(row0 + ai * 128 + m * 16) * D + col0; const float rm = xrs[row0 + ai * 128 + m * 16];
#pragma unroll
                for (int bj = 0; bj < 2; ++bj) { const u32x4 xw = *(const u32x4*)(xnb + off + bj * 128);
                    const f32x4 h0 = (f32x4){bf_lo(xw.x), bf_hi(xw.x), bf_lo(xw.y), bf_hi(xw.y)} * rm * ig[bj][0] + acc[ai][bj][m][0], h1 = (f32x4){bf_lo(xw.z), bf_hi(xw.z), bf_lo(xw.w), bf_hi(xw.w)} * rm * ig[bj][1] + acc[ai][bj][m][1];
                    u32x4 w; w.x = cvt_pk_bf16(h0[0], h0[1]); w.y = cvt_pk_bf16(h0[2], h0[3]); w.z = cvt_pk_bf16(h1[0], h1[1]); w.w = cvt_pk_bf16(h1[2], h1[3]);
                    *(u32x4*)(hb + off + bj * 128) = w; } }
        asm volatile("s_waitcnt vmcnt(0)" ::: "memory");
        bf16x8 bh[2][3], bl[2][3]; f32x4 gv[2][2];
#pragma unroll
        for (int bj = 0; bj < 2; ++bj) { gv[bj][0] = *(const f32x4*)(gffn + col0 + 128 * bj); gv[bj][1] = *(const f32x4*)(gffn + col0 + 128 * bj + 4); }
#pragma unroll
        for (int bj = 0; bj < 2; ++bj)
#pragma unroll
            for (int nt = 0; nt < 3; ++nt) { bh[bj][nt] = *(const bf16x8*)(rwh + (size_t)(16 * nt + fr) * D + col0 + 128 * bj); bl[bj][nt] = *(const bf16x8*)(rwl + (size_t)(16 * nt + fr) * D + col0 + 128 * bj); }
        LAS int* Ri = (LAS int*)R;
#pragma unroll
        for (int i = 0; i < 13; ++i) Ri[(16 * wc) * 52 + i * 64 + lane] = 0;
        __syncthreads();
#pragma unroll
        for (int ai = 0; ai < 2; ++ai) {
            f32x4 lacc[4][3]; float ssq[4];
#pragma unroll
            for (int m = 0; m < 4; ++m) { ssq[m] = 0.f;
#pragma unroll
                for (int nt = 0; nt < 3; ++nt) lacc[m][nt] = (f32x4){0.f, 0.f, 0.f, 0.f}; }
#pragma unroll
            for (int bj = 0; bj < 2; ++bj)
#pragma unroll
                for (int m = 0; m < 4; ++m) { const size_t off = (size_t)(row0 + ai * 128 + m * 16) * D + col0 + bj * 128;
                    const u32x4 w = *(const u32x4*)(hb + off); const bf16x8 af = __builtin_bit_cast(bf16x8, w);
                    const f32x4 r0 = (f32x4){bf_lo(w.x), bf_hi(w.x), bf_lo(w.y), bf_hi(w.y)}, r1 = (f32x4){bf_lo(w.z), bf_hi(w.z), bf_lo(w.w), bf_hi(w.w)};
                    ssq[m] += ((r0[0] * r0[0] + r0[1] * r0[1]) + (r0[2] * r0[2] + r0[3] * r0[3])) + ((r1[0] * r1[0] + r1[1] * r1[1]) + (r1[2] * r1[2] + r1[3] * r1[3]));
                    { const f32x4 y0 = r0 * gv[bj][0], y1 = r1 * gv[bj][1];
                      u32x2 w8; w8.x = cvt_pk4_fp8(y0[0], y0[1], y0[2], y0[3]); w8.y = cvt_pk4_fp8(y1[0], y1[1], y1[2], y1[3]);
                      *(u32x2*)(xn2 + off) = w8; }
#pragma unroll
                    for (int nt = 0; nt < 3; ++nt) { lacc[m][nt] = __builtin_amdgcn_mfma_f32_16x16x32_bf16(af, bh[bj][nt], lacc[m][nt], 0, 0, 0); lacc[m][nt] = __builtin_amdgcn_mfma_f32_16x16x32_bf16(af, bl[bj][nt], lacc[m][nt], 0, 0, 0); } }
#pragma unroll
            for (int m = 0; m < 4; ++m) {
#pragma unroll
                for (int nt = 0; nt < 3; ++nt)
#pragma unroll
                    for (int j = 0; j < 4; ++j) __hip_atomic_fetch_add(Ri + (16 * m + 4 * fq + j) * 52 + 16 * nt + fr, __float2int_rn(lacc[m][nt][j] * 4194304.0f), __ATOMIC_RELAXED, __HIP_MEMORY_SCOPE_WORKGROUP);
                float sq = ssq[m]; sq += __shfl_xor(sq, 16); sq += __shfl_xor(sq, 32);
                if (fq == 0) __hip_atomic_fetch_add(Ri + (16 * m + fr) * 52 + 48, __float2int_rn(sq * 65536.0f), __ATOMIC_RELAXED, __HIP_MEMORY_SCOPE_WORKGROUP); }
            __syncthreads();
            const int grow0 = u.pm * 256 + ai * 128 + wr * 64;
#pragma unroll
            for (int i = 0; i < 3; ++i) { const int q = i * 64 + lane, r = 16 * wc + q / 12, c4 = q % 12;
                const pg8::i32x4_t iv = *(const LAS pg8::i32x4_t*)(Ri + r * 52 + 4 * c4);
                *(f32x4*)(lpart + ((size_t)u.pn * T + grow0 + r) * 48 + 4 * c4) = (f32x4){(float)iv[0], (float)iv[1], (float)iv[2], (float)iv[3]} * (1.0f / 4194304.0f); }
            if (lane < 16) ssqp[(size_t)u.pn * T + grow0 + 16 * wc + lane] = (float)Ri[(16 * wc + lane) * 52 + 48] * (1.0f / 65536.0f);
            if (ai == 0) {
                asm volatile("s_waitcnt lgkmcnt(0)" ::: "memory");
#pragma unroll
                for (int i = 0; i < 13; ++i) Ri[(16 * wc) * 52 + i * 64 + lane] = 0;
                __syncthreads(); }
        }
    }
};
struct EpiMoe1 {
    static constexpr bool PERM = true;
    unsigned char* hid;
    const float* rsp; const unsigned* cnt;
    __device__ __forceinline__ void operator()(const f32x4 (&acc)[2][2][4][2], const pg8::Unit& u, int wr, int wc, int fr, int fq) const {
        const int hc0 = 128 * u.pn + 16 * wc + 4 * fq;
        const int ce = __builtin_amdgcn_readfirstlane((int)cnt[64 * u.ex]);
        float rsv[2][4];
#pragma unroll
        for (int ai = 0; ai < 2; ++ai)
#pragma unroll
            for (int m = 0; m < 4; ++m) { const int p = u.rt * 256 + ai * 128 + wr * 64 + m * 16 + fr; rsv[ai][m] = p < ce ? rsp[u.ex * LCAP + p] : 0.f; }
#pragma unroll
        for (int ai = 0; ai < 2; ++ai)
#pragma unroll
            for (int m = 0; m < 4; ++m) { const int r = ai * 128 + wr * 64 + m * 16 + fr; const float rs = rsv[ai][m];
                unsigned char* rowp = hid + (size_t)(u.pm * 256 + r) * DEXP + hc0;
#pragma unroll
                for (int bj = 0; bj < 2; ++bj) { const f32x4 a = acc[ai][bj][m][0] * rs, b = acc[ai][bj][m][1] * rs; f32x4 o;
#pragma unroll
                    for (int j = 0; j < 4; ++j) { const float sg = __builtin_amdgcn_rcpf(1.0f + __builtin_amdgcn_exp2f(-LOG2E * a[j])); o[j] = a[j] * sg * b[j]; }
                    *(unsigned*)(rowp + bj * 64) = cvt_pk4_fp8(o[0], o[1], o[2], o[3]); } }
    }
};
struct EpiMoe2 {
    static constexpr bool PERM = true;
    unsigned char* yp;
    __device__ __forceinline__ void operator()(const f32x4 (&acc)[2][2][4][2], const pg8::Unit& u, int wr, int wc, int fr, int fq) const {
        const int row0 = u.pm * 256 + wr * 64 + fr, col0 = u.pn * 256 + wc * 32 + 8 * fq;
#pragma unroll
        for (int ai = 0; ai < 2; ++ai)
#pragma unroll
            for (int m = 0; m < 4; ++m) { unsigned char* rowp = yp + (size_t)(row0 + ai * 128 + m * 16) * D + col0;
#pragma unroll
                for (int bj = 0; bj < 2; ++bj) { const f32x4 v0 = acc[ai][bj][m][0] * 16.0f, v1 = acc[ai][bj][m][1] * 16.0f;
                    u32x2 w; w.x = cvt_pk4_fp8(v0[0], v0[1], v0[2], v0[3]); w.y = cvt_pk4_fp8(v1[0], v1[1], v1[2], v1[3]);
                    *(u32x2*)(rowp + bj * 128) = w; } }
    }
};

struct Args {
    const float* x; const float* norm_mix_g; const float* w_in; const float* b_gates; const float* ln_g; const float* ln_b; const float* w_spatial; const float* b_spatial;
    const float* rel_bias; const float* w_out; const float* norm_ffn_g; const float* w_gr; const float* b_gr; const float* w_er; const float* b_er;
    const float* w1; const float* w3; const float* w2; const float* norm_final_g;
    float* out; unsigned char* ws; int ph_lo, ph_hi; int rep_mask, pad;
};
struct Frame { LAS unsigned char* lds; int tid, lane, wave, vcu, G; };
__device__ __forceinline__ Args load_args() {
#if defined(__HIP_DEVICE_COMPILE__)
    const __attribute__((address_space(4))) Args* p = (const __attribute__((address_space(4))) Args*)__builtin_amdgcn_kernarg_segment_ptr(); asm volatile("" : "+s"(p));
    Args r; __builtin_memcpy(&r, (const Args*)p, sizeof(Args)); return r;
#else
    return Args{};
#endif
}

__device__ __forceinline__ unsigned off_b(unsigned row, unsigned ch) { return 256u * row + 16u * (ch ^ (((row & 3) << 2) | ((row >> 2) & 3))); }
__device__ __forceinline__ int crow(int r, int hi) { return (r & 3) + 8 * (r >> 2) + 4 * hi; }
__device__ __forceinline__ s16x4 lds_tr(LAS const unsigned char* p) { typedef short v4i16_t __attribute__((ext_vector_type(4))); return __builtin_bit_cast(s16x4, __builtin_amdgcn_ds_read_tr16_b64_v4i16((LAS v4i16_t*)p)); }

struct TDesc { const float* src; int N, k0, n0; unsigned char* dst; int ldd  ; int rmk  , which; float scale  ; };
__device__ __forceinline__ int tdesc_row(const TDesc& d, int n) {
    if (d.rmk == 0) return n;
    if (d.rmk == 3) return 8 * (n >> 2) + 4 * d.which + (n & 3);
    const int sg = n >> 10, j = n & 1023; const int r = sg == 0 ? 8 * (j >> 2) + (j & 3) : sg == 5 ? 8 * (j >> 2) + 4 + (j & 3) : sg == 6 ? 6144 + j : 1024 + n;
    return d.rmk == 1 ? r : r - 2048;
}
__device__ __forceinline__ void titem_load(const TDesc& d, f32x4 (&v)[8], int lane) {
    const float* p = d.src + (size_t)(d.k0 + (lane >> 4)) * d.N + d.n0 + 4 * (lane & 15);
#pragma unroll
    for (int i = 0; i < 8; ++i) v[i] = __builtin_nontemporal_load((const f32x4*)(p + (size_t)(4 * i) * d.N));
}
__device__ __forceinline__ void titem_store(const TDesc& d, const f32x4 (&v)[8], LAS float* scr  , int lane) {
#pragma unroll
    for (int i = 0; i < 8; ++i) *(LAS f32x4*)(scr + (4 * i + (lane >> 4)) * 68 + 4 * (lane & 15)) = v[i];
    LDS_WAIT(); asm volatile("" ::: "memory");
    if (d.scale != 0.f) {
#pragma unroll
        for (int q = 0; q < 2; ++q) { const int n = (lane >> 1) + 32 * q, kh = lane & 1; const LAS float* sp = scr + (16 * kh) * 68 + n; float f[16];
#pragma unroll
            for (int j = 0; j < 16; ++j) f[j] = sp[j * 68] * d.scale;
            u32x4 o; o.x = cvt_pk4_fp8(f[0], f[1], f[2], f[3]); o.y = cvt_pk4_fp8(f[4], f[5], f[6], f[7]); o.z = cvt_pk4_fp8(f[8], f[9], f[10], f[11]); o.w = cvt_pk4_fp8(f[12], f[13], f[14], f[15]);
            *(u32x4*)(d.dst + (size_t)tdesc_row(d, d.n0 + n) * d.ldd + d.k0 + 16 * kh) = o; }
    } else {
#pragma unroll
        for (int q = 0; q < 4; ++q) { const int n = (lane >> 2) + 16 * q, kq = lane & 3; const LAS float* sp = scr + (8 * kq) * 68 + n; float f[8];
#pragma unroll
            for (int j = 0; j < 8; ++j) f[j] = sp[j * 68];
            u32x4 o; o.x = cvt_pk_bf16(f[0], f[1]); o.y = cvt_pk_bf16(f[2], f[3]); o.z = cvt_pk_bf16(f[4], f[5]); o.w = cvt_pk_bf16(f[6], f[7]);
            *(u32x4*)(d.dst + (size_t)tdesc_row(d, d.n0 + n) * d.ldd + (size_t)(d.k0 + 8 * kq) * 2) = o; }
    }
    LDS_WAIT(); asm volatile("" ::: "memory");
}
template <class Gen>
__device__ __forceinline__ void titems_run(const Gen& gen, int first, int stride, int end, LAS float* scr, int lane) {
    for (int it = first; it < end; it += 4 * stride) {
        const bool h1 = it + stride < end, h2 = it + 2 * stride < end, h3 = it + 3 * stride < end;
        const TDesc d0 = gen(it), d1 = gen(h1 ? it + stride : it), d2 = gen(h2 ? it + 2 * stride : it), d3 = gen(h3 ? it + 3 * stride : it);
        f32x4 v0[8], v1[8], v2[8], v3[8];
        titem_load(d0, v0, lane); if (h1) titem_load(d1, v1, lane); if (h2) titem_load(d2, v2, lane); if (h3) titem_load(d3, v3, lane);
        titem_store(d0, v0, scr, lane); if (h1) titem_store(d1, v1, scr, lane); if (h2) titem_store(d2, v2, scr, lane); if (h3) titem_store(d3, v3, scr, lane);
    }
}
template <class RowMap>
__device__ __forceinline__ void transpose_item_fp8(const float* W, int N, int k0, int n0, unsigned char* dst, int ldd, LAS float* scr, int lane, RowMap rm, float scale) {
#pragma unroll 8
    for (int i = 0; i < 32; ++i) { const int kk = 2 * i + (lane >> 5); scr[kk * 33 + (lane & 31)] = W[(size_t)(k0 + kk) * N + n0 + (lane & 31)]; }
    LDS_WAIT(); asm volatile("" ::: "memory");
    const int c = lane & 7;
#pragma unroll
    for (int j = 0; j < 4; ++j) { const int n = (lane >> 3) + 8 * j; const LAS float* s = scr + (8 * c) * 33 + n;
        u32x2 o; o.x = cvt_pk4_fp8(s[0 * 33] * scale, s[1 * 33] * scale, s[2 * 33] * scale, s[3 * 33] * scale); o.y = cvt_pk4_fp8(s[4 * 33] * scale, s[5 * 33] * scale, s[6 * 33] * scale, s[7 * 33] * scale);
        *(u32x2*)(dst + (size_t)rm(n0 + n) * ldd + k0 + 8 * c) = o; }
    LDS_WAIT(); asm volatile("" ::: "memory");
}
template <class RowMap>
__device__ __forceinline__ void transpose_item(const float* W, int N, int k0, int n0, bf16_t* dst, int ldd, LAS float* scr, int lane, RowMap rm) {
#pragma unroll 8
    for (int i = 0; i < 32; ++i) { const int kk = 2 * i + (lane >> 5); scr[kk * 33 + (lane & 31)] = W[(size_t)(k0 + kk) * N + n0 + (lane & 31)]; }
    LDS_WAIT(); asm volatile("" ::: "memory");
    const int c = lane & 7;
#pragma unroll
    for (int j = 0; j < 4; ++j) { const int n = (lane >> 3) + 8 * j; const LAS float* s = scr + (8 * c) * 33 + n;
        u32x4 o; o.x = cvt_pk_bf16(s[0 * 33], s[1 * 33]); o.y = cvt_pk_bf16(s[2 * 33], s[3 * 33]); o.z = cvt_pk_bf16(s[4 * 33], s[5 * 33]); o.w = cvt_pk_bf16(s[6 * 33], s[7 * 33]);
        *(u32x4*)(dst + (size_t)rm(n0 + n) * ldd + k0 + 8 * c) = o; }
    LDS_WAIT(); asm volatile("" ::: "memory");
}
struct RmId { __device__ __forceinline__ int operator()(int n) const { return n; } };
struct RmWin { __device__ __forceinline__ int operator()(int n) const { const int sg = n >> 10, j = n & 1023;
    return sg == 0 ? 8 * (j >> 2) + (j & 3) : sg == 5 ? 8 * (j >> 2) + 4 + (j & 3) : sg == 6 ? 6144 + j : 1024 + n; } };
struct RmWin8 { __device__ __forceinline__ int operator()(int n) const { return RmWin{}(n) - 2048; } };
struct RmW13 { int which; __device__ __forceinline__ int operator()(int j) const { return 8 * (j >> 2) + 4 * which + (j & 3); } };

__device__ __forceinline__ void p0_prologue(const Frame& F, const Args& a) {
    unsigned char* ws = a.ws;
    LAS float* scr = (LAS float*)(F.lds + F.wave * 16384);
    const int gw = F.vcu * NWAVES + F.wave, NGW = F.G * NWAVES;
    bf16_t* win_t = (bf16_t*)(ws + WS_WIN); bf16_t* wout_t = (bf16_t*)(ws + WS_WOUT);
    constexpr int I_IN = (D / 32) * (NCOL / 64), I_OUT = (D / 32) * (D / 64);
    { const float* w_in = a.w_in; unsigned char* wsb_ = ws;
      auto gen = [=](int it) -> TDesc {
          TDesc d; const int nblk = NCOL / 64, kb = it / nblk, nb = it % nblk; const int sg = (64 * nb) >> 10; const bool bf = (sg == 0 || sg == 5);
          d.src = w_in; d.N = NCOL; d.k0 = 32 * kb; d.n0 = 64 * nb; d.dst = wsb_ + (bf ? WS_WIN : WS_WIN8); d.ldd = bf ? D * 2 : D; d.rmk = bf ? 1 : 2; d.which = 0; d.scale = bf ? 0.f : 32.0f;
          return d; };
      titems_run(gen, gw, NGW, I_IN, scr, F.lane); }
    { const float* w_out = a.w_out; unsigned char* wsb_ = ws;
      auto gen = [=](int it) -> TDesc {
          TDesc d; const int nblk = D / 64, kb = it / nblk, nb = it % nblk;
          d.src = w_out; d.N = D; d.k0 = 32 * kb; d.n0 = 64 * nb; d.dst = wsb_ + WS_WOUT; d.ldd = D * 2; d.rmk = 0; d.which = 0; d.scale = 0.f;
          return d; };
      titems_run(gen, gw, NGW, I_OUT, scr, F.lane); }
    bf16_t* xn = (bf16_t*)a.out;
    f32x4 gv[4];
#pragma unroll
    for (int j = 0; j < 4; ++j) gv[j] = *((const f32x4*)a.norm_mix_g + F.lane + 64 * j);
    for (int m = gw; m < T; m += NGW) {
        const f32x4* xr = (const f32x4*)(a.x + (size_t)m * D) + F.lane;
        f32x4 v[4]; float s = 0.f;
#pragma unroll
        for (int j = 0; j < 4; ++j) { v[j] = __builtin_nontemporal_load(xr + 64 * j); s += (v[j].x * v[j].x + v[j].y * v[j].y) + (v[j].z * v[j].z + v[j].w * v[j].w); }
        const float rms = sqrtf(wave_sum(s) * (1.f / D) + NORM_EPS), rs = 1.0f / rms;
        if (F.lane == 0) ((float*)(ws + WS_XRS))[m] = rms;
        u32x2* o8 = (u32x2*)(xn + (size_t)m * D) + F.lane;
#pragma unroll
        for (int j = 0; j < 4; ++j) { const f32x4 y = v[j] * rs * gv[j]; u32x2 w; w.x = cvt_pk_bf16(y.x, y.y); w.y = cvt_pk_bf16(y.z, y.w); o8[64 * j] = w;
            ((unsigned*)(ws + WS_XN8 + (size_t)m * D))[F.lane + 64 * j] = cvt_pk4_fp8(y.x, y.y, y.z, y.w); }
    }
    { bf16_t* rwh = (bf16_t*)(ws + WS_RW); bf16_t* rwl = rwh + 48 * D;
      for (int i = (blockIdx.x * NTHREADS + F.tid) * 2; i < 48 * D; i += F.G * NTHREADS * 2) {
          const int c = i >> 10, k = i & 1023; float v0 = 0.f, v1 = 0.f;
          if (c < 32) { v0 = a.norm_ffn_g[k] * a.w_er[((size_t)(c >> 3) * D + k) * 8 + (c & 7)]; v1 = a.norm_ffn_g[k + 1] * a.w_er[((size_t)(c >> 3) * D + k + 1) * 8 + (c & 7)]; }
          else if (c < 36) { v0 = a.norm_ffn_g[k] * a.w_gr[k * 4 + (c - 32)]; v1 = a.norm_ffn_g[k + 1] * a.w_gr[(k + 1) * 4 + (c - 32)]; }
          const unsigned hi = cvt_pk_bf16(v0, v1);
          *(unsigned*)(rwh + i) = hi; *(unsigned*)(rwl + i) = cvt_pk_bf16(v0 - bf_lo(hi), v1 - bf_hi(hi)); } }
    bf16_t* wsb = (bf16_t*)(ws + WS_WSB);
    for (int i = (blockIdx.x * NTHREADS + F.tid) * 2; i < 8 * 128 * 128; i += F.G * NTHREADS * 2) {
        const int s = i & 127, t = (i >> 7) & 127;
        const float v0 = (s <= t) ? a.w_spatial[i] : 0.f, v1 = (s + 1 <= t) ? a.w_spatial[i + 1] : 0.f;
        *(unsigned*)(wsb + i) = cvt_pk_bf16(v0, v1);
    }
}

constexpr int GM_WSL = 98304, GM_STAT = 90112;
__device__ __forceinline__ void gmlp_load_ws(const Frame& F, const Args& a, int g) {
    const bf16_t* wsb = (const bf16_t*)(a.ws + WS_WSB);
    for (int i = F.tid; i < 128 * 16; i += NTHREADS) { const int row = i >> 4, ch = i & 15; *(LAS u32x4*)(F.lds + GM_WSL + off_b(row, ch)) = *(const u32x4*)(wsb + ((size_t)g * 128 + row) * 128 + ch * 8); }
}
__device__ __forceinline__ void gmlp_chunk(const Frame& F, const Args& a, int row0, int g, const bool live) {
    asm volatile("" : "+s"(row0), "+s"(g));
    int tid_ = F.tid; asm volatile("" : "+v"(tid_));
    unsigned char* ws = a.ws;
    bf16_t* Ub = (bf16_t*)(ws + WS_U); const bf16_t* VG = (const bf16_t*)(ws + WS_VG);
    const f32x2* stats = (const f32x2*)(ws + WS_STAT);
    LAS unsigned char* VN = F.lds;
    LAS unsigned char* WSL = F.lds + GM_WSL;
    LAS float* MEAN = (LAS float*)(F.lds + GM_STAT); LAS float* RSTD = MEAN + 128;
    const int lane = tid_ & 63, wid = __builtin_amdgcn_readfirstlane(tid_ >> 6), r32 = lane & 31, hh = lane >> 5;
    const int mych = tid_ & 15;
    const f32x4 lg0 = *(const f32x4*)(a.ln_g + g * 128 + mych * 8), lg1 = *(const f32x4*)(a.ln_g + g * 128 + mych * 8 + 4);
    const f32x4 lb0 = *(const f32x4*)(a.ln_b + g * 128 + mych * 8), lb1 = *(const f32x4*)(a.ln_b + g * 128 + mych * 8 + 4);
    const int tt = wid >> 1, cp = wid & 1;
    const float bsp = a.b_spatial[g * 128 + tt * 32 + r32];
    __syncthreads();
    if (tid_ < 128) { const f32x2* sp = stats + (size_t)(row0 + tid_) * 16; float s1 = 0.f, s2 = 0.f;
#pragma unroll
        for (int j = 0; j < 16; ++j) { const f32x2 v = sp[j]; s1 += v.x; s2 += v.y; }
        const float mean = s1 * (1.f / 1024.f), var = s2 * (1.f / 1024.f) - mean * mean;
        MEAN[tid_] = mean; RSTD[tid_] = 1.0f / sqrtf(fmaxf(var, 0.f) + NORM_EPS); }
    __syncthreads();
#pragma unroll
    for (int it = 0; it < 4; ++it) { const int s = (tid_ >> 4) + 32 * it;
        const u32x4 raw = *(const u32x4*)(VG + (size_t)(row0 + s) * D + g * 128 + mych * 8);
        const float mu = MEAN[s], rs = RSTD[s];
        f32x4 x0 = (f32x4){bf_lo(raw.x), bf_hi(raw.x), bf_lo(raw.y), bf_hi(raw.y)}, x1 = (f32x4){bf_lo(raw.z), bf_hi(raw.z), bf_lo(raw.w), bf_hi(raw.w)};
        x0 = (x0 - mu) * rs * lg0 + lb0; x1 = (x1 - mu) * rs * lg1 + lb1;
        u32x4 w; w.x = cvt_pk_bf16(x0[0], x0[1]); w.y = cvt_pk_bf16(x0[2], x0[3]); w.z = cvt_pk_bf16(x1[0], x1[1]); w.w = cvt_pk_bf16(x1[2], x1[3]);
        *(LAS u32x4*)(VN + off_b(s, mych)) = w; }
    __syncthreads();
    f32x16 c0 = {}, c1 = {};
    const unsigned blk = (lane >> 4) & 1, q = (lane & 15) >> 2, p = lane & 3;
    for (int ks = 0; ks < 2 * (tt + 1); ++ks) {
        const bf16x8 bfrag = *(const LAS bf16x8*)(WSL + off_b(tt * 32 + r32, 2 * ks + hh));
        bf16x8 af[2];
#pragma unroll
        for (int ct = 0; ct < 2; ++ct) { const int cc = 2 * cp + ct;
            const s16x4 lo = lds_tr(VN + off_b(16 * ks + 8 * hh + q, 4 * cc + 2 * blk + (p >> 1)) + 8 * (p & 1));
            const s16x4 hi = lds_tr(VN + off_b(16 * ks + 8 * hh + 4 + q, 4 * cc + 2 * blk + (p >> 1)) + 8 * (p & 1));
            af[ct] = (bf16x8){lo[0], lo[1], lo[2], lo[3], hi[0], hi[1], hi[2], hi[3]}; }
        c0 = __builtin_amdgcn_mfma_f32_32x32x16_bf16(af[0], bfrag, c0, 0, 0, 0);
        c1 = __builtin_amdgcn_mfma_f32_32x32x16_bf16(af[1], bfrag, c1, 0, 0, 0);
    }
    const size_t rowoff = (size_t)(row0 + tt * 32 + r32) * D + g * 128;
#pragma unroll
    for (int ct = 0; ct < 2; ++ct)
#pragma unroll
        for (int gq = 0; gq < 4; ++gq) { const int c = 32 * (2 * cp + ct) + 8 * gq + 4 * hh;
            const u32x2 uu = *(const u32x2*)(Ub + rowoff + c);
            const f32x16& cc_ = ct ? c1 : c0;
            const float m0 = cc_[4 * gq + 0] + bsp, m1 = cc_[4 * gq + 1] + bsp, m2 = cc_[4 * gq + 2] + bsp, m3 = cc_[4 * gq + 3] + bsp;
            u32x2 o; o.x = cvt_pk_bf16(bf_lo(uu.x) * m0, bf_hi(uu.x) * m1); o.y = cvt_pk_bf16(bf_lo(uu.y) * m2, bf_hi(uu.y) * m3);
            if (live) *(u32x2*)(Ub + rowoff + c) = o; }
}

__constant__ unsigned char T5_BUCKET[128] = {0, 1, 2, 3, 4, 5, 6, 7, 8, 9, 10, 11, 12, 13, 14, 15, 16, 16, 16, 17, 17, 18, 18, 18, 19, 19, 19, 20, 20, 20, 20, 21, 21, 21, 21, 22, 22, 22, 22, 22, 23, 23, 23, 23, 23, 23, 24, 24, 24, 24, 24, 24, 25, 25, 25, 25, 25, 25, 25, 26, 26, 26, 26, 26, 26, 26, 26, 27, 27, 27, 27, 27, 27, 27, 27, 27, 27, 28, 28, 28, 28, 28, 28, 28, 28, 28, 28, 29, 29, 29, 29, 29, 29, 29, 29, 29, 29, 29, 29, 30, 30, 30, 30, 30, 30, 30, 30, 30, 30, 30, 30, 30, 30, 31, 31, 31, 31, 31, 31, 31, 31, 31, 31, 31, 31, 31, 31, 31};
constexpr int AT_KV = 0;
constexpr int AT_KMH = 65536, AT_KML = 73728, AT_TB = 81920;
__device__ __forceinline__ void attn_bh_tables(const Frame& F, const Args& a, int b, int h) {
    LAS unsigned char* lds = F.lds; const int tid = F.tid;
    const float* kpart = (const float*)(a.ws + WS_KPART);
    { const int n = tid >> 5, c4 = (tid & 31) * 4;
      const float* kp = kpart + ((size_t)(b * 16 + n) * 2) * D + h * HD + c4;
      const f32x4 s = (*(const f32x4*)kp + *(const f32x4*)(kp + D)) * (1.0f / 256.0f);
      u32x2 hi; hi.x = cvt_pk_bf16(s[0], s[1]); hi.y = cvt_pk_bf16(s[2], s[3]);
      const f32x4 rsd = (f32x4){s[0] - bf_lo(hi.x), s[1] - bf_hi(hi.x), s[2] - bf_lo(hi.y), s[3] - bf_hi(hi.y)};
      u32x2 lo; lo.x = cvt_pk_bf16(rsd[0], rsd[1]); lo.y = cvt_pk_bf16(rsd[2], rsd[3]);
      const unsigned o = off_b(n, c4 >> 3) + (c4 & 7) * 2, oz = off_b(n + 16, c4 >> 3) + (c4 & 7) * 2;
      *(LAS u32x2*)(lds + AT_KMH + o) = hi; *(LAS u32x2*)(lds + AT_KML + o) = lo;
      *(LAS u32x2*)(lds + AT_KMH + oz) = (u32x2){0u, 0u}; *(LAS u32x2*)(lds + AT_KML + oz) = (u32x2){0u, 0u};
#pragma unroll
      for (int i = 0; i < 3; ++i) { const int j = tid + 512 * i; const int d = 512 - j;
          if (j < 768) ((LAS float*)(lds + AT_TB))[j] = d < 0 ? -INFINITY : a.rel_bias[T5_BUCKET[d > 127 ? 127 : d] * NH + h] * LOG2E - 4.0f; else ((LAS float*)(lds + AT_TB))[j] = -INFINITY; } }
}
__device__ __forceinline__ void attn_unit(const Frame& F, const Args& a, int b, int h, int qb, const bool live) {
    unsigned char* ws = a.ws;
    const bf16_t* Qg = (const bf16_t*)(ws + WS_Q); const unsigned char* K8g = ws + WS_K; const unsigned char* VTg = ws + WS_VA;
    bf16_t* Zg = (bf16_t*)(ws + WS_U); const bf16_t* GBg = (const bf16_t*)(ws + WS_GB);
    const float* kpart = (const float*)(ws + WS_KPART);
    LAS unsigned char* lds = F.lds;
    int lane_ = F.lane, wid_ = F.wave; asm volatile("" : "+v"(lane_), "+s"(wid_));
    const int lane = lane_, wid = wid_, tid = wid * 64 + lane, r32 = lane & 31, hh = lane >> 5;
    const size_t tok_b = (size_t)b * SEQ;
    const int NT = 4 * (qb + 1);
#pragma unroll 1
    for (int cch = ((a.rep_mask >> 10) & 1) ? -2 : 0; cch < 2; ++cch) gmlp_chunk(F, a, (int)tok_b + qb * 256 + 128 * (cch & 1), h, live && cch >= 0);
    asm volatile("s_waitcnt vmcnt(0)" ::: "memory"); __builtin_amdgcn_fence(__ATOMIC_ACQ_REL, "workgroup");
    __syncthreads();
    const unsigned char* ksrc = K8g + (tok_b + 8 * wid + (lane >> 3)) * D + h * HD + 16 * ((lane & 7) ^ ((4 * wid + (lane >> 4)) & 7));
    const unsigned char* vsrc = VTg + (size_t)(b * 8 + h) * (64 * 8192) + (16 * wid + (lane >> 2)) * 64 + 16 * ((lane & 3) ^ ((lane >> 4) & 3));
#define AT_ISSUE(t) do { const int _bo = ((t) & 1) * 32768; \
        __builtin_amdgcn_global_load_lds((const unsigned*)(ksrc + (size_t)(t) * 64 * D), (LAS unsigned*)(lds + AT_KV + _bo + wid * 1024), 16, 0, 0); \
        __builtin_amdgcn_global_load_lds((const unsigned*)(vsrc + (size_t)(t) * 8192), (LAS unsigned*)(lds + AT_KV + _bo + 16384 + wid * 1024), 16, 0, 0); } while (0)
    AT_ISSUE(0);
    const int qi = wid * 32 + r32;
    const size_t qtok = tok_b + (size_t)qb * 256 + qi;
    pg8::i32x8_t q8[2];
    const float QS = 8.0f * 0.08838834764831845f * LOG2E;
    unsigned sel = 0u;
    { f32x16 gacc = {};
#pragma unroll
      for (int ks2 = 0; ks2 < 2; ++ks2) { bf16x8 qraw[4];
#pragma unroll
          for (int e = 0; e < 4; ++e) qraw[e] = *(const bf16x8*)(Qg + qtok * D + h * HD + 64 * ks2 + 32 * hh + 8 * e);
#pragma unroll
          for (int e = 0; e < 4; ++e) { const bf16x8 kh = *(const LAS bf16x8*)(lds + AT_KMH + off_b(r32, 8 * ks2 + 4 * hh + e)), kl = *(const LAS bf16x8*)(lds + AT_KML + off_b(r32, 8 * ks2 + 4 * hh + e));
              gacc = __builtin_amdgcn_mfma_f32_32x32x16_bf16(kh, qraw[e], gacc, 0, 0, 0); gacc = __builtin_amdgcn_mfma_f32_32x32x16_bf16(kl, qraw[e], gacc, 0, 0, 0); }
#pragma unroll
          for (int e = 0; e < 4; ++e) { const bf16x8 qq = qraw[e]; const u32x4 qw = __builtin_bit_cast(u32x4, qq);
              q8[ks2][2 * e] = (int)cvt_pk4_fp8(QS * bf_lo(qw.x), QS * bf_hi(qw.x), QS * bf_lo(qw.y), QS * bf_hi(qw.y)); q8[ks2][2 * e + 1] = (int)cvt_pk4_fp8(QS * bf_lo(qw.z), QS * bf_hi(qw.z), QS * bf_lo(qw.w), QS * bf_hi(qw.w)); } }
      float gv[16];
#pragma unroll
      for (int aa = 0; aa < 2; ++aa)
#pragma unroll
          for (int i = 0; i < 4; ++i) { const float own = gacc[4 * aa + i], oth = __shfl_xor(own, 32);
              gv[8 * aa + i] = hh ? oth : own; gv[8 * aa + 4 + i] = hh ? own : oth; }
#pragma unroll
      for (int n = 0; n < 16; ++n) if (n >= qb) gv[n] = -INFINITY;
#pragma unroll
      for (int k = 0; k < 3; ++k) { float best = -INFINITY; int bi = -1;
#pragma unroll
          for (int n = 0; n < 16; ++n) { const bool c = !((sel >> n) & 1u) && gv[n] > best; best = c ? gv[n] : best; bi = c ? n : bi; }
          if (bi >= 0) sel |= 1u << bi; } }
    const LAS float* TB = (const LAS float*)(lds + AT_TB);
    const float b31 = TB[512 - 127];
    const LAS float* tbl = TB + (512 - r32 + 4 * hh);
    f32x16 o[4]; o[0] = f32x16{}; o[1] = f32x16{}; o[2] = f32x16{}; o[3] = f32x16{};
    f32x16 o5 = f32x16{};
    const pg8::i32x8_t ones8 = {0x38383838, 0x38383838, 0x38383838, 0x38383838, 0x38383838, 0x38383838, 0x38383838, 0x38383838};
    pg8::i32x8_t p8 = {0, 0, 0, 0, 0, 0, 0, 0};
    f32x16 cbf = {};
    const unsigned kb0 = 128u * r32 + 16u * ((2u * hh) ^ ((r32 >> 1) & 7u));
    const unsigned vb0 = 64u * r32 + 16u * ((2u * hh) ^ ((r32 >> 2) & 3u));
    const int sc1 = 0x7f7f7f7f, scq = 0x7c7c7c7c;
#define AT_MMA_SEED(S, KF, QF) asm volatile("v_mfma_scale_f32_32x32x64_f8f6f4 %0, %1, %2, %5, %3, %4 op_sel_hi:[0,0,0]" : "=&v"(S) : "v"(KF), "v"(QF), "v"(sc1), "v"(scq), "v"(cbf))
#define AT_MMA_ACC(S, KF, QF) asm volatile("v_mfma_scale_f32_32x32x64_f8f6f4 %0, %1, %2, %0, %3, %4 op_sel_hi:[0,0,0]" : "+v"(S) : "v"(KF), "v"(QF), "v"(sc1), "v"(scq))
#define AT_SOFTMAX(S, HI) { float pr[16]; \
            _Pragma("unroll") for (int r = 0; r < 16; ++r) pr[r] = __builtin_amdgcn_exp2f(S[r]); \
            _Pragma("unroll") for (int w = 0; w < 8; ++w) p8[w] = HI ? __builtin_amdgcn_cvt_pk_fp8_f32(pr[w], pr[8 + w], p8[w], true) : __builtin_amdgcn_cvt_pk_fp8_f32(pr[w], pr[8 + w], p8[w], false); }
#define AT_TILE(FAST) { pg8::i32x8_t kf[4]; \
            _Pragma("unroll") for (int i = 0; i < 4; ++i) { const pg8::i32x4_t lo = *(const LAS pg8::i32x4_t*)(lds + (kb ^ (64u * (i & 1))) + (i >> 1) * 4096), hi = *(const LAS pg8::i32x4_t*)(lds + (kb ^ (64u * (i & 1)) ^ 16u) + (i >> 1) * 4096); \
                kf[i] = (pg8::i32x8_t){lo[0], lo[1], lo[2], lo[3], hi[0], hi[1], hi[2], hi[3]}; } \
            f32x16 s0, s1; \
            if (!(FAST)) { const LAS float* tp = tbl + (bfar == -INFINITY ? 768 : 0) + (kj0 - rel - wid * 32); \
                _Pragma("unroll") for (int r = 0; r < 16; ++r) s0[r] = tp[(r & 3) + 8 * (r >> 2)]; \
                _Pragma("unroll") for (int r = 0; r < 16; ++r) s1[r] = tp[32 + (r & 3) + 8 * (r >> 2)]; } \
            asm volatile("s_waitcnt lgkmcnt(0)\n\ts_nop 1" ::: "memory"); \
            if (FAST) { AT_MMA_SEED(s0, kf[0], q8[0]); } else { AT_MMA_ACC(s0, kf[0], q8[0]); } \
            AT_MMA_ACC(s0, kf[1], q8[1]); \
            if (FAST) { AT_MMA_SEED(s1, kf[2], q8[0]); } else { AT_MMA_ACC(s1, kf[2], q8[0]); } \
              \
            asm volatile("v_mfma_scale_f32_32x32x64_f8f6f4 %0, %2, %3, %0, %4, %5 op_sel_hi:[0,0,0]\n\ts_nop 7" : "+v"(s1), "+v"(s0) : "v"(kf[3]), "v"(q8[1]), "v"(sc1), "v"(scq)); \
              \
            pg8::i32x8_t vf[4]; \
            _Pragma("unroll") for (int dt = 0; dt < 4; ++dt) { const pg8::i32x4_t lo = *(const LAS pg8::i32x4_t*)(lds + vb + 2048 * dt), hi = *(const LAS pg8::i32x4_t*)(lds + (vb ^ 16u) + 2048 * dt); \
                vf[dt] = (pg8::i32x8_t){lo[0], lo[1], lo[2], lo[3], hi[0], hi[1], hi[2], hi[3]}; } \
            __builtin_amdgcn_sched_barrier(0); \
            AT_SOFTMAX(s0, false) \
            __builtin_amdgcn_sched_barrier(0); \
            AT_SOFTMAX(s1, true) \
            __builtin_amdgcn_sched_barrier(0); \
              \
            asm volatile("s_waitcnt lgkmcnt(0)\n\ts_nop 3" ::: "memory"); \
            _Pragma("unroll") for (int dt = 0; dt < 4; ++dt) \
                asm volatile("v_mfma_f32_32x32x64_f8f6f4 %0, %1, %2, %0" : "+v"(o[dt]) : "v"(p8), "v"(vf[dt])); \
            asm volatile("v_mfma_f32_32x32x64_f8f6f4 %0, %1, %2, %0" : "+v"(o5) : "v"(p8), "v"(ones8)); \
            __builtin_amdgcn_sched_barrier(0); }
#define AT_STEP(FAST) { \
        if (t + 1 < NT) { AT_ISSUE(t + 1); asm volatile("s_waitcnt vmcnt(2)" ::: "memory"); } else { asm volatile("s_waitcnt vmcnt(0)" ::: "memory"); } \
        __builtin_amdgcn_s_barrier(); asm volatile("" ::: "memory"); \
        const int n = t >> 2, kj0 = (t & 3) * 64; \
        unsigned kb = kb0 + AT_KV + (t & 1) * 32768, vb = vb0 + AT_KV + (t & 1) * 32768 + 16384; \
        asm volatile("" : "+v"(kb), "+v"(vb));                                    \
        const int rel = (n == qb) ? 0 : 256;                                      \
        const float bfar = (n == qb || ((sel >> n) & 1u)) ? b31 : -INFINITY;      \
        AT_TILE(FAST) \
        asm volatile("s_waitcnt lgkmcnt(0)" ::: "memory"); __builtin_amdgcn_s_barrier(); asm volatile("" ::: "memory"); }
    const int T1 = qb > 0 ? 4 * (qb - 1) : 0;
#pragma unroll 1
    for (int pass = (a.rep_mask >> 11) & 1; pass >= 0; --pass) {
    int t = 0;
#pragma unroll 1
    while (t < T1) {
        { const float bf = ((sel >> (t >> 2)) & 1u) ? b31 : -INFINITY;
#pragma unroll
          for (int r = 0; r < 16; ++r) cbf[r] = bf; }
#pragma unroll 1
        for (int j = 0; j < 4; ++j, ++t) AT_STEP(1)
    }
    asm volatile("s_nop 15\n\ts_nop 7" : "+v"(o[0]), "+v"(o[1]), "+v"(o[2]), "+v"(o[3]), "+v"(o5));
#pragma unroll 1
    for (; t < NT; ++t) AT_STEP(0)
    asm volatile("s_nop 15\n\ts_nop 7" : "+v"(o[0]), "+v"(o[1]), "+v"(o[2]), "+v"(o[3]), "+v"(o5));
    if (pass) { AT_ISSUE(0); }
    }
#undef AT_STEP
#undef AT_TILE
#undef AT_SOFTMAX
#undef AT_MMA_ACC
#undef AT_MMA_SEED
    asm volatile("s_nop 15\n\ts_nop 15" ::: "memory");
    { LAS unsigned char* stg = lds + AT_KV + wid * 8192;
#pragma unroll
      for (int r = 0; r < 16; ++r) { const int qrow = crow(r, hh); const float li = __builtin_amdgcn_rcpf(o5[r]);
#pragma unroll
          for (int dt = 0; dt < 4; ++dt) *(LAS bf16_t*)(stg + qrow * 256 + (32 * dt + r32) * 2) = (bf16_t)(cvt_pk_bf16(o[dt][r] * li, 0.f) & 0xffffu); }
      asm volatile("s_waitcnt lgkmcnt(0)" ::: "memory");
      const size_t rowbase = (tok_b + (size_t)qb * 256 + wid * 32) * D + h * HD;
#pragma unroll
      for (int i = 0; i < 8; ++i) { const int row = 4 * i + (lane >> 4), ch = lane & 15;
          const u32x4 yv = *(const LAS u32x4*)(stg + row * 256 + ch * 16);
          const size_t off = rowbase + (size_t)row * D + ch * 8;
          const u32x4 zv = *(const u32x4*)(Zg + off); const u32x2 g8 = *(const u32x2*)((const unsigned char*)GBg + off);
          u32x4 ov;
          { const f32x2 g0 = __builtin_amdgcn_cvt_pk_f32_fp8((int)g8.x, false), g1 = __builtin_amdgcn_cvt_pk_f32_fp8((int)g8.x, true), g2 = __builtin_amdgcn_cvt_pk_f32_fp8((int)g8.y, false), g3 = __builtin_amdgcn_cvt_pk_f32_fp8((int)g8.y, true);
            ov.x = cvt_pk_bf16(bf_lo(zv.x) + g0[0] * bf_lo(yv.x), bf_hi(zv.x) + g0[1] * bf_hi(yv.x)); ov.y = cvt_pk_bf16(bf_lo(zv.y) + g1[0] * bf_lo(yv.y), bf_hi(zv.y) + g1[1] * bf_hi(yv.y));
            ov.z = cvt_pk_bf16(bf_lo(zv.z) + g2[0] * bf_lo(yv.z), bf_hi(zv.z) + g2[1] * bf_hi(yv.z)); ov.w = cvt_pk_bf16(bf_lo(zv.w) + g3[0] * bf_lo(yv.w), bf_hi(zv.w) + g3[1] * bf_hi(yv.w)); }
          if (live) *(u32x4*)(Zg + off) = ov; }
      asm volatile("s_waitcnt lgkmcnt(0)" ::: "memory"); }
#undef AT_ISSUE
}
__device__ __forceinline__ void p3_attention(const Frame& F, const Args& a, const bool live) {
    for (int v = F.vcu; v < 256; v += F.G) {
        const int bh = v >> 3, s = v & 7;
        __syncthreads(); gmlp_load_ws(F, a, bh & 7); attn_bh_tables(F, a, bh >> 3, bh & 7);
#pragma unroll 1
        for (int uu = 0; uu < 2; ++uu) attn_unit(F, a, bh >> 3, bh & 7, uu ? s : 15 - s, live);
    }
}

constexpr int P5_CTR_OFF = MISC_OFF + 256;
__device__ __forceinline__ void p5_router(const Frame& F, const Args& a, const bool live) {
    unsigned char* ws = a.ws;
    const int lane = F.lane, wid = F.wave;
    const float* lpart = (const float*)(ws + WS_LPART); const float* ssqp = (const float*)(ws + WS_SSQ);
    unsigned* cnt = (unsigned*)(ws + WS_CTL) + CW_CNT; int* list = (int*)(ws + WS_LIST); int* inv = (int*)(ws + WS_INV); float* wtok = (float*)(ws + WS_WTOK); float* rsp = (float*)(ws + WS_RSP);
    LAS unsigned* ctr = (LAS unsigned*)(F.lds + P5_CTR_OFF);
    if (F.tid == 0) *ctr = 0u;
    __syncthreads();
    if (wid < 4) {
        LAS float* scr = (LAS float*)(F.lds + wid * 16384 + 8704);
        for (int tile = F.vcu * 4 + wid; tile < T / 16; tile += F.G * 4) {
        const int row0 = tile * 16, r = lane & 15, kq = lane >> 4;
        const float* lp = lpart + ((size_t)kq * T + row0 + r) * 48;
        f32x4 pv[12];
#pragma unroll
        for (int i = 0; i < 12; ++i) pv[i] = *(const f32x4*)(lp + 4 * i);
        float ssq = ssqp[(size_t)kq * T + row0 + r];
#pragma unroll
        for (int i = 0; i < 12; ++i)
#pragma unroll
            for (int j = 0; j < 4; ++j) { float v = pv[i][j]; v += __shfl_xor(v, 16); v += __shfl_xor(v, 32); pv[i][j] = v; }
        ssq += __shfl_xor(ssq, 16); ssq += __shfl_xor(ssq, 32);
        const float rs = 1.0f / sqrtf(ssq * (1.f / D) + NORM_EPS);
        if (kq == 0) {
#pragma unroll
            for (int i = 0; i < 12; ++i)
#pragma unroll
                for (int j = 0; j < 4; ++j) scr[r * 49 + 4 * i + j] = pv[i][j]; }
        LDS_WAIT(); asm volatile("" ::: "memory");
        if (lane < 16) {
            const LAS float* lr = scr + lane * 49;
            float gl[4];
#pragma unroll
            for (int g = 0; g < 4; ++g) gl[g] = lr[32 + g] * rs + a.b_gr[g];
            int gi = 0; float gm = gl[0];
#pragma unroll
            for (int g = 1; g < 4; ++g) if (gl[g] > gm) { gm = gl[g]; gi = g; }
            float den = 0.f;
#pragma unroll
            for (int g = 0; g < 4; ++g) den += __expf(gl[g] - gm);
            const float g_w = 1.0f / den;
            float el[8];
#pragma unroll
            for (int e = 0; e < 8; ++e) el[e] = lr[gi * 8 + e] * rs + a.b_er[gi * 8 + e];
            int e0 = 0; float v0 = el[0];
#pragma unroll
            for (int e = 1; e < 8; ++e) if (el[e] > v0) { v0 = el[e]; e0 = e; }
            int e1 = -1; float v1 = -INFINITY;
#pragma unroll
            for (int e = 0; e < 8; ++e) if (e != e0 && el[e] > v1) { v1 = el[e]; e1 = e; }
            const float x1 = __expf(v1 - v0), w0f = g_w / (1.0f + x1), w1f = g_w * x1 / (1.0f + x1);
            if (live) { const int m = row0 + lane;
                const int ex0 = gi * 8 + e0, ex1 = gi * 8 + e1;
                const unsigned p0 = __hip_atomic_fetch_add(cnt + 64 * ex0, 1u, __ATOMIC_RELAXED, __HIP_MEMORY_SCOPE_AGENT);
                const unsigned p1 = __hip_atomic_fetch_add(cnt + 64 * ex1, 1u, __ATOMIC_RELAXED, __HIP_MEMORY_SCOPE_AGENT);
                list[ex0 * LCAP + p0] = m * 2; list[ex1 * LCAP + p1] = m * 2 + 1;
                rsp[ex0 * LCAP + p0] = rs; rsp[ex1 * LCAP + p1] = rs;
                *(int2*)(inv + m * 2) = make_int2(ex0 * LCAP + (int)p0, ex1 * LCAP + (int)p1); *(float2*)(wtok + m * 2) = make_float2(w0f, w1f); }
        }
        LDS_WAIT(); asm volatile("" ::: "memory");
        }
    }
    { LAS float* tscr = (LAS float*)(F.lds + wid * 16384);
      const float* w1 = a.w1; const float* w3 = a.w3; const float* w2 = a.w2; unsigned char* w13 = ws + WS_W13; unsigned char* w2t = ws + WS_W2;
      constexpr int I13 = (D / 32) * (DEXP / 64), I2 = (DEXP / 32) * (D / 64), IPE = 2 * I13 + I2;
      auto gen = [=](int it) -> TDesc {
          TDesc d; const int e = it / IPE; int r = it % IPE;
          if (r < 2 * I13) { const int which = r / I13; r %= I13; const int kb = r / (DEXP / 64), nb = r % (DEXP / 64);
              d.src = (which ? w3 : w1) + (size_t)e * D * DEXP; d.N = DEXP; d.k0 = 32 * kb; d.n0 = 64 * nb; d.dst = w13 + (size_t)e * 512 * D; d.ldd = D; d.rmk = 3; d.which = which; d.scale = 32.0f; }
          else { r -= 2 * I13; const int kb = r / (D / 64), nb = r % (D / 64);
              d.src = w2 + (size_t)e * DEXP * D; d.N = D; d.k0 = 32 * kb; d.n0 = 64 * nb; d.dst = w2t + (size_t)e * D * DEXP; d.ldd = DEXP; d.rmk = 0; d.which = 0; d.scale = 16.0f; }
          return d; };
      const int per_wg = (NEXP * IPE + F.G - 1) / F.G;
      const int base = F.vcu * per_wg;
      const int q4 = per_wg / 8;
      const int restw = (per_wg - 4 * q4 + 3) / 4;
      const int lo_ = wid < 4 ? wid * q4 : 4 * q4 + (wid - 4) * restw;
      int hi_ = wid < 4 ? lo_ + q4 : lo_ + restw; if (hi_ > per_wg) hi_ = per_wg;
      int endi = base + hi_; if (endi > NEXP * IPE) endi = NEXP * IPE;
      titems_run(gen, base + lo_, 1, endi, tscr, lane); }
    __syncthreads();
}

__device__ __forceinline__ void p8_final(const Frame& F, const Args& a, const bool live) {
    const int gw = F.vcu * NWAVES + F.wave, NGW = F.G * NWAVES, lane = F.lane;
    const unsigned char* yp = a.ws + WS_YP;
    const LAS int* pref = (const LAS int*)(F.lds + PREF_OFF);
    f32x4 gv[4];
#pragma unroll
    for (int j = 0; j < 4; ++j) gv[j] = *((const f32x4*)a.norm_final_g + lane + 64 * j);
    for (int m = gw; m < T; m += NGW) {
        f32x4* xr = (f32x4*)(a.out + (size_t)m * D) + lane;
        const u32x2* hr = (const u32x2*)((const bf16_t*)(a.ws + WS_HB) + (size_t)m * D) + lane;
        const int2 iv = *(const int2*)((const int*)(a.ws + WS_INV) + m * 2); const float2 wv = *(const float2*)((const float*)(a.ws + WS_WTOK) + m * 2);
        const int pr0 = 256 * pref[iv.x >> 14] + (iv.x & (LCAP - 1)), pr1 = 256 * pref[iv.y >> 14] + (iv.y & (LCAP - 1));
        const unsigned* y0 = (const unsigned*)(yp + (size_t)pr0 * D) + lane; const unsigned* y1 = (const unsigned*)(yp + (size_t)pr1 * D) + lane;
        const float w0 = wv.x * (1.0f / 16.0f), w1 = wv.y * (1.0f / 16.0f);
        f32x4 v[4]; float s = 0.f;
#pragma unroll
        for (int j = 0; j < 4; ++j) { const unsigned p0 = y0[64 * j], p1 = y1[64 * j];
            const f32x2 a0 = __builtin_amdgcn_cvt_pk_f32_fp8((int)p0, false), a1 = __builtin_amdgcn_cvt_pk_f32_fp8((int)p0, true), b0 = __builtin_amdgcn_cvt_pk_f32_fp8((int)p1, false), b1 = __builtin_amdgcn_cvt_pk_f32_fp8((int)p1, true);
            const u32x2 hb = hr[64 * j];
            v[j] = (f32x4){bf_lo(hb.x), bf_hi(hb.x), bf_lo(hb.y), bf_hi(hb.y)} + (f32x4){w0 * a0[0] + w1 * b0[0], w0 * a0[1] + w1 * b0[1], w0 * a1[0] + w1 * b1[0], w0 * a1[1] + w1 * b1[1]};
            s += (v[j].x * v[j].x + v[j].y * v[j].y) + (v[j].z * v[j].z + v[j].w * v[j].w); }
        const float rs = 1.0f / sqrtf(wave_sum(s) * (1.f / D) + NORM_EPS);
#pragma unroll
        for (int j = 0; j < 4; ++j) if (live) xr[64 * j] = v[j] * rs * gv[j];
    }
}

constexpr int N_PHASES = 9;
__global__ void __launch_bounds__(NTHREADS, 2) mk_fwd(Args args) {
    extern __shared__ __attribute__((aligned(16))) unsigned char lds_raw[];
#define MKFRAME() Frame F; { unsigned l_ = __builtin_amdgcn_mbcnt_hi(~0u, __builtin_amdgcn_mbcnt_lo(~0u, 0u)); asm volatile("" : "+v"(l_)); F.lds = (LAS unsigned char*)lds_raw; F.lane = (int)l_; F.wave = wave0; F.tid = wave0 * 64 + F.lane; \
        F.G = gridDim.x; const int bx_ = blockIdx.x; F.vcu = (F.G % 8 == 0) ? (bx_ % 8) * (F.G / 8) + bx_ / 8 : bx_; }
    LAS unsigned char* const lds0 = (LAS unsigned char*)lds_raw;
    const int wave0 = __builtin_amdgcn_readfirstlane((int)(threadIdx.x >> 6));
    unsigned char* ws = args.ws;
    unsigned* ctl = (unsigned*)(ws + WS_CTL);
    if (threadIdx.x < 64) ((LAS unsigned*)(lds0 + MISC_OFF))[threadIdx.x] = 0u;
    __syncthreads();
    const int lo = args.ph_lo, hi = args.ph_hi, repm = args.rep_mask;
    XcdBarrier bar; bar.bar = ctl + CW_BAR; bar.x = 0; bar.st = nullptr;
    bar = xcd_barrier_post(ctl + CW_BAR, (volatile LAS unsigned*)(lds0 + MISC_OFF));
#ifndef PHASE_MASK
#define PHASE_MASK 0x1ff
#endif
#define IN(k) (((PHASE_MASK >> (k)) & 1) && lo <= (k) && (k) < hi)
#define SEAM(k) do { if (IN(k) && IN((k) + 1)) xcd_barrier(bar); } while (0)
#define REP(k) _Pragma("unroll 1") for (int rep_ = ((repm >> (k)) & 1); rep_ >= 0; --rep_)
#define LIVE (rep_ == 0)

    if (IN(0)) { REP(0) { MKFRAME(); const Args a = load_args(); p0_prologue(F, a); } SEAM(0); }
    if (IN(1)) { REP(1) {
        { MKFRAME(); const Args args = load_args();
          pg8::StaticOrder S; S.init((const bf16_t*)args.out, (const bf16_t*)(ws + WS_WIN), T, 2048, D, F.G, (int)blockIdx.x);
          EpiInProj E{(bf16_t*)(ws + WS_U), args.b_gates, (float*)(ws + WS_KPART), (f32x2*)(ws + WS_STAT), 0};
          pg8::gemm_phase<EpiInProj, pg8::StaticOrder, false, D>(F.lds, F.tid, S, E, nullptr); }
        { MKFRAME(); const Args args = load_args();
          pg8::StaticOrder S; S.init((const bf16_t*)(ws + WS_XN8), (const bf16_t*)(ws + WS_WIN8), T, 5120, D / 2, F.G, (int)blockIdx.x);
          EpiInProj E{(bf16_t*)(ws + WS_U), args.b_gates, (float*)(ws + WS_KPART), (f32x2*)(ws + WS_STAT), 8};
          pg8::gemm_phase<EpiInProj, pg8::StaticOrder, false, D / 2, 0x7a>(F.lds, F.tid, S, E, nullptr); } }
        SEAM(1);
    }
    if (IN(3)) { REP(3) { MKFRAME(); const Args a = load_args(); p3_attention(F, a, LIVE); } SEAM(3); }
    if (IN(4)) { REP(4) {
        MKFRAME(); const Args args = load_args();
        pg8::StaticOrder S; S.init((const bf16_t*)(ws + WS_U), (const bf16_t*)(ws + WS_WOUT), T, D, D, F.G, (int)blockIdx.x);
        EpiOutProj E{(const bf16_t*)args.out, (const float*)(ws + WS_XRS), args.norm_mix_g, (bf16_t*)(ws + WS_HB), args.norm_ffn_g, ws + WS_XN2, (const bf16_t*)(ws + WS_RW), (float*)(ws + WS_LPART), (float*)(ws + WS_SSQ), F.lds + RED_OFF};
        pg8::gemm_phase<EpiOutProj, pg8::StaticOrder, false, D>(F.lds, F.tid, S, E, nullptr); }
        SEAM(4);
    }
    if (IN(5)) { REP(5) { MKFRAME(); const Args a = load_args(); p5_router(F, a, LIVE); } SEAM(5); }
    if (IN(6) || IN(7) || IN(8)) {
        if (threadIdx.x == 0) { LAS int* pref = (LAS int*)(lds0 + PREF_OFF); int acc = 0;
            for (int e = 0; e < NEXP; ++e) { pref[e] = acc; const int c = (int)__hip_atomic_load(ctl + CW_CNT + 64 * e, __ATOMIC_RELAXED, __HIP_MEMORY_SCOPE_AGENT); acc += (c + 255) >> 8; }
            pref[NEXP] = acc; }
        __syncthreads();
    }
    if (IN(6)) { REP(6) {
        typedef pg8::MoeOrder<2, 0, (size_t)512 * D, (size_t)256 * D, D> Ord1;
        typedef pg8::MoeOrder<4, (size_t)256 * DEXP, (size_t)D * DEXP, (size_t)256 * DEXP, 0> Ord2;
        const int G = gridDim.x, total = __builtin_amdgcn_readfirstlane(((const LAS int*)(lds0 + PREF_OFF))[NEXP]);
        const int n1 = 2 * total, r = n1 > G ? n1 - G : 0, early = (n1 > G ? G : n1) / 2;
#pragma unroll 1
        for (int stage = 0; stage < 2; ++stage) {
            MKFRAME();
            Ord1 S; S.pref = (const LAS int*)(F.lds + PREF_OFF); S.c = (int)blockIdx.x; S.A = (const char*)(ws + WS_XN2); S.Bt = (const char*)(ws + WS_W13); S.list = (const int*)(ws + WS_LIST);
            S.first = stage == 0 ? 0 : 2 * early; S.limit = stage == 0 ? 2 * early : n1; S.cbase = 0; S.nwg = stage == 0 ? G : (r > 0 ? r : 1);
            EpiMoe1 E{ws + WS_HID, (const float*)(ws + WS_RSP), ctl + CW_CNT};
            pg8::gemm_phase<EpiMoe1, Ord1, true, D / 2, 0x7a>(F.lds, F.tid, S, E, ctl + CW_CNT);
            if (stage == 0) xcd_barrier(bar);
        }
#pragma unroll 1
        for (int stage = 1; stage < 3; ++stage) {
            MKFRAME();
            Ord2 S; S.pref = (const LAS int*)(F.lds + PREF_OFF); S.c = (int)blockIdx.x; S.A = (const char*)(ws + WS_HID); S.Bt = (const char*)(ws + WS_W2); S.list = (const int*)(ws + WS_LIST);
            S.first = stage == 2 ? 4 * early : 0; S.limit = stage == 1 ? 4 * early : 4 * total; S.cbase = stage == 1 ? r : 0; S.nwg = stage == 1 ? G - r : G;
            EpiMoe2 E{ws + WS_YP};
            pg8::gemm_phase<EpiMoe2, Ord2, false, DEXP / 2, 0x7b>(F.lds, F.tid, S, E, nullptr);
            if (stage == 1) xcd_barrier(bar);
        } }
        SEAM(6);
    }
    if (IN(8)) { REP(8) { MKFRAME(); const Args a = load_args(); p8_final(F, a, LIVE); } }
#undef IN
#undef SEAM
#undef REP
#undef LIVE
}

#ifndef MK_REP_MASK
#define MK_REP_MASK 0x000
#endif
#ifndef MK_SPLIT
#define MK_SPLIT 0
#endif
extern "C" void kernel_launch(void* const* d_in, const int* in_sizes, int n_in, void* d_out, int out_size, void* d_ws, size_t ws_size, hipStream_t stream) {
    static int grid = 0;
    if (grid == 0) {
        if (n_in != 19 || out_size != T * D || ws_size < WS_END) { fprintf(stderr, "kernel_launch: unexpected problem (n_in %d, out %d, ws %zu)\n", n_in, out_size, ws_size); grid = -1; return; }
        int dev = 0, cus = 0, per_cu = 0;
        if (hipGetDevice(&dev) != hipSuccess || hipDeviceGetAttribute(&cus, hipDeviceAttributeMultiprocessorCount, dev) != hipSuccess) { grid = -1; return; }
        if (hipFuncSetAttribute((const void*)mk_fwd, hipFuncAttributeMaxDynamicSharedMemorySize, LDS_BYTES) != hipSuccess) { fprintf(stderr, "kernel_launch: hipFuncSetAttribute failed\n"); grid = -1; return; }
        if (hipOccupancyMaxActiveBlocksPerMultiprocessor(&per_cu, (const void*)mk_fwd, NTHREADS, LDS_BYTES) != hipSuccess || per_cu < 1) fprintf(stderr, "kernel_launch: occupancy query reports %d\n", per_cu);
        (void)hipGetLastError();
        grid = cus;
    }
    if (grid < 0) return;
    if (hipMemsetAsync((char*)d_ws + WS_CTL, 0, CTL_ZERO_BYTES, stream) != hipSuccess) return;
    Args a{};
    a.x = (const float*)d_in[0]; a.norm_mix_g = (const float*)d_in[1]; a.w_in = (const float*)d_in[2]; a.b_gates = (const float*)d_in[3]; a.ln_g = (const float*)d_in[4]; a.ln_b = (const float*)d_in[5];
    a.w_spatial = (const float*)d_in[6]; a.b_spatial = (const float*)d_in[7]; a.rel_bias = (const float*)d_in[8]; a.w_out = (const float*)d_in[9]; a.norm_ffn_g = (const float*)d_in[10];
    a.w_gr = (const float*)d_in[11]; a.b_gr = (const float*)d_in[12]; a.w_er = (const float*)d_in[13]; a.b_er = (const float*)d_in[14]; a.w1 = (const float*)d_in[15]; a.w3 = (const float*)d_in[16]; a.w2 = (const float*)d_in[17];
    a.norm_final_g = (const float*)d_in[18]; a.out = (float*)d_out; a.ws = (unsigned char*)d_ws; a.rep_mask = MK_REP_MASK; a.pad = 0;
#if MK_SPLIT
    for (int p = 0; p < N_PHASES; ++p) { a.ph_lo = p; a.ph_hi = p + 1; hipLaunchKernelGGL(mk_fwd, dim3(grid), dim3(NTHREADS), LDS_BYTES, stream, a); }
#else
    a.ph_lo = 0; a.ph_hi = N_PHASES; hipLaunchKernelGGL(mk_fwd, dim3(grid), dim3(NTHREADS), LDS_BYTES, stream, a);
#endif
}
```

```cpp
#include <hip/hip_runtime.h>
#include <cstdio>
#include <cstdint>

#define LAS __attribute__((address_space(3)))
#define GAS __attribute__((address_space(1)))
typedef unsigned short bf16_t;
typedef short bf16x8 __attribute__((ext_vector_type(8)));
typedef short s16x4 __attribute__((ext_vector_type(4)));
typedef float f32x4 __attribute__((ext_vector_type(4)));
typedef float f32x2 __attribute__((ext_vector_type(2)));
typedef float f32x16 __attribute__((ext_vector_type(16)));
typedef unsigned u32x4 __attribute__((ext_vector_type(4)));
typedef unsigned u32x2 __attribute__((ext_vector_type(2)));

constexpr int T = 16384, D = 1024, NCOL = 7168, SEQ = 4096, NBATCH = 4, NH = 8, HD = 128;
constexpr int NEXP = 32, DEXP = 256, LCAP = 16384;
constexpr float NORM_EPS = 1e-6f;
constexpr float LOG2E = 1.4426950408889634f;
constexpr int NWAVES = 8, NTHREADS = 512;

constexpr size_t MiB = 1u << 20;
constexpr size_t WS_CTL = 0, CTL_ZERO_BYTES = 1 * MiB;
constexpr size_t WS_WIN = 1 * MiB;
constexpr size_t WS_WIN8 = 5 * MiB;
constexpr size_t WS_XN8 = 212 * MiB;
constexpr size_t WS_WOUT = 15 * MiB;
constexpr size_t WS_WSB = 17 * MiB;
constexpr size_t WS_KPART = 17 * MiB + 256 * 1024;
constexpr size_t WS_RW = 17 * MiB + 768 * 1024;
constexpr size_t WS_LPART = 100 * MiB;
constexpr size_t WS_SSQ = 113 * MiB;
constexpr size_t WS_STAT = 18 * MiB;
constexpr size_t WS_U = 20 * MiB;
constexpr size_t SEG_BYTES = 32 * MiB;
constexpr size_t WS_VG = WS_U + SEG_BYTES, WS_Q = WS_U + 2 * SEG_BYTES, WS_K = WS_U + 3 * SEG_BYTES, WS_VA = WS_U + 4 * SEG_BYTES, WS_GB = WS_U + 5 * SEG_BYTES;
constexpr size_t WS_XN2 = 52 * MiB;
constexpr size_t WS_W13 = 84 * MiB;
constexpr size_t WS_W2 = 116 * MiB;
constexpr size_t WS_HID = 132 * MiB;
constexpr size_t WS_YP = 152 * MiB;
constexpr size_t WS_LIST = 232 * MiB;
constexpr size_t WS_INV = 234 * MiB;
constexpr size_t WS_WTOK = 235 * MiB;
constexpr size_t WS_RSP = 236 * MiB;
constexpr size_t WS_XRS = 228 * MiB;
constexpr size_t WS_HB = 192 * MiB;
constexpr size_t WS_END = 238 * MiB;
constexpr int CW_BAR = 4096;
constexpr int CW_CNT = 8192;
constexpr int CW_PANEL = 16384;

constexpr int RING_BYTES = 131072;
constexpr int MISC_OFF = RING_BYTES;
constexpr int PREF_OFF = MISC_OFF + 64;
constexpr int LDS_BYTES = 163840;
constexpr int RED_OFF = MISC_OFF + 4096, RED_BYTES = 64 * 52 * 4;

typedef __bf16 bf16x2_t __attribute__((ext_vector_type(2)));
__device__ __forceinline__ unsigned cvt_pk_bf16(float lo, float hi) { const f32x2 v = {lo, hi}; const bf16x2_t b = __builtin_convertvector(v, bf16x2_t); return __builtin_bit_cast(unsigned, b); }
__device__ __forceinline__ unsigned cvt_pk4_fp8(float a, float b, float c, float d) { unsigned w = 0u; w = (unsigned)__builtin_amdgcn_cvt_pk_fp8_f32(a, b, (int)w, false); w = (unsigned)__builtin_amdgcn_cvt_pk_fp8_f32(c, d, (int)w, true); return w; }
__device__ __forceinline__ float bf_lo(unsigned w) { return __uint_as_float(w << 16); }
__device__ __forceinline__ float bf_hi(unsigned w) { return __uint_as_float(w & 0xffff0000u); }
__device__ __forceinline__ float wave_sum(float v) {
#pragma unroll
    for (int o = 1; o < 64; o <<= 1) v += __shfl_xor(v, o);
    return v;
}
#define LDS_WAIT() asm volatile("s_waitcnt lgkmcnt(0)" ::: "memory")
#define VM_WAIT() asm volatile("s_waitcnt vmcnt(0)" ::: "memory")

#define XB_TMO      128
#define XB_XCNT(j)  (256  + 64 * (j))
#define XB_XSUB(j)  (1280 + 64 * (j))
#define XB_XGEN(j)  (2304 + 64 * (j))
#define XB_TOP      3328
#define XB_TOPGEN   3392
#define XCD_BAR_WORDS 3456
#define XB_SPIN_CAP (1u << 18)
__device__ __forceinline__ unsigned xb_ld(unsigned* p)              { return __hip_atomic_load(p, __ATOMIC_RELAXED, __HIP_MEMORY_SCOPE_AGENT); }
__device__ __forceinline__ unsigned xb_add(unsigned* p, unsigned v) { return __hip_atomic_fetch_add(p, v, __ATOMIC_RELAXED, __HIP_MEMORY_SCOPE_AGENT); }
__device__ __forceinline__ unsigned xb_xcc_id() { return (unsigned)__builtin_amdgcn_s_getreg((3 << 11) | 20) & 0xFu; }
#define XB_SPIN(cond, bar) do { unsigned _sp = 0; while (cond) { __builtin_amdgcn_s_sleep(1); \
    if ((++_sp & 255u) == 0u) { if (xb_ld(&(bar)[XB_TMO])) break; if (_sp > XB_SPIN_CAP) { atomicAdd(&(bar)[XB_TMO], 1u); break; } } } } while (0)
struct XcdBarrier { unsigned* bar; unsigned x; volatile LAS unsigned* st; };
__device__ __forceinline__ XcdBarrier xcd_barrier_post(unsigned* bar, volatile LAS unsigned* st) {
    XcdBarrier b; b.bar = bar; b.x = xb_xcc_id(); b.st = st;
    if (threadIdx.x == 0) (void)xb_add(&bar[XB_XCNT(b.x)], 1u);
    return b;
}
__device__ __forceinline__ void xcd_barrier_complete(unsigned* bar, unsigned x, unsigned& nloc, unsigned& nx) {
    const unsigned G = gridDim.x * gridDim.y * gridDim.z;
    unsigned sum, cnt, mine, sp = 0u;
    for (;;) {
        sum = 0u; cnt = 0u; mine = 0u;
#pragma unroll
        for (unsigned j = 0; j < 16; ++j) { const unsigned c = xb_ld(&bar[XB_XCNT(j)]); sum += c; cnt += (c > 0u) ? 1u : 0u; mine = (j == x) ? c : mine; }
        if (sum == G) break;
        __builtin_amdgcn_s_sleep(1);
        if ((++sp & 255u) == 0u) { if (xb_ld(&bar[XB_TMO])) break; if (sp > XB_SPIN_CAP) { atomicAdd(&bar[XB_TMO], 1u); break; } }
    }
    nloc = mine > 0u ? mine : 1u; nx = cnt > 0u ? cnt : 1u;
}
__device__ __forceinline__ void xcd_barrier(const XcdBarrier& b) {
    asm volatile("s_waitcnt vmcnt(0)" ::: "memory");
    __syncthreads();
    if (threadIdx.x == 0) {
        unsigned* bar = b.bar;
        __builtin_amdgcn_s_waitcnt(0);
        unsigned nloc = b.st[0], nx = b.st[1];
        if (nloc == 0u) { xcd_barrier_complete(bar, b.x, nloc, nx); b.st[0] = nloc; b.st[1] = nx; }
        const unsigned old = xb_add(&bar[XB_XSUB(b.x)], 1u);
        const unsigned gen = old / nloc;
        if (old + 1u == (gen + 1u) * nloc) {
            __builtin_amdgcn_fence(__ATOMIC_RELEASE, "agent");
            asm volatile("s_waitcnt vmcnt(0)" ::: "memory");
            const unsigned og = xb_add(&bar[XB_TOP], 1u);
            const unsigned tg = og / nx;
            if (og + 1u == (tg + 1u) * nx) xb_add(&bar[XB_TOPGEN], 1u);
            else XB_SPIN(xb_ld(&bar[XB_TOPGEN]) == tg, bar);
            __builtin_amdgcn_fence(__ATOMIC_ACQUIRE, "agent");
            xb_add(&bar[XB_XGEN(b.x)], 1u);
            asm volatile("s_waitcnt vmcnt(0)" ::: "memory");
        } else {
            XB_SPIN(xb_ld(&bar[XB_XGEN(b.x)]) == gen, bar);
            __builtin_amdgcn_fence(__ATOMIC_ACQUIRE, "agent");
            asm volatile("s_waitcnt vmcnt(0)" ::: "memory");
        }
    }
    __syncthreads();
}

namespace pg8 {
constexpr int BM = 256, BK = 64, HALF = 128, HTB = HALF * BK * 2, STAGE_BYTES = 8 * HTB, NXCD = 8, WGM = 8;
__host__ __device__ __forceinline__ int lds_byte(int r, int c) { const int st = (r >> 4) * 2 + (c >> 5), rr = r & 15, cc = c & 31, ob = rr * 64 + cc * 2; return st * 1024 + (ob ^ (((ob >> 9) & 1) << 5)); }
__host__ __device__ __forceinline__ void stage_rc(int b, int& R, int& C) { const int st = b / 1024, sb = b % 1024, swz = sb ^ (((sb >> 9) & 1) << 5); R = (st >> 1) * 16 + swz / 64; C = (st & 1) * 32 + (swz % 64) / 2; }
__host__ __device__ __forceinline__ int perm32(int rho) { const int n = rho >> 4, i = rho & 15; return 8 * (i >> 2) + 4 * n + (i & 3); }

struct Unit { int pm, pn, ex, rt; };

struct StaticOrder {
    int nM, nN, nwg, G, c; const char* A; const char* Bt; size_t tstep;
    __device__ void init(const bf16_t* A_, const bf16_t* Bt_, int M, int N, int K, int G_, int c_) { nM = M / BM; nN = N / BM; nwg = nM * nN; G = G_; c = c_; A = (const char*)A_; Bt = (const char*)Bt_; tstep = (size_t)BM * K * 2; }
    __device__ bool next(int i, Unit& u) const {
        const long L = (long)i * G + c; if (L >= nwg) return false;
        int wgid = (int)L; { const int q = nwg / NXCD, r = nwg % NXCD, xcd = wgid % NXCD, off = wgid / NXCD; wgid = (xcd < r ? xcd * (q + 1) : r * (q + 1) + (xcd - r) * q) + off; }
        const int nig = WGM * nN, gid = wgid / nig, fm = gid * WGM, gsz = (nM - fm) < WGM ? (nM - fm) : WGM;
        u.pm = fm + ((wgid % nig) % gsz); u.pn = (wgid % nig) / gsz; u.ex = 0; u.rt = 0; return true;
    }
    __device__ __forceinline__ const char* abase(const Unit& u) const { return A + (size_t)u.pm * tstep; }
    __device__ __forceinline__ const char* bbase(const Unit& u) const { return Bt + (size_t)u.pn * tstep; }
    __device__ __forceinline__ unsigned arow_off(const Unit&, int) const { return 0u; }
};
template <int npn, size_t a_tstep, size_t b_estep, size_t b_tstep, unsigned rowbytes>
struct MoeOrder {
    const LAS int* pref; int c; const char* A; const char* Bt; const int* list;
    int first, limit, cbase, nwg;
    __device__ bool next(int i, Unit& u) const {
        if (c < cbase || c >= cbase + nwg) return false;
        const long L = (long)first + (long)i * nwg + (c - cbase);
        if (L >= (long)limit) return false;
        const int tl = (int)(L / npn); u.pn = (int)(L % npn); u.pm = tl;
        const int ln = (int)__builtin_amdgcn_mbcnt_hi(~0u, __builtin_amdgcn_mbcnt_lo(~0u, 0u));
        const int mine = pref[ln & 31];
        const unsigned long long m = __ballot(ln >= 1 && ln < NEXP && mine <= tl);
        const int e = __builtin_popcountll(m);
        u.ex = e; u.rt = tl - __builtin_amdgcn_readlane(mine, e); return true;
    }
    __device__ __forceinline__ const char* abase(const Unit& u) const { return A + (size_t)u.pm * a_tstep; }
    __device__ __forceinline__ const char* bbase(const Unit& u) const { return Bt + (size_t)u.ex * b_estep + (size_t)u.pn * b_tstep; }
    __device__ __forceinline__ unsigned arow_off(const Unit& u, int r, int cnt_e) const {
        int p = u.rt * 256 + r; p = p < cnt_e ? p : 0;
        const int ent = list[u.ex * LCAP + p];
        return (unsigned)(ent >> 1) * rowbytes;
    }
};

typedef float f32x2v __attribute__((ext_vector_type(2)));
typedef int i32x4_t __attribute__((ext_vector_type(4)));
typedef int i32x8_t __attribute__((ext_vector_type(8)));
__device__ __forceinline__ f32x2v gelu_pk(f32x2v v) {
    const f32x2v av = __builtin_elementwise_abs(v), d = av * 0.2316418882f + 1.0f;
    f32x2v t; t.x = __builtin_amdgcn_rcpf(d.x); t.y = __builtin_amdgcn_rcpf(d.y);
    f32x2v q = t * 0.5307027145f + (-0.7265760135f); q = q * t + 0.7107068705f; q = q * t + (-0.142248368f); q = q * t + 0.127414796f; q = q * t;
    const f32x2v s = (v * v) * (-0.72134752044f);
    f32x2v e; e.x = __builtin_amdgcn_exp2f(s.x); e.y = __builtin_amdgcn_exp2f(s.y);
    const f32x2v m = v * (q * e), r = v - m;
    f32x2v o; o.x = v.x < 0.f ? m.x : r.x; o.y = v.y < 0.f ? m.y : r.y; return o;
}

template <class Epi, class Sched, bool GATHER, int K, int WSCALE = 0>
__device__ __forceinline__ void gemm_phase(LAS unsigned char* lds, const int tid, const Sched& S, const Epi& E, const unsigned* cnts) {
    const int wid = __builtin_amdgcn_readfirstlane(tid >> 6), lane = tid & 63, wr = wid >> 2, wc = wid & 3, fr = lane & 15, fq = lane >> 4;
    const int nt = K / BK;
    unsigned voffA[2], voffB[2]; int stR[2];
#pragma unroll
    for (int i = 0; i < 2; ++i) { int R, C; stage_rc(tid * 16 + i * 8192, R, C); const int Rb = Epi::PERM ? ((R & ~31) + perm32(R & 31)) : R;
        voffA[i] = GATHER ? (unsigned)(C * 2) : (unsigned)(R * K + C) * 2u; voffB[i] = (unsigned)(Rb * K + C) * 2u; stR[i] = R; }
    const size_t kstep = (size_t)(BK * 2);
    const size_t hstep = (size_t)HALF * K * 2;
    const unsigned ldsw = (unsigned)wid * 1024u;
    const int aoff = lds_byte(wr * 64 + fr, fq * 8), boff = lds_byte(wc * 32 + fr, fq * 8);
#define PG8_SA(b, h) (((b) * 2 + (h)) * HTB)
#define PG8_SB(b, h) ((4 + (b) * 2 + (h)) * HTB)
#define PG8_GLDS(gp, bufoff, i) __builtin_amdgcn_global_load_lds((const unsigned*)(gp), (LAS unsigned*)(lds + (bufoff) + ldsw + (i) * 8192), 16, 0, 0)
#define PG8_STAGE(bufoff, gbase, voff) do { _Pragma("unroll") for (int _i = 0; _i < 2; ++_i) PG8_GLDS((const char*)(gbase) + (voff)[_i], bufoff, _i); } while (0)
#define PG8_STAGE_A(bufoff, H, NX, KO) do { _Pragma("unroll") for (int _i = 0; _i < 2; ++_i) { \
        if constexpr (GATHER) { const unsigned _o = (NX) ? offN[H][_i] : offC[H][_i]; PG8_GLDS(gA + _o + voffA[_i] + (KO), bufoff, _i); } \
        else { PG8_GLDS(((NX) ? nA : cA) + (H) * hstep + voffA[_i] + (KO), bufoff, _i); } } } while (0)
#define PG8_LDA(dst, b, h) do { _Pragma("unroll") for (int m = 0; m < 4; ++m) { dst[m].lo = *(const LAS i32x4_t*)(lds + PG8_SA(b, h) + aoff + m * 2048); dst[m].hi = *(const LAS i32x4_t*)(lds + PG8_SA(b, h) + aoff + m * 2048 + 1024); } } while (0)
#define PG8_LDB(dst, b, h) do { _Pragma("unroll") for (int n = 0; n < 2; ++n) { dst[n].lo = *(const LAS i32x4_t*)(lds + PG8_SB(b, h) + boff + n * 2048); dst[n].hi = *(const LAS i32x4_t*)(lds + PG8_SB(b, h) + boff + n * 2048 + 1024); } } while (0)
#define PG8_MMA(ai, bj, At, Bt) do { __builtin_amdgcn_s_setprio(1); if constexpr (WSCALE != 0) asm volatile("s_nop 3" ::: "memory");     \
        _Pragma("unroll") for (int m = 0; m < 4; ++m) _Pragma("unroll") for (int n = 0; n < 2; ++n) { \
        if constexpr (WSCALE != 0) { asm volatile("v_mfma_scale_f32_16x16x128_f8f6f4 %0, %1, %2, %0, %3, %4 op_sel_hi:[0,0,0]" : "+v"(acc[ai][bj][m][n]) : "v"(Bt[n]), "v"(At[m]), "v"(wscale_v), "v"(ascale_v)); } \
        else { const i32x4_t bl_ = Bt[n].lo, bh_ = Bt[n].hi, al_ = At[m].lo, ah_ = At[m].hi;     \
               acc[ai][bj][m][n] = __builtin_amdgcn_mfma_f32_16x16x32_bf16(__builtin_bit_cast(bf16x8, bl_), __builtin_bit_cast(bf16x8, al_), acc[ai][bj][m][n], 0, 0, 0); \
               acc[ai][bj][m][n] = __builtin_amdgcn_mfma_f32_16x16x32_bf16(__builtin_bit_cast(bf16x8, bh_), __builtin_bit_cast(bf16x8, ah_), acc[ai][bj][m][n], 0, 0, 0); } } \
        __builtin_amdgcn_s_setprio(0); } while (0)
#define PG8_WAIT_V(n) asm volatile("s_waitcnt vmcnt(" #n ")" ::: "memory")
#define PG8_WAIT_L(n) asm volatile("s_waitcnt lgkmcnt(" #n ")" ::: "memory")
#define PG8_BAR __builtin_amdgcn_s_barrier()
#define PG8_SCHED __builtin_amdgcn_sched_barrier(0)
    Unit cur, nxt; int ui = 0;
    if (!S.next(0, cur)) return;
    f32x4 acc[2][2][4][2];
#pragma unroll
    for (int a = 0; a < 2; ++a)
#pragma unroll
        for (int b = 0; b < 2; ++b)
#pragma unroll
            for (int m = 0; m < 4; ++m)
#pragma unroll
                for (int n = 0; n < 2; ++n) acc[a][b][m][n] = (f32x4){0.f, 0.f, 0.f, 0.f};
    i32x8_t At[4], B0[2], B1[2];
    const int wscale_v = WSCALE * 0x01010101, ascale_v = 0x7f7f7f7f;
    const char* gA = S.A;
    const char* cA = S.abase(cur); const char* cB = S.bbase(cur);
    const char* nA = cA;
    unsigned offC[2][2], offN[2][2];
    if constexpr (GATHER) {
        const int ce = __builtin_amdgcn_readfirstlane((int)cnts[64 * cur.ex]);
#pragma unroll
        for (int h = 0; h < 2; ++h)
#pragma unroll
            for (int i = 0; i < 2; ++i) { offC[h][i] = S.arow_off(cur, stR[i] + h * HALF, ce); offN[h][i] = offC[h][i]; }
    } else {
#pragma unroll
        for (int h = 0; h < 2; ++h)
#pragma unroll
            for (int i = 0; i < 2; ++i) { offC[h][i] = 0u; offN[h][i] = 0u; }
    }
    PG8_STAGE(PG8_SB(0, 0), cB, voffB); PG8_STAGE(PG8_SB(0, 1), cB + hstep, voffB); PG8_STAGE_A(PG8_SA(0, 0), 0, false, 0); PG8_STAGE_A(PG8_SA(0, 1), 1, false, 0);
    if (wr == 1) PG8_BAR;
    PG8_WAIT_V(2); PG8_BAR;
    PG8_STAGE(PG8_SB(1, 0), cB + kstep, voffB); PG8_STAGE_A(PG8_SA(1, 0), 0, false, kstep); PG8_STAGE(PG8_SB(1, 1), cB + hstep + kstep, voffB);
    PG8_WAIT_V(6); PG8_BAR;
    for (;;) {
        const bool has_next = S.next(ui + 1, nxt);
        nA = has_next ? S.abase(nxt) : cA; const char* nB = has_next ? S.bbase(nxt) : cB;
        if constexpr (GATHER) {
            if (has_next) { const int ce = __builtin_amdgcn_readfirstlane((int)cnts[64 * nxt.ex]);
#pragma unroll
                for (int h = 0; h < 2; ++h)
#pragma unroll
                    for (int i = 0; i < 2; ++i) offN[h][i] = S.arow_off(nxt, stR[i] + h * HALF, ce);
            } else {
#pragma unroll
                for (int h = 0; h < 2; ++h)
#pragma unroll
                    for (int i = 0; i < 2; ++i) offN[h][i] = offC[h][i];
            }
        }
#pragma unroll 1
        for (int t = 0; t < nt; t += 2) {
            const bool last = (t == nt - 2);
            const size_t k1 = (size_t)(t + 1) * kstep;
            const size_t k2 = last ? 0 : (size_t)(t + 2) * kstep, k3 = k2 + kstep;
            const char* b2 = last ? nB : cB + (size_t)(t + 2) * kstep; const char* b3 = b2 + kstep;
            PG8_LDB(B0, 0, 0); PG8_LDB(B1, 0, 1); PG8_SCHED; PG8_LDA(At, 0, 0); PG8_STAGE_A(PG8_SA(1, 1), 1, false, k1);
            PG8_WAIT_V(8); PG8_WAIT_L(0); PG8_BAR; PG8_MMA(0, 0, At, B0); PG8_MMA(0, 1, At, B1); PG8_BAR; PG8_SCHED;
            PG8_LDA(At, 0, 1); PG8_STAGE(PG8_SB(0, 0), b2, voffB); PG8_STAGE(PG8_SB(0, 1), b2 + hstep, voffB); PG8_STAGE_A(PG8_SA(0, 0), 0, last, k2);
            PG8_WAIT_V(8); PG8_WAIT_L(0); PG8_BAR; PG8_MMA(1, 0, At, B0); PG8_MMA(1, 1, At, B1); PG8_BAR; PG8_SCHED;
            PG8_LDB(B0, 1, 0); PG8_LDB(B1, 1, 1); PG8_SCHED; PG8_LDA(At, 1, 0); PG8_STAGE_A(PG8_SA(0, 1), 1, last, k2);
            PG8_WAIT_V(8); PG8_WAIT_L(0); PG8_BAR; PG8_MMA(0, 0, At, B0); PG8_MMA(0, 1, At, B1); PG8_BAR; PG8_SCHED;
            PG8_LDA(At, 1, 1); PG8_STAGE(PG8_SB(1, 0), b3, voffB); PG8_STAGE(PG8_SB(1, 1), b3 + hstep, voffB); PG8_STAGE_A(PG8_SA(1, 0), 0, last, k3);
            PG8_WAIT_V(8); PG8_WAIT_L(0); PG8_BAR; PG8_MMA(1, 0, At, B0); PG8_MMA(1, 1, At, B1); PG8_BAR; PG8_SCHED;
        }
        if (wr == 0) PG8_BAR;
        if constexpr (WSCALE != 0) asm volatile("s_nop 15\n\ts_nop 7" ::: "memory");
        E(acc, cur, wr, wc, fr, fq);
        if (!has_next) break;
#pragma unroll
        for (int a = 0; a < 2; ++a)
#pragma unroll
            for (int b = 0; b < 2; ++b)
#pragma unroll
                for (int m = 0; m < 4; ++m)
#pragma unroll
                    for (int n = 0; n < 2; ++n) acc[a][b][m][n] = (f32x4){0.f, 0.f, 0.f, 0.f};
        cur = nxt; cA = nA; cB = nB; ++ui;
#pragma unroll
        for (int h = 0; h < 2; ++h)
#pragma unroll
            for (int i = 0; i < 2; ++i) offC[h][i] = offN[h][i];
        if (wr == 1) PG8_BAR;
    }
    PG8_WAIT_V(0);
    PG8_BAR;
#undef PG8_SA
#undef PG8_SB
#undef PG8_GLDS
#undef PG8_STAGE
#undef PG8_STAGE_A
#undef PG8_LDA
#undef PG8_LDB
#undef PG8_MMA
#undef PG8_WAIT_V
#undef PG8_WAIT_L
#undef PG8_BAR
#undef PG8_SCHED
}
}

struct EpiInProj {
    static constexpr bool PERM = true;
    bf16_t* seg0; const float* b_gates; float* kpart; f32x2* stats; int pn_off;
    __device__ __forceinline__ void operator()(const f32x4 (&acc)[2][2][4][2], const pg8::Unit& u_, int wr, int wc, int fr, int fq) const {
        pg8::Unit u = u_; u.pn += pn_off;
        const int row0 = u.pm * 256 + wr * 64 + fr;
        if (u.pn < 8) {
            const int ch0 = 128 * u.pn + 16 * wc + 4 * fq;
            f32x4 bv[2];
#pragma unroll
            for (int bj = 0; bj < 2; ++bj) bv[bj] = *(const f32x4*)(b_gates + ch0 + 64 * bj);
#pragma unroll
            for (int ai = 0; ai < 2; ++ai)
#pragma unroll
                for (int m = 0; m < 4; ++m) { bf16_t* rowp = seg0 + (size_t)(row0 + ai * 128 + m * 16) * D + ch0;
#pragma unroll
                    for (int bj = 0; bj < 2; ++bj) { const f32x4 uu = acc[ai][bj][m][0], gg = acc[ai][bj][m][1] + bv[bj];
                        const pg8::f32x2v a = pg8::gelu_pk((pg8::f32x2v){uu[0], uu[1]}), b = pg8::gelu_pk((pg8::f32x2v){uu[2], uu[3]});
                        float sg[4];
#pragma unroll
                        for (int j = 0; j < 4; ++j) sg[j] = __builtin_amdgcn_rcpf(1.0f + __builtin_amdgcn_exp2f(-LOG2E * gg[j]));
                        u32x2 w; w.x = cvt_pk_bf16(a.x * sg[0], a.y * sg[1]); w.y = cvt_pk_bf16(b.x * sg[2], b.y * sg[3]);
                        *(u32x2*)(rowp + 64 * bj) = w; } }
            return;
        }
        const int seg = (u.pn >> 2) - 1;
        const int colt = (u.pn & 3) * 256, col0 = colt + wc * 32 + 8 * fq;
        bf16_t* base = seg0 + (size_t)seg * (SEG_BYTES / 2);
        if (seg == 1) {
#pragma unroll
            for (int ai = 0; ai < 2; ++ai)
#pragma unroll
                for (int m = 0; m < 4; ++m) { bf16_t* rowp = base + (size_t)(row0 + ai * 128 + m * 16) * D + col0; float s1 = 0.f, s2 = 0.f;
#pragma unroll
                    for (int bj = 0; bj < 2; ++bj) { const f32x4 v0 = acc[ai][bj][m][0], v1 = acc[ai][bj][m][1];
                        const pg8::f32x2v a = pg8::gelu_pk((pg8::f32x2v){v0[0], v0[1]}), b = pg8::gelu_pk((pg8::f32x2v){v0[2], v0[3]}), c = pg8::gelu_pk((pg8::f32x2v){v1[0], v1[1]}), d = pg8::gelu_pk((pg8::f32x2v){v1[2], v1[3]});
                        s1 += ((a.x + a.y) + (b.x + b.y)) + ((c.x + c.y) + (d.x + d.y));
                        s2 += ((a.x * a.x + a.y * a.y) + (b.x * b.x + b.y * b.y)) + ((c.x * c.x + c.y * c.y) + (d.x * d.x + d.y * d.y));
                        u32x4 w; w.x = cvt_pk_bf16(a.x, a.y); w.y = cvt_pk_bf16(b.x, b.y); w.z = cvt_pk_bf16(c.x, c.y); w.w = cvt_pk_bf16(d.x, d.y);
                        *(u32x4*)(rowp + bj * 128) = w; }
                    s1 += __shfl_xor(s1, 16); s1 += __shfl_xor(s1, 32); s2 += __shfl_xor(s2, 16); s2 += __shfl_xor(s2, 32);
                    if (fq == 0) stats[(size_t)(row0 + ai * 128 + m * 16) * 16 + (u.pn & 3) * 4 + wc] = (f32x2){s1, s2}; }
        } else if (seg == 5) {
            const float* bp = b_gates + D + col0;
            f32x4 bv[2][2];
#pragma unroll
            for (int bj = 0; bj < 2; ++bj)
#pragma unroll
                for (int n = 0; n < 2; ++n) bv[bj][n] = *(const f32x4*)(bp + bj * 128 + 4 * n);
#pragma unroll
            for (int ai = 0; ai < 2; ++ai)
#pragma unroll
                for (int m = 0; m < 4; ++m) { bf16_t* rowp = base + (size_t)(row0 + ai * 128 + m * 16) * D + col0;
#pragma unroll
                    for (int bj = 0; bj < 2; ++bj) { f32x4 v0 = acc[ai][bj][m][0] + bv[bj][0], v1 = acc[ai][bj][m][1] + bv[bj][1];
#pragma unroll
                        for (int j = 0; j < 4; ++j) { v0[j] = __builtin_amdgcn_rcpf(1.0f + __builtin_amdgcn_exp2f(-LOG2E * v0[j])); v1[j] = __builtin_amdgcn_rcpf(1.0f + __builtin_amdgcn_exp2f(-LOG2E * v1[j])); }
                        u32x2 w; w.x = cvt_pk4_fp8(v0[0], v0[1], v0[2], v0[3]); w.y = cvt_pk4_fp8(v1[0], v1[1], v1[2], v1[3]);
                        *(u32x2*)((unsigned char*)base + (size_t)(row0 + ai * 128 + m * 16) * D + col0 + bj * 128) = w; } }
        } else if (seg == 4) {
            unsigned char* vt = (unsigned char*)base;
            const int pw = 4 * (8 * ((fr >> 2) & 1) + 4 * (fr >> 3) + (fr & 3));
#pragma unroll
            for (int ai = 0; ai < 2; ++ai)
#pragma unroll
                for (int bj = 0; bj < 2; ++bj) {
                    unsigned char* tb = vt + ((size_t)(((u.pm >> 4) * 8 + 2 * (u.pn & 3) + bj) * 64 + 4 * (u.pm & 15) + 2 * ai + wr) * 128 + 32 * wc + 8 * fq) * 64 + pw;
#pragma unroll
                    for (int n = 0; n < 2; ++n)
#pragma unroll
                        for (int i = 0; i < 4; ++i) *(unsigned*)(tb + (4 * n + i) * 64) = cvt_pk4_fp8(acc[ai][bj][0][n][i], acc[ai][bj][1][n][i], acc[ai][bj][2][n][i], acc[ai][bj][3][n][i]); }
        } else {
            if (seg == 3) {
#pragma unroll
                for (int ai = 0; ai < 2; ++ai)
#pragma unroll
                    for (int m = 0; m < 4; ++m)
#pragma unroll
                        for (int bj = 0; bj < 2; ++bj) { const f32x4 v0 = acc[ai][bj][m][0], v1 = acc[ai][bj][m][1];
                            u32x2 w; w.x = cvt_pk4_fp8(v0[0], v0[1], v0[2], v0[3]); w.y = cvt_pk4_fp8(v1[0], v1[1], v1[2], v1[3]);
                            *(u32x2*)((unsigned char*)base + (size_t)(row0 + ai * 128 + m * 16) * D + col0 + bj * 128) = w; }
            } else {
#pragma unroll
            for (int ai = 0; ai < 2; ++ai)
#pragma unroll
                for (int m = 0; m < 4; ++m) { bf16_t* rowp = base + (size_t)(row0 + ai * 128 + m * 16) * D + col0;
#pragma unroll
                    for (int bj = 0; bj < 2; ++bj) { const f32x4 v0 = acc[ai][bj][m][0], v1 = acc[ai][bj][m][1];
                        u32x4 w; w.x = cvt_pk_bf16(v0[0], v0[1]); w.y = cvt_pk_bf16(v0[2], v0[3]); w.z = cvt_pk_bf16(v1[0], v1[1]); w.w = cvt_pk_bf16(v1[2], v1[3]);
                        *(u32x4*)(rowp + bj * 128) = w; } }
            }
            if (seg == 3) {
#pragma unroll
                for (int bj = 0; bj < 2; ++bj)
#pragma unroll
                    for (int n = 0; n < 2; ++n) { f32x4 s = (f32x4){0.f, 0.f, 0.f, 0.f};
#pragma unroll
                        for (int ai = 0; ai < 2; ++ai)
#pragma unroll
                            for (int m = 0; m < 4; ++m) s += acc[ai][bj][m][n];
#pragma unroll
                        for (int o = 1; o < 16; o <<= 1) { s[0] += __shfl_xor(s[0], o); s[1] += __shfl_xor(s[1], o); s[2] += __shfl_xor(s[2], o); s[3] += __shfl_xor(s[3], o); }
                        if (fr == 0) *(f32x4*)(kpart + ((size_t)u.pm * 2 + wr) * D + col0 + bj * 128 + 4 * n) = s; }
            }
        }
    }
};
struct EpiOutProj {
    static constexpr bool PERM = true;
    const bf16_t* xnb; const float* xrs; const float* gmix; bf16_t* hb; const float* gffn; unsigned char* xn2; const bf16_t* rwh; float* lpart; float* ssqp; LAS unsigned char* red;
    __device__ __forceinline__ void operator()(const f32x4 (&acc)[2][2][4][2], const pg8::Unit& u, int wr, int wc, int fr, int fq) const {
        asm volatile("" : "+v"(fr), "+v"(fq));
        const int row0 = u.pm * 256 + wr * 64 + fr, col0 = u.pn * 256 + wc * 32 + 8 * fq, lane = fq * 16 + fr;
        const bf16_t* rwl = rwh + 48 * D;
        LAS float* R = (LAS float*)(red + wr * RED_BYTES);
        f32x4 ig[2][2];
#pragma unroll
        for (int bj = 0; bj < 2; ++bj)
#pragma unroll
            for (int n = 0; n < 2; ++n) { const f32x4 gm = *(const f32x4*)(gmix + col0 + 128 * bj + 4 * n); ig[bj][n] = (f32x4){__builtin_amdgcn_rcpf(gm[0]), __builtin_amdgcn_rcpf(gm[1]), __builtin_amdgcn_rcpf(gm[2]), __builtin_amdgcn_rcpf(gm[3])}; }
#pragma unroll
        for (int ai = 0; ai < 2; ++ai)
#pragma unroll
            for (int m = 0; m < 4; ++m) { const size_t off = (size_t)(row0 + ai * 128 + m * 16) * D + col0; const float rm = xrs[row0 + ai * 128 + m * 16];
#pragma unroll
                for (int bj = 0; bj < 2; ++bj) { const u32x4 xw = *(const u32x4*)(xnb + off + bj * 128);
                    const f32x4 h0 = (f32x4){bf_lo(xw.x), bf_hi(xw.x), bf_lo(xw.y), bf_hi(xw.y)} * rm * ig[bj][0] + acc[ai][bj][m][0], h1 = (f32x4){bf_lo(xw.z), bf_hi(xw.z), bf_lo(xw.w), bf_hi(xw.w)} * rm * ig[bj][1] + acc[ai][bj][m][1];
                    u32x4 w; w.x = cvt_pk_bf16(h0[0], h0[1]); w.y = cvt_pk_bf16(h0[2], h0[3]); w.z = cvt_pk_bf16(h1[0], h1[1]); w.w = cvt_pk_bf16(h1[2], h1[3]);
                    *(u32x4*)(hb + off + bj * 128) = w; } }
        asm volatile("s_waitcnt vmcnt(0)" ::: "memory");
        bf16x8 bh[2][3], bl[2][3]; f32x4 gv[2][2];
#pragma unroll
        for (int bj = 0; bj < 2; ++bj) { gv[bj][0] = *(const f32x4*)(gffn + col0 + 128 * bj); gv[bj][1] = *(const f32x4*)(gffn + col0 + 128 * bj + 4); }
#pragma unroll
        for (int bj = 0; bj < 2; ++bj)
#pragma unroll
            for (int nt = 0; nt < 3; ++nt) { bh[bj][nt] = *(const bf16x8*)(rwh + (size_t)(16 * nt + fr) * D + col0 + 128 * bj); bl[bj][nt] = *(const bf16x8*)(rwl + (size_t)(16 * nt + fr) * D + col0 + 128 * bj); }
        LAS int* Ri = (LAS int*)R;
#pragma unroll
        for (int i = 0; i < 13; ++i) Ri[(16 * wc) * 52 + i * 64 + lane] = 0;
        __syncthreads();
#pragma unroll
        for (int ai = 0; ai < 2; ++ai) {
            f32x4 lacc[4][3]; float ssq[4];
#pragma unroll
            for (int m = 0; m < 4; ++m) { ssq[m] = 0.f;
#pragma unroll
                for (int nt = 0; nt < 3; ++nt) lacc[m][nt] = (f32x4){0.f, 0.f, 0.f, 0.f}; }
#pragma unroll
            for (int bj = 0; bj < 2; ++bj)
#pragma unroll
                for (int m = 0; m < 4; ++m) { const size_t off = (size_t)(row0 + ai * 128 + m * 16) * D + col0 + bj * 128;
                    const u32x4 w = *(const u32x4*)(hb + off); const bf16x8 af = __builtin_bit_cast(bf16x8, w);
                    const f32x4 r0 = (f32x4){bf_lo(w.x), bf_hi(w.x), bf_lo(w.y), bf_hi(w.y)}, r1 = (f32x4){bf_lo(w.z), bf_hi(w.z), bf_lo(w.w), bf_hi(w.w)};
                    ssq[m] += ((r0[0] * r0[0] + r0[1] * r0[1]) + (r0[2] * r0[2] + r0[3] * r0[3])) + ((r1[0] * r1[0] + r1[1] * r1[1]) + (r1[2] * r1[2] + r1[3] * r1[3]));
                    { const f32x4 y0 = r0 * gv[bj][0], y1 = r1 * gv[bj][1];
                      u32x2 w8; w8.x = cvt_pk4_fp8(y0[0], y0[1], y0[2], y0[3]); w8.y = cvt_pk4_fp8(y1[0], y1[1], y1[2], y1[3]);
                      *(u32x2*)(xn2 + off) = w8; }
#pragma unroll
                    for (int nt = 0; nt < 3; ++nt) { lacc[m][nt] = __builtin_amdgcn_mfma_f32_16x16x32_bf16(af, bh[bj][nt], lacc[m][nt], 0, 0, 0); lacc[m][nt] = __builtin_amdgcn_mfma_f32_16x16x32_bf16(af, bl[bj][nt], lacc[m][nt], 0, 0, 0); } }
#pragma unroll
            for (int m = 0; m < 4; ++m) {
#pragma unroll
                for (int nt = 0; nt < 3; ++nt)
#pragma unroll
                    for (int j = 0; j < 4; ++j) __hip_atomic_fetch_add(Ri + (16 * m + 4 * fq + j) * 52 + 16 * nt + fr, __float2int_rn(lacc[m][nt][j] * 4194304.0f), __ATOMIC_RELAXED, __HIP_MEMORY_SCOPE_WORKGROUP);
                float sq = ssq[m]; sq += __shfl_xor(sq, 16); sq += __shfl_xor(sq, 32);
                if (fq == 0) __hip_atomic_fetch_add(Ri + (16 * m + fr) * 52 + 48, __float2int_rn(sq * 65536.0f), __ATOMIC_RELAXED, __HIP_MEMORY_SCOPE_WORKGROUP); }
            __syncthreads();
            const int grow0 = u.pm * 256 + ai * 128 + wr * 64;
#pragma unroll
            for (int i = 0; i < 3; ++i) { const int q = i * 64 + lane, r = 16 * wc + q / 12, c4 = q % 12;
                const pg8::i32x4_t iv = *(const LAS pg8::i32x4_t*)(Ri + r * 52 + 4 * c4);
                *(f32x4*)(lpart + ((size_t)u.pn * T + grow0 + r) * 48 + 4 * c4) = (f32x4){(float)iv[0], (float)iv[1], (float)iv[2], (float)iv[3]} * (1.0f / 4194304.0f); }
            if (lane < 16) ssqp[(size_t)u.pn * T + grow0 + 16 * wc + lane] = (float)Ri[(16 * wc + lane) * 52 + 48] * (1.0f / 65536.0f);
            if (ai == 0) {
                asm volatile("s_waitcnt lgkmcnt(0)" ::: "memory");
#pragma unroll
                for (int i = 0; i < 13; ++i) Ri[(16 * wc) * 52 + i * 64 + lane] = 0;
                __syncthreads(); }
        }
    }
};
struct EpiMoe1 {
    static constexpr bool PERM = true;
    unsigned char* hid;
    const float* rsp; const unsigned* cnt;
    __device__ __forceinline__ void operator()(const f32x4 (&acc)[2][2][4][2], const pg8::Unit& u, int wr, int wc, int fr, int fq) const {
        const int hc0 = 128 * u.pn + 16 * wc + 4 * fq;
        const int ce = __builtin_amdgcn_readfirstlane((int)cnt[64 * u.ex]);
        float rsv[2][4];
#pragma unroll
        for (int ai = 0; ai < 2; ++ai)
#pragma unroll
            for (int m = 0; m < 4; ++m) { const int p = u.rt * 256 + ai * 128 + wr * 64 + m * 16 + fr; rsv[ai][m] = p < ce ? rsp[u.ex * LCAP + p] : 0.f; }
#pragma unroll
        for (int ai = 0; ai < 2; ++ai)
#pragma unroll
            for (int m = 0; m < 4; ++m) { const int r = ai * 128 + wr * 64 + m * 16 + fr; const float rs = rsv[ai][m];
                unsigned char* rowp = hid + (size_t)(u.pm * 256 + r) * DEXP + hc0;
#pragma unroll
                for (int bj = 0; bj < 2; ++bj) { const f32x4 a = acc[ai][bj][m][0] * rs, b = acc[ai][bj][m][1] * rs; f32x4 o;
#pragma unroll
                    for (int j = 0; j < 4; ++j) { const float sg = __builtin_amdgcn_rcpf(1.0f + __builtin_amdgcn_exp2f(-LOG2E * a[j])); o[j] = a[j] * sg * b[j]; }
                    *(unsigned*)(rowp + bj * 64) = cvt_pk4_fp8(o[0], o[1], o[2], o[3]); } }
    }
};
struct EpiMoe2 {
    static constexpr bool PERM = true;
    unsigned char* yp;
    __device__ __forceinline__ void operator()(const f32x4 (&acc)[2][2][4][2], const pg8::Unit& u, int wr, int wc, int fr, int fq) const {
        const int row0 = u.pm * 256 + wr * 64 + fr, col0 = u.pn * 256 + wc * 32 + 8 * fq;
#pragma unroll
        for (int ai = 0; ai < 2; ++ai)
#pragma unroll
            for (int m = 0; m < 4; ++m) { unsigned char* rowp = yp + (size_t)(row0 + ai * 128 + m * 16) * D + col0;
#pragma unroll
                for (int bj = 0; bj < 2; ++bj) { const f32x4 v0 = acc[ai][bj][m][0] * 16.0f, v1 = acc[ai][bj][m][1] * 16.0f;
                    u32x2 w; w.x = cvt_pk4_fp8(v0[0], v0[1], v0[2], v0[3]); w.y = cvt_pk4_fp8(v1[0], v1[1], v1[2], v1[3]);
                    *(u32x2*)(rowp + bj * 128) = w; } }
    }
};

struct Args {
    const float* x; const float* norm_mix_g; const float* w_in; const float* b_gates; const float* ln_g; const float* ln_b; const float* w_spatial; const float* b_spatial;
    const float* rel_bias; const float* w_out; const float* norm_ffn_g; const float* w_gr; const float* b_gr; const float* w_er; const float* b_er;
    const float* w1; const float* w3; const float* w2; const float* norm_final_g;
    float* out; unsigned char* ws; int ph_lo, ph_hi; int rep_mask, pad;
};
struct Frame { LAS unsigned char* lds; int tid, lane, wave, vcu, G; };
__device__ __forceinline__ Args load_args() {
#if defined(__HIP_DEVICE_COMPILE__)
    const __attribute__((address_space(4))) Args* p = (const __attribute__((address_space(4))) Args*)__builtin_amdgcn_kernarg_segment_ptr(); asm volatile("" : "+s"(p));
    Args r; __builtin_memcpy(&r, (const Args*)p, sizeof(Args)); return r;
#else
    return Args{};
#endif
}

__device__ __forceinline__ unsigned off_b(unsigned row, unsigned ch) { return 256u * row + 16u * (ch ^ (((row & 3) << 2) | ((row >> 2) & 3))); }
__device__ __forceinline__ int crow(int r, int hi) { return (r & 3) + 8 * (r >> 2) + 4 * hi; }
__device__ __forceinline__ s16x4 lds_tr(LAS const unsigned char* p) { typedef short v4i16_t __attribute__((ext_vector_type(4))); return __builtin_bit_cast(s16x4, __builtin_amdgcn_ds_read_tr16_b64_v4i16((LAS v4i16_t*)p)); }

struct TDesc { const float* src; int N, k0, n0; unsigned char* dst; int ldd  ; int rmk  , which; float scale  ; };
__device__ __forceinline__ int tdesc_row(const TDesc& d, int n) {
    if (d.rmk == 0) return n;
    if (d.rmk == 3) return 8 * (n >> 2) + 4 * d.which + (n & 3);
    const int sg = n >> 10, j = n & 1023; const int r = sg == 0 ? 8 * (j >> 2) + (j & 3) : sg == 5 ? 8 * (j >> 2) + 4 + (j & 3) : sg == 6 ? 6144 + j : 1024 + n;
    return d.rmk == 1 ? r : r - 2048;
}
__device__ __forceinline__ void titem_load(const TDesc& d, f32x4 (&v)[8], int lane) {
    const float* p = d.src + (size_t)(d.k0 + (lane >> 4)) * d.N + d.n0 + 4 * (lane & 15);
#pragma unroll
    for (int i = 0; i < 8; ++i) v[i] = __builtin_nontemporal_load((const f32x4*)(p + (size_t)(4 * i) * d.N));
}
__device__ __forceinline__ void titem_store(const TDesc& d, const f32x4 (&v)[8], LAS float* scr  , int lane) {
#pragma unroll
    for (int i = 0; i < 8; ++i) *(LAS f32x4*)(scr + (4 * i + (lane >> 4)) * 68 + 4 * (lane & 15)) = v[i];
    LDS_WAIT(); asm volatile("" ::: "memory");
    if (d.scale != 0.f) {
#pragma unroll
        for (int q = 0; q < 2; ++q) { const int n = (lane >> 1) + 32 * q, kh = lane & 1; const LAS float* sp = scr + (16 * kh) * 68 + n; float f[16];
#pragma unroll
            for (int j = 0; j < 16; ++j) f[j] = sp[j * 68] * d.scale;
            u32x4 o; o.x = cvt_pk4_fp8(f[0], f[1], f[2], f[3]); o.y = cvt_pk4_fp8(f[4], f[5], f[6], f[7]); o.z = cvt_pk4_fp8(f[8], f[9], f[10], f[11]); o.w = cvt_pk4_fp8(f[12], f[13], f[14], f[15]);
            *(u32x4*)(d.dst + (size_t)tdesc_row(d, d.n0 + n) * d.ldd + d.k0 + 16 * kh) = o; }
    } else {
#pragma unroll
        for (int q = 0; q < 4; ++q) { const int n = (lane >> 2) + 16 * q, kq = lane & 3; const LAS float* sp = scr + (8 * kq) * 68 + n; float f[8];
#pragma unroll
            for (int j = 0; j < 8; ++j) f[j] = sp[j * 68];
            u32x4 o; o.x = cvt_pk_bf16(f[0], f[1]); o.y = cvt_pk_bf16(f[2], f[3]); o.z = cvt_pk_bf16(f[4], f[5]); o.w = cvt_pk_bf16(f[6], f[7]);
            *(u32x4*)(d.dst + (size_t)tdesc_row(d, d.n0 + n) * d.ldd + (size_t)(d.k0 + 8 * kq) * 2) = o; }
    }
    LDS_WAIT(); asm volatile("" ::: "memory");
}
template <class Gen>
__device__ __forceinline__ void titems_run(const Gen& gen, int first, int stride, int end, LAS float* scr, int lane) {
    for (int it = first; it < end; it += 4 * stride) {
        const bool h1 = it + stride < end, h2 = it + 2 * stride < end, h3 = it + 3 * stride < end;
        const TDesc d0 = gen(it), d1 = gen(h1 ? it + stride : it), d2 = gen(h2 ? it + 2 * stride : it), d3 = gen(h3 ? it + 3 * stride : it);
        f32x4 v0[8], v1[8], v2[8], v3[8];
        titem_load(d0, v0, lane); if (h1) titem_load(d1, v1, lane); if (h2) titem_load(d2, v2, lane); if (h3) titem_load(d3, v3, lane);
        titem_store(d0, v0, scr, lane); if (h1) titem_store(d1, v1, scr, lane); if (h2) titem_store(d2, v2, scr, lane); if (h3) titem_store(d3, v3, scr, lane);
    }
}
template <class RowMap>
__device__ __forceinline__ void transpose_item_fp8(const float* W, int N, int k0, int n0, unsigned char* dst, int ldd, LAS float* scr, int lane, RowMap rm, float scale) {
#pragma unroll 8
    for (int i = 0; i < 32; ++i) { const int kk = 2 * i + (lane >> 5); scr[kk * 33 + (lane & 31)] = W[(size_t)(k0 + kk) * N + n0 + (lane & 31)]; }
    LDS_WAIT(); asm volatile("" ::: "memory");
    const int c = lane & 7;
#pragma unroll
    for (int j = 0; j < 4; ++j) { const int n = (lane >> 3) + 8 * j; const LAS float* s = scr + (8 * c) * 33 + n;
        u32x2 o; o.x = cvt_pk4_fp8(s[0 * 33] * scale, s[1 * 33] * scale, s[2 * 33] * scale, s[3 * 33] * scale); o.y = cvt_pk4_fp8(s[4 * 33] * scale, s[5 * 33] * scale, s[6 * 33] * scale, s[7 * 33] * scale);
        *(u32x2*)(dst + (size_t)rm(n0 + n) * ldd + k0 + 8 * c) = o; }
    LDS_WAIT(); asm volatile("" ::: "memory");
}
template <class RowMap>
__device__ __forceinline__ void transpose_item(const float* W, int N, int k0, int n0, bf16_t* dst, int ldd, LAS float* scr, int lane, RowMap rm) {
#pragma unroll 8
    for (int i = 0; i < 32; ++i) { const int kk = 2 * i + (lane >> 5); scr[kk * 33 + (lane & 31)] = W[(size_t)(k0 + kk) * N + n0 + (lane & 31)]; }
    LDS_WAIT(); asm volatile("" ::: "memory");
    const int c = lane & 7;
#pragma unroll
    for (int j = 0; j < 4; ++j) { const int n = (lane >> 3) + 8 * j; const LAS float* s = scr + (8 * c) * 33 + n;
        u32x4 o; o.x = cvt_pk_bf16(s[0 * 33], s[1 * 33]); o.y = cvt_pk_bf16(s[2 * 33], s[3 * 33]); o.z = cvt_pk_bf16(s[4 * 33], s[5 * 33]); o.w = cvt_pk_bf16(s[6 * 33], s[7 * 33]);
        *(u32x4*)(dst + (size_t)rm(n0 + n) * ldd + k0 + 8 * c) = o; }
    LDS_WAIT(); asm volatile("" ::: "memory");
}
struct RmId { __device__ __forceinline__ int operator()(int n) const { return n; } };
struct RmWin { __device__ __forceinline__ int operator()(int n) const { const int sg = n >> 10, j = n & 1023;
    return sg == 0 ? 8 * (j >> 2) + (j & 3) : sg == 5 ? 8 * (j >> 2) + 4 + (j & 3) : sg == 6 ? 6144 + j : 1024 + n; } };
struct RmWin8 { __device__ __forceinline__ int operator()(int n) const { return RmWin{}(n) - 2048; } };
struct RmW13 { int which; __device__ __forceinline__ int operator()(int j) const { return 8 * (j >> 2) + 4 * which + (j & 3); } };

__device__ __forceinline__ void p0_prologue(const Frame& F, const Args& a) {
    unsigned char* ws = a.ws;
    LAS float* scr = (LAS float*)(F.lds + F.wave * 16384);
    const int gw = F.vcu * NWAVES + F.wave, NGW = F.G * NWAVES;
    bf16_t* win_t = (bf16_t*)(ws + WS_WIN); bf16_t* wout_t = (bf16_t*)(ws + WS_WOUT);
    constexpr int I_IN = (D / 32) * (NCOL / 64), I_OUT = (D / 32) * (D / 64);
    { const float* w_in = a.w_in; unsigned char* wsb_ = ws;
      auto gen = [=](int it) -> TDesc {
          TDesc d; const int nblk = NCOL / 64, kb = it / nblk, nb = it % nblk; const int sg = (64 * nb) >> 10; const bool bf = (sg == 0 || sg == 5);
          d.src = w_in; d.N = NCOL; d.k0 = 32 * kb; d.n0 = 64 * nb; d.dst = wsb_ + (bf ? WS_WIN : WS_WIN8); d.ldd = bf ? D * 2 : D; d.rmk = bf ? 1 : 2; d.which = 0; d.scale = bf ? 0.f : 32.0f;
          return d; };
      titems_run(gen, gw, NGW, I_IN, scr, F.lane); }
    { const float* w_out = a.w_out; unsigned char* wsb_ = ws;
      auto gen = [=](int it) -> TDesc {
          TDesc d; const int nblk = D / 64, kb = it / nblk, nb = it % nblk;
          d.src = w_out; d.N = D; d.k0 = 32 * kb; d.n0 = 64 * nb; d.dst = wsb_ + WS_WOUT; d.ldd = D * 2; d.rmk = 0; d.which = 0; d.scale = 0.f;
          return d; };
      titems_run(gen, gw, NGW, I_OUT, scr, F.lane); }
    bf16_t* xn = (bf16_t*)a.out;
    f32x4 gv[4];
#pragma unroll
    for (int j = 0; j < 4; ++j) gv[j] = *((const f32x4*)a.norm_mix_g + F.lane + 64 * j);
    for (int m = gw; m < T; m += NGW) {
        const f32x4* xr = (const f32x4*)(a.x + (size_t)m * D) + F.lane;
        f32x4 v[4]; float s = 0.f;
#pragma unroll
        for (int j = 0; j < 4; ++j) { v[j] = __builtin_nontemporal_load(xr + 64 * j); s += (v[j].x * v[j].x + v[j].y * v[j].y) + (v[j].z * v[j].z + v[j].w * v[j].w); }
        const float rms = sqrtf(wave_sum(s) * (1.f / D) + NORM_EPS), rs = 1.0f / rms;
        if (F.lane == 0) ((float*)(ws + WS_XRS))[m] = rms;
        u32x2* o8 = (u32x2*)(xn + (size_t)m * D) + F.lane;
#pragma unroll
        for (int j = 0; j < 4; ++j) { const f32x4 y = v[j] * rs * gv[j]; u32x2 w; w.x = cvt_pk_bf16(y.x, y.y); w.y = cvt_pk_bf16(y.z, y.w); o8[64 * j] = w;
            ((unsigned*)(ws + WS_XN8 + (size_t)m * D))[F.lane + 64 * j] = cvt_pk4_fp8(y.x, y.y, y.z, y.w); }
    }
    { bf16_t* rwh = (bf16_t*)(ws + WS_RW); bf16_t* rwl = rwh + 48 * D;
      for (int i = (blockIdx.x * NTHREADS + F.tid) * 2; i < 48 * D; i += F.G * NTHREADS * 2) {
          const int c = i >> 10, k = i & 1023; float v0 = 0.f, v1 = 0.f;
          if (c < 32) { v0 = a.norm_ffn_g[k] * a.w_er[((size_t)(c >> 3) * D + k) * 8 + (c & 7)]; v1 = a.norm_ffn_g[k + 1] * a.w_er[((size_t)(c >> 3) * D + k + 1) * 8 + (c & 7)]; }
          else if (c < 36) { v0 = a.norm_ffn_g[k] * a.w_gr[k * 4 + (c - 32)]; v1 = a.norm_ffn_g[k + 1] * a.w_gr[(k + 1) * 4 + (c - 32)]; }
          const unsigned hi = cvt_pk_bf16(v0, v1);
          *(unsigned*)(rwh + i) = hi; *(unsigned*)(rwl + i) = cvt_pk_bf16(v0 - bf_lo(hi), v1 - bf_hi(hi)); } }
    bf16_t* wsb = (bf16_t*)(ws + WS_WSB);
    for (int i = (blockIdx.x * NTHREADS + F.tid) * 2; i < 8 * 128 * 128; i += F.G * NTHREADS * 2) {
        const int s = i & 127, t = (i >> 7) & 127;
        const float v0 = (s <= t) ? a.w_spatial[i] : 0.f, v1 = (s + 1 <= t) ? a.w_spatial[i + 1] : 0.f;
        *(unsigned*)(wsb + i) = cvt_pk_bf16(v0, v1);
    }
}

constexpr int GM_WSL = 98304, GM_STAT = 90112;
__device__ __forceinline__ void gmlp_load_ws(const Frame& F, const Args& a, int g) {
    const bf16_t* wsb = (const bf16_t*)(a.ws + WS_WSB);
    for (int i = F.tid; i < 128 * 16; i += NTHREADS) { const int row = i >> 4, ch = i & 15; *(LAS u32x4*)(F.lds + GM_WSL + off_b(row, ch)) = *(const u32x4*)(wsb + ((size_t)g * 128 + row) * 128 + ch * 8); }
}
__device__ __forceinline__ void gmlp_chunk(const Frame& F, const Args& a, int row0, int g, const bool live) {
    asm volatile("" : "+s"(row0), "+s"(g));
    int tid_ = F.tid; asm volatile("" : "+v"(tid_));
    unsigned char* ws = a.ws;
    bf16_t* Ub = (bf16_t*)(ws + WS_U); const bf16_t* VG = (const bf16_t*)(ws + WS_VG);
    const f32x2* stats = (const f32x2*)(ws + WS_STAT);
    LAS unsigned char* VN = F.lds;
    LAS unsigned char* WSL = F.lds + GM_WSL;
    LAS float* MEAN = (LAS float*)(F.lds + GM_STAT); LAS float* RSTD = MEAN + 128;
    const int lane = tid_ & 63, wid = __builtin_amdgcn_readfirstlane(tid_ >> 6), r32 = lane & 31, hh = lane >> 5;
    const int mych = tid_ & 15;
    const f32x4 lg0 = *(const f32x4*)(a.ln_g + g * 128 + mych * 8), lg1 = *(const f32x4*)(a.ln_g + g * 128 + mych * 8 + 4);
    const f32x4 lb0 = *(const f32x4*)(a.ln_b + g * 128 + mych * 8), lb1 = *(const f32x4*)(a.ln_b + g * 128 + mych * 8 + 4);
    const int tt = wid >> 1, cp = wid & 1;
    const float bsp = a.b_spatial[g * 128 + tt * 32 + r32];
    __syncthreads();
    if (tid_ < 128) { const f32x2* sp = stats + (size_t)(row0 + tid_) * 16; float s1 = 0.f, s2 = 0.f;
#pragma unroll
        for (int j = 0; j < 16; ++j) { const f32x2 v = sp[j]; s1 += v.x; s2 += v.y; }
        const float mean = s1 * (1.f / 1024.f), var = s2 * (1.f / 1024.f) - mean * mean;
        MEAN[tid_] = mean; RSTD[tid_] = 1.0f / sqrtf(fmaxf(var, 0.f) + NORM_EPS); }
    __syncthreads();
#pragma unroll
    for (int it = 0; it < 4; ++it) { const int s = (tid_ >> 4) + 32 * it;
        const u32x4 raw = *(const u32x4*)(VG + (size_t)(row0 + s) * D + g * 128 + mych * 8);
        const float mu = MEAN[s], rs = RSTD[s];
        f32x4 x0 = (f32x4){bf_lo(raw.x), bf_hi(raw.x), bf_lo(raw.y), bf_hi(raw.y)}, x1 = (f32x4){bf_lo(raw.z), bf_hi(raw.z), bf_lo(raw.w), bf_hi(raw.w)};
        x0 = (x0 - mu) * rs * lg0 + lb0; x1 = (x1 - mu) * rs * lg1 + lb1;
        u32x4 w; w.x = cvt_pk_bf16(x0[0], x0[1]); w.y = cvt_pk_bf16(x0[2], x0[3]); w.z = cvt_pk_bf16(x1[0], x1[1]); w.w = cvt_pk_bf16(x1[2], x1[3]);
        *(LAS u32x4*)(VN + off_b(s, mych)) = w; }
    __syncthreads();
    f32x16 c0 = {}, c1 = {};
    const unsigned blk = (lane >> 4) & 1, q = (lane & 15) >> 2, p = lane & 3;
    for (int ks = 0; ks < 2 * (tt + 1); ++ks) {
        const bf16x8 bfrag = *(const LAS bf16x8*)(WSL + off_b(tt * 32 + r32, 2 * ks + hh));
        bf16x8 af[2];
#pragma unroll
        for (int ct = 0; ct < 2; ++ct) { const int cc = 2 * cp + ct;
            const s16x4 lo = lds_tr(VN + off_b(16 * ks + 8 * hh + q, 4 * cc + 2 * blk + (p >> 1)) + 8 * (p & 1));
            const s16x4 hi = lds_tr(VN + off_b(16 * ks + 8 * hh + 4 + q, 4 * cc + 2 * blk + (p >> 1)) + 8 * (p & 1));
            af[ct] = (bf16x8){lo[0], lo[1], lo[2], lo[3], hi[0], hi[1], hi[2], hi[3]}; }
        c0 = __builtin_amdgcn_mfma_f32_32x32x16_bf16(af[0], bfrag, c0, 0, 0, 0);
        c1 = __builtin_amdgcn_mfma_f32_32x32x16_bf16(af[1], bfrag, c1, 0, 0, 0);
    }
    const size_t rowoff = (size_t)(row0 + tt * 32 + r32) * D + g * 128;
#pragma unroll
    for (int ct = 0; ct < 2; ++ct)
#pragma unroll
        for (int gq = 0; gq < 4; ++gq) { const int c = 32 * (2 * cp + ct) + 8 * gq + 4 * hh;
            const u32x2 uu = *(const u32x2*)(Ub + rowoff + c);
            const f32x16& cc_ = ct ? c1 : c0;
            const float m0 = cc_[4 * gq + 0] + bsp, m1 = cc_[4 * gq + 1] + bsp, m2 = cc_[4 * gq + 2] + bsp, m3 = cc_[4 * gq + 3] + bsp;
            u32x2 o; o.x = cvt_pk_bf16(bf_lo(uu.x) * m0, bf_hi(uu.x) * m1); o.y = cvt_pk_bf16(bf_lo(uu.y) * m2, bf_hi(uu.y) * m3);
            if (live) *(u32x2*)(Ub + rowoff + c) = o; }
}

__constant__ unsigned char T5_BUCKET[128] = {0, 1, 2, 3, 4, 5, 6, 7, 8, 9, 10, 11, 12, 13, 14, 15, 16, 16, 16, 17, 17, 18, 18, 18, 19, 19, 19, 20, 20, 20, 20, 21, 21, 21, 21, 22, 22, 22, 22, 22, 23, 23, 23, 23, 23, 23, 24, 24, 24, 24, 24, 24, 25, 25, 25, 25, 25, 25, 25, 26, 26, 26, 26, 26, 26, 26, 26, 27, 27, 27, 27, 27, 27, 27, 27, 27, 27, 28, 28, 28, 28, 28, 28, 28, 28, 28, 28, 29, 29, 29, 29, 29, 29, 29, 29, 29, 29, 29, 29, 30, 30, 30, 30, 30, 30, 30, 30, 30, 30, 30, 30, 30, 30, 31, 31, 31, 31, 31, 31, 31, 31, 31, 31, 31, 31, 31, 31, 31};
constexpr int AT_KV = 0;
constexpr int AT_KMH = 65536, AT_KML = 73728, AT_TB = 81920;
__device__ __forceinline__ void attn_bh_tables(const Frame& F, const Args& a, int b, int h) {
    LAS unsigned char* lds = F.lds; const int tid = F.tid;
    const float* kpart = (const float*)(a.ws + WS_KPART);
    { const int n = tid >> 5, c4 = (tid & 31) * 4;
      const float* kp = kpart + ((size_t)(b * 16 + n) * 2) * D + h * HD + c4;
      const f32x4 s = (*(const f32x4*)kp + *(const f32x4*)(kp + D)) * (1.0f / 256.0f);
      u32x2 hi; hi.x = cvt_pk_bf16(s[0], s[1]); hi.y = cvt_pk_bf16(s[2], s[3]);
      const f32x4 rsd = (f32x4){s[0] - bf_lo(hi.x), s[1] - bf_hi(hi.x), s[2] - bf_lo(hi.y), s[3] - bf_hi(hi.y)};
      u32x2 lo; lo.x = cvt_pk_bf16(rsd[0], rsd[1]); lo.y = cvt_pk_bf16(rsd[2], rsd[3]);
      const unsigned o = off_b(n, c4 >> 3) + (c4 & 7) * 2, oz = off_b(n + 16, c4 >> 3) + (c4 & 7) * 2;
      *(LAS u32x2*)(lds + AT_KMH + o) = hi; *(LAS u32x2*)(lds + AT_KML + o) = lo;
      *(LAS u32x2*)(lds + AT_KMH + oz) = (u32x2){0u, 0u}; *(LAS u32x2*)(lds + AT_KML + oz) = (u32x2){0u, 0u};
#pragma unroll
      for (int i = 0; i < 3; ++i) { const int j = tid + 512 * i; const int d = 512 - j;
          if (j < 768) ((LAS float*)(lds + AT_TB))[j] = d < 0 ? -INFINITY : a.rel_bias[T5_BUCKET[d > 127 ? 127 : d] * NH + h] * LOG2E - 4.0f; else ((LAS float*)(lds + AT_TB))[j] = -INFINITY; } }
}
__device__ __forceinline__ void attn_unit(const Frame& F, const Args& a, int b, int h, int qb, const bool live) {
    unsigned char* ws = a.ws;
    const bf16_t* Qg = (const bf16_t*)(ws + WS_Q); const unsigned char* K8g = ws + WS_K; const unsigned char* VTg = ws + WS_VA;
    bf16_t* Zg = (bf16_t*)(ws + WS_U); const bf16_t* GBg = (const bf16_t*)(ws + WS_GB);
    const float* kpart = (const float*)(ws + WS_KPART);
    LAS unsigned char* lds = F.lds;
    int lane_ = F.lane, wid_ = F.wave; asm volatile("" : "+v"(lane_), "+s"(wid_));
    const int lane = lane_, wid = wid_, tid = wid * 64 + lane, r32 = lane & 31, hh = lane >> 5;
    const size_t tok_b = (size_t)b * SEQ;
    const int NT = 4 * (qb + 1);
#pragma unroll 1
    for (int cch = ((a.rep_mask >> 10) & 1) ? -2 : 0; cch < 2; ++cch) gmlp_chunk(F, a, (int)tok_b + qb * 256 + 128 * (cch & 1), h, live && cch >= 0);
    asm volatile("s_waitcnt vmcnt(0)" ::: "memory"); __builtin_amdgcn_fence(__ATOMIC_ACQ_REL, "workgroup");
    __syncthreads();
    const unsigned char* ksrc = K8g + (tok_b + 8 * wid + (lane >> 3)) * D + h * HD + 16 * ((lane & 7) ^ ((4 * wid + (lane >> 4)) & 7));
    const unsigned char* vsrc = VTg + (size_t)(b * 8 + h) * (64 * 8192) + (16 * wid + (lane >> 2)) * 64 + 16 * ((lane & 3) ^ ((lane >> 4) & 3));
#define AT_ISSUE(t) do { const int _bo = ((t) & 1) * 32768; \
        __builtin_amdgcn_global_load_lds((const unsigned*)(ksrc + (size_t)(t) * 64 * D), (LAS unsigned*)(lds + AT_KV + _bo + wid * 1024), 16, 0, 0); \
        __builtin_amdgcn_global_load_lds((const unsigned*)(vsrc + (size_t)(t) * 8192), (LAS unsigned*)(lds + AT_KV + _bo + 16384 + wid * 1024), 16, 0, 0); } while (0)
    AT_ISSUE(0);
    const int qi = wid * 32 + r32;
    const size_t qtok = tok_b + (size_t)qb * 256 + qi;
    pg8::i32x8_t q8[2];
    const float QS = 8.0f * 0.08838834764831845f * LOG2E;
    unsigned sel = 0u;
    { f32x16 gacc = {};
#pragma unroll
      for (int ks2 = 0; ks2 < 2; ++ks2) { bf16x8 qraw[4];
#pragma unroll
          for (int e = 0; e < 4; ++e) qraw[e] = *(const bf16x8*)(Qg + qtok * D + h * HD + 64 * ks2 + 32 * hh + 8 * e);
#pragma unroll
          for (int e = 0; e < 4; ++e) { const bf16x8 kh = *(const LAS bf16x8*)(lds + AT_KMH + off_b(r32, 8 * ks2 + 4 * hh + e)), kl = *(const LAS bf16x8*)(lds + AT_KML + off_b(r32, 8 * ks2 + 4 * hh + e));
              gacc = __builtin_amdgcn_mfma_f32_32x32x16_bf16(kh, qraw[e], gacc, 0, 0, 0); gacc = __builtin_amdgcn_mfma_f32_32x32x16_bf16(kl, qraw[e], gacc, 0, 0, 0); }
#pragma unroll
          for (int e = 0; e < 4; ++e) { const bf16x8 qq = qraw[e]; const u32x4 qw = __builtin_bit_cast(u32x4, qq);
              q8[ks2][2 * e] = (int)cvt_pk4_fp8(QS * bf_lo(qw.x), QS * bf_hi(qw.x), QS * bf_lo(qw.y), QS * bf_hi(qw.y)); q8[ks2][2 * e + 1] = (int)cvt_pk4_fp8(QS * bf_lo(qw.z), QS * bf_hi(qw.z), QS * bf_lo(qw.w), QS * bf_hi(qw.w)); } }
      float gv[16];
#pragma unroll
      for (int aa = 0; aa < 2; ++aa)
#pragma unroll
          for (int i = 0; i < 4; ++i) { const float own = gacc[4 * aa + i], oth = __shfl_xor(own, 32);
              gv[8 * aa + i] = hh ? oth : own; gv[8 * aa + 4 + i] = hh ? own : oth; }
#pragma unroll
      for (int n = 0; n < 16; ++n) if (n >= qb) gv[n] = -INFINITY;
#pragma unroll
      for (int k = 0; k < 3; ++k) { float best = -INFINITY; int bi = -1;
#pragma unroll
          for (int n = 0; n < 16; ++n) { const bool c = !((sel >> n) & 1u) && gv[n] > best; best = c ? gv[n] : best; bi = c ? n : bi; }
          if (bi >= 0) sel |= 1u << bi; } }
    const LAS float* TB = (const LAS float*)(lds + AT_TB);
    const float b31 = TB[512 - 127];
    const LAS float* tbl = TB + (512 - r32 + 4 * hh);
    f32x16 o[4]; o[0] = f32x16{}; o[1] = f32x16{}; o[2] = f32x16{}; o[3] = f32x16{};
    f32x16 o5 = f32x16{};
    const pg8::i32x8_t ones8 = {0x38383838, 0x38383838, 0x38383838, 0x38383838, 0x38383838, 0x38383838, 0x38383838, 0x38383838};
    pg8::i32x8_t p8 = {0, 0, 0, 0, 0, 0, 0, 0};
    f32x16 cbf = {};
    const unsigned kb0 = 128u * r32 + 16u * ((2u * hh) ^ ((r32 >> 1) & 7u));
    const unsigned vb0 = 64u * r32 + 16u * ((2u * hh) ^ ((r32 >> 2) & 3u));
    const int sc1 = 0x7f7f7f7f, scq = 0x7c7c7c7c;
#define AT_MMA_SEED(S, KF, QF) asm volatile("v_mfma_scale_f32_32x32x64_f8f6f4 %0, %1, %2, %5, %3, %4 op_sel_hi:[0,0,0]" : "=&v"(S) : "v"(KF), "v"(QF), "v"(sc1), "v"(scq), "v"(cbf))
#define AT_MMA_ACC(S, KF, QF) asm volatile("v_mfma_scale_f32_32x32x64_f8f6f4 %0, %1, %2, %0, %3, %4 op_sel_hi:[0,0,0]" : "+v"(S) : "v"(KF), "v"(QF), "v"(sc1), "v"(scq))
#define AT_SOFTMAX(S, HI) { float pr[16]; \
            _Pragma("unroll") for (int r = 0; r < 16; ++r) pr[r] = __builtin_amdgcn_exp2f(S[r]); \
            _Pragma("unroll") for (int w = 0; w < 8; ++w) p8[w] = HI ? __builtin_amdgcn_cvt_pk_fp8_f32(pr[w], pr[8 + w], p8[w], true) : __builtin_amdgcn_cvt_pk_fp8_f32(pr[w], pr[8 + w], p8[w], false); }
#define AT_TILE(FAST) { pg8::i32x8_t kf[4]; \
            _Pragma("unroll") for (int i = 0; i < 4; ++i) { const pg8::i32x4_t lo = *(const LAS pg8::i32x4_t*)(lds + (kb ^ (64u * (i & 1))) + (i >> 1) * 4096), hi = *(const LAS pg8::i32x4_t*)(lds + (kb ^ (64u * (i & 1)) ^ 16u) + (i >> 1) * 4096); \
                kf[i] = (pg8::i32x8_t){lo[0], lo[1], lo[2], lo[3], hi[0], hi[1], hi[2], hi[3]}; } \
            f32x16 s0, s1; \
            if (!(FAST)) { const LAS float* tp = tbl + (bfar == -INFINITY ? 768 : 0) + (kj0 - rel - wid * 32); \
                _Pragma("unroll") for (int r = 0; r < 16; ++r) s0[r] = tp[(r & 3) + 8 * (r >> 2)]; \
                _Pragma("unroll") for (int r = 0; r < 16; ++r) s1[r] = tp[32 + (r & 3) + 8 * (r >> 2)]; } \
            asm volatile("s_waitcnt lgkmcnt(0)\n\ts_nop 1" ::: "memory"); \
            if (FAST) { AT_MMA_SEED(s0, kf[0], q8[0]); } else { AT_MMA_ACC(s0, kf[0], q8[0]); } \
            AT_MMA_ACC(s0, kf[1], q8[1]); \
            if (FAST) { AT_MMA_SEED(s1, kf[2], q8[0]); } else { AT_MMA_ACC(s1, kf[2], q8[0]); } \
              \
            asm volatile("v_mfma_scale_f32_32x32x64_f8f6f4 %0, %2, %3, %0, %4, %5 op_sel_hi:[0,0,0]\n\ts_nop 7" : "+v"(s1), "+v"(s0) : "v"(kf[3]), "v"(q8[1]), "v"(sc1), "v"(scq)); \
              \
            pg8::i32x8_t vf[4]; \
            _Pragma("unroll") for (int dt = 0; dt < 4; ++dt) { const pg8::i32x4_t lo = *(const LAS pg8::i32x4_t*)(lds + vb + 2048 * dt), hi = *(const LAS pg8::i32x4_t*)(lds + (vb ^ 16u) + 2048 * dt); \
                vf[dt] = (pg8::i32x8_t){lo[0], lo[1], lo[2], lo[3], hi[0], hi[1], hi[2], hi[3]}; } \
            __builtin_amdgcn_sched_barrier(0); \
            AT_SOFTMAX(s0, false) \
            __builtin_amdgcn_sched_barrier(0); \
            AT_SOFTMAX(s1, true) \
            __builtin_amdgcn_sched_barrier(0); \
              \
            asm volatile("s_waitcnt lgkmcnt(0)\n\ts_nop 3" ::: "memory"); \
            _Pragma("unroll") for (int dt = 0; dt < 4; ++dt) \
                asm volatile("v_mfma_f32_32x32x64_f8f6f4 %0, %1, %2, %0" : "+v"(o[dt]) : "v"(p8), "v"(vf[dt])); \
            asm volatile("v_mfma_f32_32x32x64_f8f6f4 %0, %1, %2, %0" : "+v"(o5) : "v"(p8), "v"(ones8)); \
            __builtin_amdgcn_sched_barrier(0); }
#define AT_STEP(FAST) { \
        if (t + 1 < NT) { AT_ISSUE(t + 1); asm volatile("s_waitcnt vmcnt(2)" ::: "memory"); } else { asm volatile("s_waitcnt vmcnt(0)" ::: "memory"); } \
        __builtin_amdgcn_s_barrier(); asm volatile("" ::: "memory"); \
        const int n = t >> 2, kj0 = (t & 3) * 64; \
        unsigned kb = kb0 + AT_KV + (t & 1) * 32768, vb = vb0 + AT_KV + (t & 1) * 32768 + 16384; \
        asm volatile("" : "+v"(kb), "+v"(vb));                                    \
        const int rel = (n == qb) ? 0 : 256;                                      \
        const float bfar = (n == qb || ((sel >> n) & 1u)) ? b31 : -INFINITY;      \
        AT_TILE(FAST) \
        asm volatile("s_waitcnt lgkmcnt(0)" ::: "memory"); __builtin_amdgcn_s_barrier(); asm volatile("" ::: "memory"); }
    const int T1 = qb > 0 ? 4 * (qb - 1) : 0;
#pragma unroll 1
    for (int pass = (a.rep_mask >> 11) & 1; pass >= 0; --pass) {
    int t = 0;
#pragma unroll 1
    while (t < T1) {
        { const float bf = ((sel >> (t >> 2)) & 1u) ? b31 : -INFINITY;
#pragma unroll
          for (int r = 0; r < 16; ++r) cbf[r] = bf; }
#pragma unroll 1
        for (int j = 0; j < 4; ++j, ++t) AT_STEP(1)
    }
    asm volatile("s_nop 15\n\ts_nop 7" : "+v"(o[0]), "+v"(o[1]), "+v"(o[2]), "+v"(o[3]), "+v"(o5));
#pragma unroll 1
    for (; t < NT; ++t) AT_STEP(0)
    asm volatile("s_nop 15\n\ts_nop 7" : "+v"(o[0]), "+v"(o[1]), "+v"(o[2]), "+v"(o[3]), "+v"(o5));
    if (pass) { AT_ISSUE(0); }
    }
#undef AT_STEP
#undef AT_TILE
#undef AT_SOFTMAX
#undef AT_MMA_ACC
#undef AT_MMA_SEED
    asm volatile("s_nop 15\n\ts_nop 15" ::: "memory");
    { LAS unsigned char* stg = lds + AT_KV + wid * 8192;
#pragma unroll
      for (int r = 0; r < 16; ++r) { const int qrow = crow(r, hh); const float li = __builtin_amdgcn_rcpf(o5[r]);
#pragma unroll
          for (int dt = 0; dt < 4; ++dt) *(LAS bf16_t*)(stg + qrow * 256 + (32 * dt + r32) * 2) = (bf16_t)(cvt_pk_bf16(o[dt][r] * li, 0.f) & 0xffffu); }
      asm volatile("s_waitcnt lgkmcnt(0)" ::: "memory");
      const size_t rowbase = (tok_b + (size_t)qb * 256 + wid * 32) * D + h * HD;
#pragma unroll
      for (int i = 0; i < 8; ++i) { const int row = 4 * i + (lane >> 4), ch = lane & 15;
          const u32x4 yv = *(const LAS u32x4*)(stg + row * 256 + ch * 16);
          const size_t off = rowbase + (size_t)row * D + ch * 8;
          const u32x4 zv = *(const u32x4*)(Zg + off); const u32x2 g8 = *(const u32x2*)((const unsigned char*)GBg + off);
          u32x4 ov;
          { const f32x2 g0 = __builtin_amdgcn_cvt_pk_f32_fp8((int)g8.x, false), g1 = __builtin_amdgcn_cvt_pk_f32_fp8((int)g8.x, true), g2 = __builtin_amdgcn_cvt_pk_f32_fp8((int)g8.y, false), g3 = __builtin_amdgcn_cvt_pk_f32_fp8((int)g8.y, true);
            ov.x = cvt_pk_bf16(bf_lo(zv.x) + g0[0] * bf_lo(yv.x), bf_hi(zv.x) + g0[1] * bf_hi(yv.x)); ov.y = cvt_pk_bf16(bf_lo(zv.y) + g1[0] * bf_lo(yv.y), bf_hi(zv.y) + g1[1] * bf_hi(yv.y));
            ov.z = cvt_pk_bf16(bf_lo(zv.z) + g2[0] * bf_lo(yv.z), bf_hi(zv.z) + g2[1] * bf_hi(yv.z)); ov.w = cvt_pk_bf16(bf_lo(zv.w) + g3[0] * bf_lo(yv.w), bf_hi(zv.w) + g3[1] * bf_hi(yv.w)); }
          if (live) *(u32x4*)(Zg + off) = ov; }
      asm volatile("s_waitcnt lgkmcnt(0)" ::: "memory"); }
#undef AT_ISSUE
}
__device__ __forceinline__ void p3_attention(const Frame& F, const Args& a, const bool live) {
    for (int v = F.vcu; v < 256; v += F.G) {
        const int bh = v >> 3, s = v & 7;
        __syncthreads(); gmlp_load_ws(F, a, bh & 7); attn_bh_tables(F, a, bh >> 3, bh & 7);
#pragma unroll 1
        for (int uu = 0; uu < 2; ++uu) attn_unit(F, a, bh >> 3, bh & 7, uu ? s : 15 - s, live);
    }
}

constexpr int P5_CTR_OFF = MISC_OFF + 256;
__device__ __forceinline__ void router_tile(const Args& a, const int tile, const int lane, LAS float* scr  , const bool live) {
    unsigned char* ws = a.ws;
    const float* lpart = (const float*)(ws + WS_LPART); const float* ssqp = (const float*)(ws + WS_SSQ);
    unsigned* cnt = (unsigned*)(ws + WS_CTL) + CW_CNT; int* list = (int*)(ws + WS_LIST); int* inv = (int*)(ws + WS_INV); float* wtok = (float*)(ws + WS_WTOK); float* rsp = (float*)(ws + WS_RSP);
        const int row0 = tile * 16, r = lane & 15, kq = lane >> 4;
        const float* lp = lpart + ((size_t)kq * T + row0 + r) * 48;
        f32x4 pv[12];
#pragma unroll
        for (int i = 0; i < 12; ++i) pv[i] = *(const f32x4*)(lp + 4 * i);
        float ssq = ssqp[(size_t)kq * T + row0 + r];
#pragma unroll
        for (int i = 0; i < 12; ++i)
#pragma unroll
            for (int j = 0; j < 4; ++j) { float v = pv[i][j]; v += __shfl_xor(v, 16); v += __shfl_xor(v, 32); pv[i][j] = v; }
        ssq += __shfl_xor(ssq, 16); ssq += __shfl_xor(ssq, 32);
        const float rs = 1.0f / sqrtf(ssq * (1.f / D) + NORM_EPS);
        if (kq == 0) {
#pragma unroll
            for (int i = 0; i < 12; ++i)
#pragma unroll
                for (int j = 0; j < 4; ++j) scr[r * 49 + 4 * i + j] = pv[i][j]; }
        LDS_WAIT(); asm volatile("" ::: "memory");
        if (lane < 16) {
            const LAS float* lr = scr + lane * 49;
            float gl[4];
#pragma unroll
            for (int g = 0; g < 4; ++g) gl[g] = lr[32 + g] * rs + a.b_gr[g];
            int gi = 0; float gm = gl[0];
#pragma unroll
            for (int g = 1; g < 4; ++g) if (gl[g] > gm) { gm = gl[g]; gi = g; }
            float den = 0.f;
#pragma unroll
            for (int g = 0; g < 4; ++g) den += __expf(gl[g] - gm);
            const float g_w = 1.0f / den;
            float el[8];
#pragma unroll
            for (int e = 0; e < 8; ++e) el[e] = lr[gi * 8 + e] * rs + a.b_er[gi * 8 + e];
            int e0 = 0; float v0 = el[0];
#pragma unroll
            for (int e = 1; e < 8; ++e) if (el[e] > v0) { v0 = el[e]; e0 = e; }
            int e1 = -1; float v1 = -INFINITY;
#pragma unroll
            for (int e = 0; e < 8; ++e) if (e != e0 && el[e] > v1) { v1 = el[e]; e1 = e; }
            const float x1 = __expf(v1 - v0), w0f = g_w / (1.0f + x1), w1f = g_w * x1 / (1.0f + x1);
            if (live) { const int m = row0 + lane;
                const int ex0 = gi * 8 + e0, ex1 = gi * 8 + e1;
                const unsigned p0 = __hip_atomic_fetch_add(cnt + 64 * ex0, 1u, __ATOMIC_RELAXED, __HIP_MEMORY_SCOPE_AGENT);
                const unsigned p1 = __hip_atomic_fetch_add(cnt + 64 * ex1, 1u, __ATOMIC_RELAXED, __HIP_MEMORY_SCOPE_AGENT);
                list[ex0 * LCAP + p0] = m * 2; list[ex1 * LCAP + p1] = m * 2 + 1;
                rsp[ex0 * LCAP + p0] = rs; rsp[ex1 * LCAP + p1] = rs;
                *(int2*)(inv + m * 2) = make_int2(ex0 * LCAP + (int)p0, ex1 * LCAP + (int)p1); *(float2*)(wtok + m * 2) = make_float2(w0f, w1f); }
        }
        LDS_WAIT(); asm volatile("" ::: "memory");
}
__device__ __forceinline__ void p5_router(const Frame& F, const Args& a, const bool live, const bool route) {
    unsigned char* ws = a.ws;
    const int lane = F.lane, wid = F.wave;
    LAS unsigned* ctr = (LAS unsigned*)(F.lds + P5_CTR_OFF);
    if (F.tid == 0) *ctr = 0u;
    __syncthreads();
    if (route && wid < 4) {
        LAS float* scr = (LAS float*)(F.lds + wid * 16384 + 8704);
        for (int tile = F.vcu * 4 + wid; tile < T / 16; tile += F.G * 4) router_tile(a, tile, lane, scr, live);
    }
    { LAS float* tscr = (LAS float*)(F.lds + wid * 16384);
      const float* w1 = a.w1; const float* w3 = a.w3; const float* w2 = a.w2; unsigned char* w13 = ws + WS_W13; unsigned char* w2t = ws + WS_W2;
      constexpr int I13 = (D / 32) * (DEXP / 64), I2 = (DEXP / 32) * (D / 64), IPE = 2 * I13 + I2;
      auto gen = [=](int it) -> TDesc {
          TDesc d; const int e = it / IPE; int r = it % IPE;
          if (r < 2 * I13) { const int which = r / I13; r %= I13; const int kb = r / (DEXP / 64), nb = r % (DEXP / 64);
              d.src = (which ? w3 : w1) + (size_t)e * D * DEXP; d.N = DEXP; d.k0 = 32 * kb; d.n0 = 64 * nb; d.dst = w13 + (size_t)e * 512 * D; d.ldd = D; d.rmk = 3; d.which = which; d.scale = 32.0f; }
          else { r -= 2 * I13; const int kb = r / (D / 64), nb = r % (D / 64);
              d.src = w2 + (size_t)e * DEXP * D; d.N = D; d.k0 = 32 * kb; d.n0 = 64 * nb; d.dst = w2t + (size_t)e * D * DEXP; d.ldd = DEXP; d.rmk = 0; d.which = 0; d.scale = 16.0f; }
          return d; };
      const int per_wg = (NEXP * IPE + F.G - 1) / F.G;
      const int base = F.vcu * per_wg;
      const int q4 = per_wg / 8;
      const int restw = (per_wg - 4 * q4 + 3) / 4;
      const int lo_ = wid < 4 ? wid * q4 : 4 * q4 + (wid - 4) * restw;
      int hi_ = wid < 4 ? lo_ + q4 : lo_ + restw; if (hi_ > per_wg) hi_ = per_wg;
      int endi = base + hi_; if (endi > NEXP * IPE) endi = NEXP * IPE;
      titems_run(gen, base + lo_, 1, endi, tscr, lane); }
    __syncthreads();
}

__device__ __forceinline__ void p8_final(const Frame& F, const Args& a, const bool live) {
    const int gw = F.vcu * NWAVES + F.wave, NGW = F.G * NWAVES, lane = F.lane;
    const unsigned char* yp = a.ws + WS_YP;
    const LAS int* pref = (const LAS int*)(F.lds + PREF_OFF);
    f32x4 gv[4];
#pragma unroll
    for (int j = 0; j < 4; ++j) gv[j] = *((const f32x4*)a.norm_final_g + lane + 64 * j);
    for (int m = gw; m < T; m += NGW) {
        f32x4* xr = (f32x4*)(a.out + (size_t)m * D) + lane;
        const u32x2* hr = (const u32x2*)((const bf16_t*)(a.ws + WS_HB) + (size_t)m * D) + lane;
        const int2 iv = *(const int2*)((const int*)(a.ws + WS_INV) + m * 2); const float2 wv = *(const float2*)((const float*)(a.ws + WS_WTOK) + m * 2);
        const int pr0 = 256 * pref[iv.x >> 14] + (iv.x & (LCAP - 1)), pr1 = 256 * pref[iv.y >> 14] + (iv.y & (LCAP - 1));
        const unsigned* y0 = (const unsigned*)(yp + (size_t)pr0 * D) + lane; const unsigned* y1 = (const unsigned*)(yp + (size_t)pr1 * D) + lane;
        const float w0 = wv.x * (1.0f / 16.0f), w1 = wv.y * (1.0f / 16.0f);
        f32x4 v[4]; float s = 0.f;
#pragma unroll
        for (int j = 0; j < 4; ++j) { const unsigned p0 = y0[64 * j], p1 = y1[64 * j];
            const f32x2 a0 = __builtin_amdgcn_cvt_pk_f32_fp8((int)p0, false), a1 = __builtin_amdgcn_cvt_pk_f32_fp8((int)p0, true), b0 = __builtin_amdgcn_cvt_pk_f32_fp8((int)p1, false), b1 = __builtin_amdgcn_cvt_pk_f32_fp8((int)p1, true);
            const u32x2 hb = hr[64 * j];
            v[j] = (f32x4){bf_lo(hb.x), bf_hi(hb.x), bf_lo(hb.y), bf_hi(hb.y)} + (f32x4){w0 * a0[0] + w1 * b0[0], w0 * a0[1] + w1 * b0[1], w0 * a1[0] + w1 * b1[0], w0 * a1[1] + w1 * b1[1]};
            s += (v[j].x * v[j].x + v[j].y * v[j].y) + (v[j].z * v[j].z + v[j].w * v[j].w); }
        const float rs = 1.0f / sqrtf(wave_sum(s) * (1.f / D) + NORM_EPS);
#pragma unroll
        for (int j = 0; j < 4; ++j) if (live) xr[64 * j] = v[j] * rs * gv[j];
    }
}

constexpr int N_PHASES = 9;
__global__ void __launch_bounds__(NTHREADS, 2) mk_fwd(Args args) {
    extern __shared__ __attribute__((aligned(16))) unsigned char lds_raw[];
#define MKFRAME() Frame F; { unsigned l_ = __builtin_amdgcn_mbcnt_hi(~0u, __builtin_amdgcn_mbcnt_lo(~0u, 0u)); asm volatile("" : "+v"(l_)); F.lds = (LAS unsigned char*)lds_raw; F.lane = (int)l_; F.wave = wave0; F.tid = wave0 * 64 + F.lane; \
        F.G = gridDim.x; const int bx_ = blockIdx.x; F.vcu = (F.G % 8 == 0) ? (bx_ % 8) * (F.G / 8) + bx_ / 8 : bx_; }
    LAS unsigned char* const lds0 = (LAS unsigned char*)lds_raw;
    const int wave0 = __builtin_amdgcn_readfirstlane((int)(threadIdx.x >> 6));
    unsigned char* ws = args.ws;
    unsigned* ctl = (unsigned*)(ws + WS_CTL);
    if (threadIdx.x < 64) ((LAS unsigned*)(lds0 + MISC_OFF))[threadIdx.x] = 0u;
    __syncthreads();
    const int lo = args.ph_lo, hi = args.ph_hi, repm = args.rep_mask;
    XcdBarrier bar; bar.bar = ctl + CW_BAR; bar.x = 0; bar.st = nullptr;
    bar = xcd_barrier_post(ctl + CW_BAR, (volatile LAS unsigned*)(lds0 + MISC_OFF));
#ifndef PHASE_MASK
#define PHASE_MASK 0x1ff
#endif
#define IN(k) (((PHASE_MASK >> (k)) & 1) && lo <= (k) && (k) < hi)
#define SEAM(k) do { if (IN(k) && IN((k) + 1)) xcd_barrier(bar); } while (0)
#define REP(k) _Pragma("unroll 1") for (int rep_ = ((repm >> (k)) & 1); rep_ >= 0; --rep_)
#define LIVE (rep_ == 0)

    if (IN(0)) { REP(0) { MKFRAME(); const Args a = load_args(); p0_prologue(F, a); } SEAM(0); }
    if (IN(1)) { REP(1) {
        { MKFRAME(); const Args args = load_args();
          pg8::StaticOrder S; S.init((const bf16_t*)args.out, (const bf16_t*)(ws + WS_WIN), T, 2048, D, F.G, (int)blockIdx.x);
          EpiInProj E{(bf16_t*)(ws + WS_U), args.b_gates, (float*)(ws + WS_KPART), (f32x2*)(ws + WS_STAT), 0};
          pg8::gemm_phase<EpiInProj, pg8::StaticOrder, false, D>(F.lds, F.tid, S, E, nullptr); }
        { MKFRAME(); const Args args = load_args();
          pg8::StaticOrder S; S.init((const bf16_t*)(ws + WS_XN8), (const bf16_t*)(ws + WS_WIN8), T, 5120, D / 2, F.G, (int)blockIdx.x);
          EpiInProj E{(bf16_t*)(ws + WS_U), args.b_gates, (float*)(ws + WS_KPART), (f32x2*)(ws + WS_STAT), 8};
          pg8::gemm_phase<EpiInProj, pg8::StaticOrder, false, D / 2, 0x7a>(F.lds, F.tid, S, E, nullptr); } }
        SEAM(1);
    }
    if (IN(3)) { REP(3) { MKFRAME(); const Args a = load_args(); p3_attention(F, a, LIVE); } SEAM(3); }
    const bool fuse_route = (gridDim.x * 1 == (unsigned)(T / 256) * (D / 256));
    if (IN(4)) { REP(4) {
        MKFRAME(); const Args args = load_args();
        pg8::StaticOrder S; S.init((const bf16_t*)(ws + WS_U), (const bf16_t*)(ws + WS_WOUT), T, D, D, F.G, (int)blockIdx.x);
        EpiOutProj E{(const bf16_t*)args.out, (const float*)(ws + WS_XRS), args.norm_mix_g, (bf16_t*)(ws + WS_HB), args.norm_ffn_g, ws + WS_XN2, (const bf16_t*)(ws + WS_RW), (float*)(ws + WS_LPART), (float*)(ws + WS_SSQ), F.lds + RED_OFF};
        pg8::gemm_phase<EpiOutProj, pg8::StaticOrder, false, D>(F.lds, F.tid, S, E, nullptr);
        if (fuse_route && LIVE) {
            pg8::Unit u0; S.next(0, u0);
            LAS unsigned* flag = (LAS unsigned*)(F.lds + P5_CTR_OFF);
            if (F.tid == 0) { __builtin_amdgcn_fence(__ATOMIC_RELEASE, "agent");
                const unsigned old = __hip_atomic_fetch_add(ctl + CW_PANEL + 64 * u0.pm, 1u, __ATOMIC_RELAXED, __HIP_MEMORY_SCOPE_AGENT);
                if (old == 3u) { __builtin_amdgcn_fence(__ATOMIC_ACQUIRE, "agent"); asm volatile("s_waitcnt vmcnt(0)" ::: "memory"); }
                *flag = old; }
            __syncthreads();
            if (*flag == 3u) { LAS float* scr = (LAS float*)(F.lds + F.wave * 16384 + 8704);
#pragma unroll 1
                for (int tt = F.wave; tt < 16; tt += NWAVES) router_tile(args, u0.pm * 16 + tt, F.lane, scr, true); }
        } }
        if (!fuse_route) SEAM(4);
    }
    if (IN(5)) { REP(5) { MKFRAME(); const Args a = load_args(); p5_router(F, a, LIVE, !fuse_route); } SEAM(5); }
    if (IN(6) || IN(7) || IN(8)) {
        if (threadIdx.x == 0) { LAS int* pref = (LAS int*)(lds0 + PREF_OFF); int acc = 0;
            for (int e = 0; e < NEXP; ++e) { pref[e] = acc; const int c = (int)__hip_atomic_load(ctl + CW_CNT + 64 * e, __ATOMIC_RELAXED, __HIP_MEMORY_SCOPE_AGENT); acc += (c + 255) >> 8; }
            pref[NEXP] = acc; }
        __syncthreads();
    }
    if (IN(6)) { REP(6) {
        typedef pg8::MoeOrder<2, 0, (size_t)512 * D, (size_t)256 * D, D> Ord1;
        typedef pg8::MoeOrder<4, (size_t)256 * DEXP, (size_t)D * DEXP, (size_t)256 * DEXP, 0> Ord2;
        const int G = gridDim.x, total = __builtin_amdgcn_readfirstlane(((const LAS int*)(lds0 + PREF_OFF))[NEXP]);
        const int n1 = 2 * total, r = n1 > G ? n1 - G : 0, early = (n1 > G ? G : n1) / 2;
#pragma unroll 1
        for (int stage = 0; stage < 2; ++stage) {
            MKFRAME();
            Ord1 S; S.pref = (const LAS int*)(F.lds + PREF_OFF); S.c = (int)blockIdx.x; S.A = (const char*)(ws + WS_XN2); S.Bt = (const char*)(ws + WS_W13); S.list = (const int*)(ws + WS_LIST);
            S.first = stage == 0 ? 0 : 2 * early; S.limit = stage == 0 ? 2 * early : n1; S.cbase = 0; S.nwg = stage == 0 ? G : (r > 0 ? r : 1);
            EpiMoe1 E{ws + WS_HID, (const float*)(ws + WS_RSP), ctl + CW_CNT};
            pg8::gemm_phase<EpiMoe1, Ord1, true, D / 2, 0x7a>(F.lds, F.tid, S, E, ctl + CW_CNT);
            if (stage == 0) xcd_barrier(bar);
        }
#pragma unroll 1
        for (int stage = 1; stage < 3; ++stage) {
            MKFRAME();
            Ord2 S; S.pref = (const LAS int*)(F.lds + PREF_OFF); S.c = (int)blockIdx.x; S.A = (const char*)(ws + WS_HID); S.Bt = (const char*)(ws + WS_W2); S.list = (const int*)(ws + WS_LIST);
            S.first = stage == 2 ? 4 * early : 0; S.limit = stage == 1 ? 4 * early : 4 * total; S.cbase = stage == 1 ? r : 0; S.nwg = stage == 1 ? G - r : G;
            EpiMoe2 E{ws + WS_YP};
            pg8::gemm_phase<EpiMoe2, Ord2, false, DEXP / 2, 0x7b>(F.lds, F.tid, S, E, nullptr);
            if (stage == 1) xcd_barrier(bar);
        } }
        SEAM(6);
    }
    if (IN(8)) { REP(8) { MKFRAME(); const Args a = load_args(); p8_final(F, a, LIVE); } }
#undef IN
#undef SEAM
#undef REP
#undef LIVE
}

#ifndef MK_REP_MASK
#define MK_REP_MASK 0x000
#endif
#ifndef MK_SPLIT
#define MK_SPLIT 0
#endif
extern "C" void kernel_launch(void* const* d_in, const int* in_sizes, int n_in, void* d_out, int out_size, void* d_ws, size_t ws_size, hipStream_t stream) {
    static int grid = 0;
    if (grid == 0) {
        if (n_in != 19 || out_size != T * D || ws_size < WS_END) { fprintf(stderr, "kernel_launch: unexpected problem (n_in %d, out %d, ws %zu)\n", n_in, out_size, ws_size); grid = -1; return; }
        int dev = 0, cus = 0, per_cu = 0;
        if (hipGetDevice(&dev) != hipSuccess || hipDeviceGetAttribute(&cus, hipDeviceAttributeMultiprocessorCount, dev) != hipSuccess) { grid = -1; return; }
        if (hipFuncSetAttribute((const void*)mk_fwd, hipFuncAttributeMaxDynamicSharedMemorySize, LDS_BYTES) != hipSuccess) { fprintf(stderr, "kernel_launch: hipFuncSetAttribute failed\n"); grid = -1; return; }
        if (hipOccupancyMaxActiveBlocksPerMultiprocessor(&per_cu, (const void*)mk_fwd, NTHREADS, LDS_BYTES) != hipSuccess || per_cu < 1) fprintf(stderr, "kernel_launch: occupancy query reports %d\n", per_cu);
        (void)hipGetLastError();
        grid = cus;
    }
    if (grid < 0) return;
    if (hipMemsetAsync((char*)d_ws + WS_CTL, 0, CTL_ZERO_BYTES, stream) != hipSuccess) return;
    Args a{};
    a.x = (const float*)d_in[0]; a.norm_mix_g = (const float*)d_in[1]; a.w_in = (const float*)d_in[2]; a.b_gates = (const float*)d_in[3]; a.ln_g = (const float*)d_in[4]; a.ln_b = (const float*)d_in[5];
    a.w_spatial = (const float*)d_in[6]; a.b_spatial = (const float*)d_in[7]; a.rel_bias = (const float*)d_in[8]; a.w_out = (const float*)d_in[9]; a.norm_ffn_g = (const float*)d_in[10];
    a.w_gr = (const float*)d_in[11]; a.b_gr = (const float*)d_in[12]; a.w_er = (const float*)d_in[13]; a.b_er = (const float*)d_in[14]; a.w1 = (const float*)d_in[15]; a.w3 = (const float*)d_in[16]; a.w2 = (const float*)d_in[17];
    a.norm_final_g = (const float*)d_in[18]; a.out = (float*)d_out; a.ws = (unsigned char*)d_ws; a.rep_mask = MK_REP_MASK; a.pad = 0;
#if MK_SPLIT
    for (int p = 0; p < N_PHASES; ++p) { a.ph_lo = p; a.ph_hi = p + 1; hipLaunchKernelGGL(mk_fwd, dim3(grid), dim3(NTHREADS), LDS_BYTES, stream, a); }
#else
    a.ph_lo = 0; a.ph_hi = N_PHASES; hipLaunchKernelGGL(mk_fwd, dim3(grid), dim3(NTHREADS), LDS_BYTES, stream, a);
#endif
}
```
